# Optimizing an MI355X kernel written in HIP

```python
import math
import jax, jax.numpy as jnp
from jax import lax
import numpy as np

D_MODEL = 1024
BATCH = 1
SEQ = 16384
DEPTH = 2
DEC_BATCH = 32
DEC_SEQ = 16
PAST_LEN = 2048

CHUNK = 64
QBLK = 128
EPS = 1e-5
NEG_BIG = -1e30

S5_WIDTH = D_MODEL // 4
S5_GROUP = 16
S5_GROUPS = S5_WIDTH // S5_GROUP
S5_STATE = 64
S5_DT_MIN = 1e-3
S5_DT_MAX = 1e-1

HG_HEADS = 4
HG_DK = 64
HG_DV = 64
HG_WIDTH = HG_HEADS * HG_DV

MLA_HEADS = 8
MLA_Q_RANK = 256
MLA_KV_RANK = 128
MLA_NOPE = 64
MLA_ROPE = 32
MLA_V = 64
MLA_WIDTH = MLA_HEADS * MLA_V
ROPE_THETA = 10000.0

MIX_WIDTH = S5_WIDTH + HG_WIDTH + MLA_WIDTH
D_FF = 4 * D_MODEL

IN_SPLITS = (S5_WIDTH, HG_HEADS * HG_DK, HG_HEADS * HG_DK, HG_WIDTH, HG_WIDTH, MLA_Q_RANK, MLA_KV_RANK, MLA_ROPE)
IN_WIDTH = S5_WIDTH + 2 * HG_HEADS * HG_DK + 2 * HG_WIDTH + MLA_Q_RANK + MLA_KV_RANK + MLA_ROPE

kernel_name = 'hybrid_s5_hgrn2_mla_stream_step'


def rms_norm(x, g):
    xf = x.astype(jnp.float32)
    y = xf * lax.rsqrt(jnp.mean(xf * xf, axis=-1, keepdims=True) + EPS)
    return (y * g.astype(jnp.float32)).astype(x.dtype)


def cmul(ar, ai, br, bi):
    return ar * br - ai * bi, ar * bi + ai * br


def split_columns(proj):
    outs, start = [], 0
    for width in IN_SPLITS:
        outs.append(proj[..., start:start + width])
        start += width
    return outs


def s5_mixer(u, h0_re, h0_im, lam_re, lam_im, log_dt, b_re, b_im, c_re, c_im, d, w_glu, b_glu):
    f32 = jnp.float32
    bsz, L, _ = u.shape
    uf = u.astype(f32).reshape(bsz, L, S5_GROUPS, S5_GROUP)
    lam_re = lam_re.astype(f32)
    lam_im = lam_im.astype(f32)
    dt = jnp.exp(log_dt.astype(f32))[:, None]
    mag = jnp.exp(lam_re * dt)
    ab_re, ab_im = mag * jnp.cos(lam_im * dt), mag * jnp.sin(lam_im * dt)
    den = lam_re * lam_re + lam_im * lam_im
    z_re, z_im = cmul(ab_re - 1.0, ab_im, lam_re / den, -lam_im / den)
    bb_re, bb_im = cmul(z_re[..., None], z_im[..., None], b_re.astype(f32), b_im.astype(f32))
    bu_re = jnp.einsum('blgh,gph->blgp', uf, bb_re)
    bu_im = jnp.einsum('blgh,gph->blgp', uf, bb_im)
    s_re, s_im = cmul(ab_re, ab_im, h0_re.astype(f32), h0_im.astype(f32))
    bu_re = bu_re.at[:, 0].add(s_re)
    bu_im = bu_im.at[:, 0].add(s_im)
    a_re = jnp.broadcast_to(ab_re, bu_re.shape)
    a_im = jnp.broadcast_to(ab_im, bu_im.shape)

    def combine(e1, e2):
        a1r, a1i, b1r, b1i = e1
        a2r, a2i, b2r, b2i = e2
        ar, ai = cmul(a2r, a2i, a1r, a1i)
        br, bi = cmul(a2r, a2i, b1r, b1i)
        return ar, ai, br + b2r, bi + b2i

    _, _, h_re, h_im = lax.associative_scan(combine, (a_re, a_im, bu_re, bu_im), axis=1)
    y = (jnp.einsum('blgp,ghp->blgh', h_re, c_re.astype(f32))
         - jnp.einsum('blgp,ghp->blgh', h_im, c_im.astype(f32)))
    y = y.reshape(bsz, L, S5_WIDTH) + d.astype(f32) * u.astype(f32)
    z = jax.nn.gelu(y)
    out = z * jax.nn.sigmoid(z @ w_glu.astype(f32) + b_glu.astype(f32))
    return out.astype(u.dtype), h_re[:, -1], h_im[:, -1]


def hgrn2_mixer(q, f_pre, i, s0, lb):
    f32 = jnp.float32
    bsz, L, _ = q.shape
    C = min(CHUNK, L)
    N = L // C
    lbf = lb.astype(f32)
    fp = f_pre.astype(f32)
    f = lbf + (1.0 - lbf) * jax.nn.sigmoid(fp)
    logf = jnp.log(f)
    k = (1.0 - lbf) * jax.nn.sigmoid(-fp)
    qf = jax.nn.silu(q.astype(f32))
    v = i.astype(f32)

    def blocks(t, dim):
        return t.reshape(bsz, N, C, HG_HEADS, dim).transpose(1, 0, 3, 2, 4)

    mask = jnp.tril(jnp.ones((C, C), dtype=bool))[:, :, None]

    def step(S, blk):
        qb, kb, vb, gb = blk
        b = jnp.cumsum(gb, axis=2)
        inter = jnp.einsum('bhtd,bhdv->bhtv', qb * jnp.exp(b), S)
        diff = b[:, :, :, None, :] - b[:, :, None, :, :]
        decay = jnp.where(mask, jnp.exp(jnp.where(mask, diff, 0.0)), 0.0)
        att = jnp.einsum('bhtd,bhsd,bhtsd->bhts', qb, kb, decay)
        intra = jnp.einsum('bhts,bhsv->bhtv', att, vb)
        b_last = b[:, :, -1:, :]
        S_new = (jnp.exp(b_last[:, :, 0, :])[..., None] * S
                 + jnp.einsum('bhsd,bhsv->bhdv', kb * jnp.exp(b_last - b), vb))
        return S_new, inter + intra

    S, o = lax.scan(step, s0.astype(f32),
                    (blocks(qf, HG_DK), blocks(k, HG_DK), blocks(v, HG_DV), blocks(logf, HG_DK)))
    o = o.transpose(1, 0, 3, 2, 4).reshape(bsz, L, HG_WIDTH)
    return o, S


def rope(x, pos):
    half = MLA_ROPE // 2
    inv = ROPE_THETA ** (-jnp.arange(half, dtype=jnp.float32) / half)
    ang = pos.astype(jnp.float32)[:, None] * inv[None, :]
    ang = ang.reshape((pos.shape[0],) + (1,) * (x.ndim - 3) + (half,))
    cos, sin = jnp.cos(ang), jnp.sin(ang)
    xf = x.astype(jnp.float32)
    x1, x2 = xf[..., :half], xf[..., half:]
    return jnp.concatenate([x1 * cos - x2 * sin, x2 * cos + x1 * sin], axis=-1).astype(x.dtype)


def mla_project(cq, ckv, kpe, pos, q_norm_g, w_uq, kv_norm_g, w_uk):
    bsz, L, _ = cq.shape
    q = (rms_norm(cq, q_norm_g) @ w_uq).reshape(bsz, L, MLA_HEADS, MLA_NOPE + MLA_ROPE)
    q_nope = q[..., :MLA_NOPE]
    q_pe = rope(q[..., MLA_NOPE:], pos)
    c_kv = rms_norm(ckv, kv_norm_g)
    k_pe = rope(kpe, pos)
    q_lat = jnp.einsum('blhd,chd->blhc', q_nope, w_uk)
    return q_lat, q_pe, c_kv, k_pe


def mla_attend(q_lat, q_pe, q_pos, c_kv, k_pe, k_pos, w_uv):
    bsz, Lq = q_lat.shape[:2]
    qb = min(QBLK, Lq)
    nb = Lq // qb
    scale = (MLA_NOPE + MLA_ROPE) ** -0.5
    k_chunk = k_pos // CHUNK

    def block(args):
        ql, qp, qpos = args
        s = (jnp.einsum('bqhc,bkc->bhqk', ql, c_kv)
             + jnp.einsum('bqhr,bkr->bhqk', qp, k_pe)).astype(jnp.float32) * scale
        mask = k_chunk[None, :] <= (qpos // CHUNK)[:, None]
        p = jax.nn.softmax(jnp.where(mask, s, NEG_BIG), axis=-1)
        return jnp.einsum('bhqk,bkc->bqhc', p.astype(c_kv.dtype), c_kv)

    def split(t):
        return t.reshape((bsz, nb, qb) + t.shape[2:]).swapaxes(0, 1)

    o_lat = lax.map(block, (split(q_lat), split(q_pe), q_pos.reshape(nb, qb)))
    o_lat = o_lat.swapaxes(0, 1).reshape(bsz, Lq, MLA_HEADS, MLA_KV_RANK)
    o = jnp.einsum('blhc,chv->blhv', o_lat, w_uv)
    return o.reshape(bsz, Lq, MLA_WIDTH)


def trunk_layer(x, q_pos, k_pos, s5_h0_re, s5_h0_im, hg_s0, kv_past, pe_past, lb, w):
    h = rms_norm(x, w['norm1_g'])
    u, hq, hf, hi, hg, cq, ckv, kpe = split_columns(h @ w['w_in'])
    s5_y, s5_re, s5_im = s5_mixer(u, s5_h0_re, s5_h0_im, w['s5_lambda_re'], w['s5_lambda_im'], w['s5_log_dt'],
                                  w['s5_b_re'], w['s5_b_im'], w['s5_c_re'], w['s5_c_im'], w['s5_d'],
                                  w['s5_w_glu'], w['s5_b_glu'])
    hg_o, hg_s = hgrn2_mixer(hq, hf, hi, hg_s0, lb)
    q_lat, q_pe, c_kv, k_pe = mla_project(cq, ckv, kpe, q_pos, w['mla_q_norm_g'], w['mla_w_uq'],
                                          w['mla_kv_norm_g'], w['mla_w_uk'])
    if kv_past is None:
        kv_all, pe_all = c_kv, k_pe
    else:
        kv_all = jnp.concatenate([kv_past.astype(c_kv.dtype), c_kv], axis=1)
        pe_all = jnp.concatenate([pe_past.astype(k_pe.dtype), k_pe], axis=1)
    mla_o = mla_attend(q_lat, q_pe, q_pos, kv_all, pe_all, k_pos, w['mla_w_uv'])
    g = w['out_norm_g']
    a0, a1 = S5_WIDTH, S5_WIDTH + HG_WIDTH
    mixed = jnp.concatenate([
        rms_norm(s5_y, g[:a0]),
        rms_norm(hg_o, g[a0:a1]) * jax.nn.silu(hg.astype(jnp.float32)),
        rms_norm(mla_o, g[a1:]),
    ], axis=-1).astype(x.dtype)
    x = x + mixed @ w['w_out']
    h2 = rms_norm(x, w['norm2_g'])
    x = x + jnp.square(jax.nn.relu(h2 @ w['w_up'])) @ w['w_down']
    return x, c_kv, k_pe, hg_s, s5_re, s5_im


def setup_inputs(seed: int = 0) -> dict:
    key = jax.random.key(seed)
    ks = iter(jax.random.split(key, 40))

    def nrm(shape, scale):
        return scale * jax.random.normal(next(ks), shape, jnp.float32)

    def gain(shape):
        return 1.0 + 0.01 * jax.random.normal(next(ks), shape, jnp.float32)

    L = DEPTH
    n_idx = jnp.arange(S5_STATE, dtype=jnp.float32)
    return {
        'x_prompt': nrm((BATCH, SEQ, D_MODEL), 1.0),
        'x_sample': nrm((DEC_BATCH, DEC_SEQ, D_MODEL), 1.0),
        'cache_mla_kv': nrm((L, DEC_BATCH, PAST_LEN, MLA_KV_RANK), 1.0),
        'cache_mla_pe': nrm((L, DEC_BATCH, PAST_LEN, MLA_ROPE), 1.0),
        'state_hgrn': nrm((L, DEC_BATCH, HG_HEADS, HG_DK, HG_DV), 0.5),
        'state_s5_re': nrm((L, DEC_BATCH, S5_GROUPS, S5_STATE), 0.05),
        'state_s5_im': nrm((L, DEC_BATCH, S5_GROUPS, S5_STATE), 0.05),
        'norm1_g': gain((L, D_MODEL)),
        'w_in': nrm((L, D_MODEL, IN_WIDTH), D_MODEL ** -0.5),
        's5_lambda_re': -0.5 + nrm((L, S5_GROUPS, S5_STATE), 0.01),
        's5_lambda_im': math.pi * n_idx + nrm((L, S5_GROUPS, S5_STATE), 0.01),
        's5_log_dt': jax.random.uniform(next(ks), (L, S5_GROUPS), jnp.float32,
                                        math.log(S5_DT_MIN), math.log(S5_DT_MAX)),
        's5_b_re': nrm((L, S5_GROUPS, S5_STATE, S5_GROUP), S5_GROUP ** -0.5),
        's5_b_im': nrm((L, S5_GROUPS, S5_STATE, S5_GROUP), S5_GROUP ** -0.5),
        's5_c_re': nrm((L, S5_GROUPS, S5_GROUP, S5_STATE), S5_STATE ** -0.5),
        's5_c_im': nrm((L, S5_GROUPS, S5_GROUP, S5_STATE), S5_STATE ** -0.5),
        's5_d': nrm((L, S5_WIDTH), 1.0),
        's5_w_glu': nrm((L, S5_WIDTH, S5_WIDTH), S5_WIDTH ** -0.5),
        's5_b_glu': nrm((L, S5_WIDTH), 0.01),
        'hgrn_lb_logits': nrm((L, HG_HEADS * HG_DK), 0.5),
        'mla_q_norm_g': gain((L, MLA_Q_RANK)),
        'mla_w_uq': nrm((L, MLA_Q_RANK, MLA_HEADS * (MLA_NOPE + MLA_ROPE)), MLA_Q_RANK ** -0.5),
        'mla_kv_norm_g': gain((L, MLA_KV_RANK)),
        'mla_w_uk': nrm((L, MLA_KV_RANK, MLA_HEADS, MLA_NOPE), MLA_KV_RANK ** -0.5),
        'mla_w_uv': nrm((L, MLA_KV_RANK, MLA_HEADS, MLA_V), MLA_KV_RANK ** -0.5),
        'out_norm_g': gain((L, MIX_WIDTH)),
        'w_out': nrm((L, MIX_WIDTH, D_MODEL), MIX_WIDTH ** -0.5),
        'norm2_g': gain((L, D_MODEL)),
        'w_up': nrm((L, D_MODEL, D_FF), D_MODEL ** -0.5),
        'w_down': nrm((L, D_FF, D_MODEL), D_FF ** -0.5),
        'final_norm_g': gain((D_MODEL,)),
    }


def reference(x_prompt, x_sample, cache_mla_kv, cache_mla_pe, state_hgrn, state_s5_re, state_s5_im,
              norm1_g, w_in, s5_lambda_re, s5_lambda_im, s5_log_dt, s5_b_re, s5_b_im, s5_c_re, s5_c_im,
              s5_d, s5_w_glu, s5_b_glu, hgrn_lb_logits, mla_q_norm_g, mla_w_uq, mla_kv_norm_g, mla_w_uk,
              mla_w_uv, out_norm_g, w_out, norm2_g, w_up, w_down, final_norm_g):
    bp, lp = x_prompt.shape[0], x_prompt.shape[1]
    ls = x_sample.shape[1]
    past = cache_mla_kv.shape[2]
    pos_p = jnp.arange(lp, dtype=jnp.int32)
    pos_s = past + jnp.arange(ls, dtype=jnp.int32)
    kpos_s = jnp.arange(past + ls, dtype=jnp.int32)
    lb_p = jax.nn.softmax(hgrn_lb_logits.astype(jnp.float32), axis=0)
    lb_all = jnp.cumsum(lb_p, axis=0) - lb_p[0]
    zero_s5 = jnp.zeros((bp, S5_GROUPS, S5_STATE), jnp.float32)
    zero_hg = jnp.zeros((bp, HG_HEADS, HG_DK, HG_DV), jnp.float32)

    xp, xs = x_prompt, x_sample
    p_kv, p_pe, p_hg, p_re, p_im = [], [], [], [], []
    s_kv, s_pe, s_hg, s_re, s_im = [], [], [], [], []
    for l in range(DEPTH):
        w = {
            'norm1_g': norm1_g[l], 'w_in': w_in[l],
            's5_lambda_re': s5_lambda_re[l], 's5_lambda_im': s5_lambda_im[l], 's5_log_dt': s5_log_dt[l],
            's5_b_re': s5_b_re[l], 's5_b_im': s5_b_im[l], 's5_c_re': s5_c_re[l], 's5_c_im': s5_c_im[l],
            's5_d': s5_d[l], 's5_w_glu': s5_w_glu[l], 's5_b_glu': s5_b_glu[l],
            'mla_q_norm_g': mla_q_norm_g[l], 'mla_w_uq': mla_w_uq[l], 'mla_kv_norm_g': mla_kv_norm_g[l],
            'mla_w_uk': mla_w_uk[l], 'mla_w_uv': mla_w_uv[l],
            'out_norm_g': out_norm_g[l], 'w_out': w_out[l], 'norm2_g': norm2_g[l],
            'w_up': w_up[l], 'w_down': w_down[l],
        }
        xp, a, b, c, d, e = trunk_layer(xp, pos_p, pos_p, zero_s5, zero_s5, zero_hg, None, None, lb_all[l], w)
        p_kv.append(a); p_pe.append(b); p_hg.append(c); p_re.append(d); p_im.append(e)
        xs, a, b, c, d, e = trunk_layer(xs, pos_s, kpos_s, state_s5_re[l], state_s5_im[l], state_hgrn[l],
                                        cache_mla_kv[l], cache_mla_pe[l], lb_all[l], w)
        s_kv.append(a); s_pe.append(b); s_hg.append(c); s_re.append(d); s_im.append(e)

    y_prompt = rms_norm(xp, final_norm_g)
    y_sample = rms_norm(xs, final_norm_g)
    return (y_prompt, y_sample,
            jnp.stack(p_kv), jnp.stack(p_pe), jnp.stack(p_hg), jnp.stack(p_re), jnp.stack(p_im),
            jnp.stack(s_kv), jnp.stack(s_pe), jnp.stack(s_hg), jnp.stack(s_re), jnp.stack(s_im))
```

```cpp
#include <hip/hip_runtime.h>
#include <hip/hip_cooperative_groups.h>
#include <cstdio>
#include <cstdint>
namespace cg = cooperative_groups;
namespace pg8 {
#define PG8_LAS __attribute__((address_space(3)))
typedef unsigned short bf16_t;
typedef short bf16x8 __attribute__((ext_vector_type(8)));
typedef float f32x4 __attribute__((ext_vector_type(4)));
typedef unsigned u32x4 __attribute__((ext_vector_type(4)));
constexpr int BM = 256, BK = 64, HALF = 128, HTB = HALF * BK * 2  , STAGE_BYTES = 8 * HTB, NXCD = 8, WGM = 8;

__host__ __device__ __forceinline__ int lds_byte(int r, int c) { const int st = (r >> 4) * 2 + (c >> 5), rr = r & 15, cc = c & 31, ob = rr * 64 + cc * 2; return st * 1024 + (ob ^ (((ob >> 9) & 1) << 5)); }
__host__ __device__ __forceinline__ void stage_rc(int b, int& R, int& C) { const int st = b / 1024, sb = b % 1024, swz = sb ^ (((sb >> 9) & 1) << 5); R = (st >> 1) * 16 + swz / 64; C = (st & 1) * 32 + (swz % 64) / 2; }
__host__ __device__ __forceinline__ int perm32(int rho) { const int n = rho >> 4, i = rho & 15; return 8 * (i >> 2) + 4 * n + (i & 3); }

struct Unit { int pm, pn; };
struct Gemm { const bf16_t* A; const bf16_t* Bt; int M, N, K, lda, ldb; };

struct StaticOrder {
    int nM, nN, nwg, G, c;
    __host__ __device__ void init(int M, int N, int G_, int c_) { nM = M / BM; nN = N / BM; nwg = nM * nN; G = G_; c = c_; }
    __host__ __device__ bool next(int i, Unit& u) const {
        const long L = (long)i * G + c; if (L >= nwg) return false;
        int wgid = (int)L; { const int q = nwg / NXCD, r = nwg % NXCD, xcd = wgid % NXCD, off = wgid / NXCD; wgid = (xcd < r ? xcd * (q + 1) : r * (q + 1) + (xcd - r) * q) + off; }
        const int nig = WGM * nN, gid = wgid / nig, fm = gid * WGM, gsz = (nM - fm) < WGM ? (nM - fm) : WGM;
        u.pm = fm + ((wgid % nig) % gsz); u.pn = (wgid % nig) / gsz; return true;
    }
    __device__ __forceinline__ void a_ready(const Unit&) const {}
    __device__ __forceinline__ void done(const Unit&) const {}
};

__device__ __forceinline__ unsigned cvt_pk_bf16(float lo, float hi) { unsigned r; asm volatile("v_cvt_pk_bf16_f32 %0, %1, %2" : "=v"(r) : "v"(lo), "v"(hi)); return r; }
typedef float f32x2 __attribute__((ext_vector_type(2)));
__device__ __forceinline__ f32x2 gelu_pk(f32x2 v) {
    const f32x2 av = __builtin_elementwise_abs(v), d = av * 0.2316418882f + 1.0f;
    f32x2 t; t.x = __builtin_amdgcn_rcpf(d.x); t.y = __builtin_amdgcn_rcpf(d.y);
    f32x2 q = t * 0.5307027145f + (-0.7265760135f); q = q * t + 0.7107068705f; q = q * t + (-0.142248368f); q = q * t + 0.127414796f; q = q * t;
    const f32x2 s = (v * v) * (-0.72134752044f);
    f32x2 e; e.x = __builtin_amdgcn_exp2f(s.x); e.y = __builtin_amdgcn_exp2f(s.y);
    const f32x2 m = v * (q * e), r = v - m;
    f32x2 o; o.x = v.x < 0.f ? m.x : r.x; o.y = v.y < 0.f ? m.y : r.y; return o;
}

template <class Epi, class Sched, bool ALIGN_EPI = false, bool SP2 = false>
__device__ __forceinline__ void gemm_phase(PG8_LAS unsigned char* lds, const Gemm g, const Sched& S, const Epi& E) {
    const int tid = threadIdx.x, wid = __builtin_amdgcn_readfirstlane(tid >> 6), lane = tid & 63, wr = wid >> 2, wc = wid & 3, fr = lane & 15, fq = lane >> 4;
    const int K = g.K, nt = K / BK;
    unsigned voffA[2], voffB[2];
#pragma unroll
    for (int i = 0; i < 2; ++i) { int R, C; stage_rc(tid * 16 + i * 8192, R, C); const int Rb = Epi::PERM ? ((R & ~31) + perm32(R & 31)) : R;
        voffA[i] = (unsigned)(R * g.lda + C) * 2u; voffB[i] = (unsigned)(Rb * g.ldb + C) * 2u; }
    const size_t kstep = (size_t)(BK * 2);
    const size_t hstepA = (size_t)HALF * g.lda * 2, hstepB = (size_t)HALF * g.ldb * 2;
    const size_t tstepA = 2 * hstepA, tstepB = 2 * hstepB;
    const unsigned ldsw = (unsigned)wid * 1024u;
    const int aoff = lds_byte(wr * 64 + fr, fq * 8), boff = lds_byte(wc * 32 + fr, fq * 8);
#define PG8_SA(b, h) (((b) * 2 + (h)) * HTB)
#define PG8_SB(b, h) ((4 + (b) * 2 + (h)) * HTB)
#define PG8_STAGE(bufoff, gbase, voff) do { _Pragma("unroll") for (int _i = 0; _i < 2; ++_i) \
        __builtin_amdgcn_global_load_lds((const unsigned*)((const char*)(gbase) + (voff)[_i]), (PG8_LAS unsigned*)(lds + (bufoff) + ldsw + _i * 8192), 16, 0, 0); } while (0)
#define PG8_LDA(dst, b, h) do { _Pragma("unroll") for (int m = 0; m < 4; ++m) _Pragma("unroll") for (int k = 0; k < 2; ++k) dst[m][k] = *(const PG8_LAS bf16x8*)(lds + PG8_SA(b, h) + aoff + m * 2048 + k * 1024); } while (0)
#define PG8_LDB(dst, b, h) do { _Pragma("unroll") for (int n = 0; n < 2; ++n) _Pragma("unroll") for (int k = 0; k < 2; ++k) dst[n][k] = *(const PG8_LAS bf16x8*)(lds + PG8_SB(b, h) + boff + n * 2048 + k * 1024); } while (0)
#define PG8_MMA(ai, bj, At, Bt) do { __builtin_amdgcn_s_setprio(1); _Pragma("unroll") for (int m = 0; m < 4; ++m) _Pragma("unroll") for (int n = 0; n < 2; ++n) _Pragma("unroll") for (int k = 0; k < 2; ++k) \
        acc[ai][bj][m][n] = __builtin_amdgcn_mfma_f32_16x16x32_bf16(Bt[n][k], At[m][k], acc[ai][bj][m][n], 0, 0, 0); __builtin_amdgcn_s_setprio(0); } while (0)
#define PG8_WAIT_V(n) asm volatile("s_waitcnt vmcnt(" #n ")" ::: "memory")
#define PG8_WAIT_L(n) asm volatile("s_waitcnt lgkmcnt(" #n ")" ::: "memory")
#define PG8_BAR __builtin_amdgcn_s_barrier()
#define PG8_SCHED __builtin_amdgcn_sched_barrier(0)
    Unit cur, nxt; int ui = 0;
    if (!S.next(0, cur)) return;
    f32x4 acc[2][2][4][2];
#pragma unroll
    for (int a = 0; a < 2; ++a)
#pragma unroll
        for (int b = 0; b < 2; ++b)
#pragma unroll
            for (int m = 0; m < 4; ++m)
#pragma unroll
                for (int n = 0; n < 2; ++n) acc[a][b][m][n] = (f32x4){0.f, 0.f, 0.f, 0.f};
    bf16x8 At[4][2], B0[2][2], B1[2][2];
    const char* cA = (const char*)g.A + (size_t)cur.pm * tstepA; const char* cB = (const char*)g.Bt + (size_t)cur.pn * tstepB;
    S.a_ready(cur);
    if constexpr (SP2) {
        PG8_STAGE(PG8_SB(0, 0), cB, voffB); PG8_STAGE(PG8_SB(0, 1), cB + hstepB, voffB); PG8_STAGE(PG8_SA(0, 0), cA, voffA); PG8_STAGE(PG8_SA(0, 1), cA + hstepA, voffA);
        if (wr == 1) PG8_BAR;
        PG8_WAIT_V(2); PG8_BAR;
        PG8_STAGE(PG8_SB(1, 0), cB + kstep, voffB); PG8_STAGE(PG8_SA(1, 0), cA + kstep, voffA); PG8_STAGE(PG8_SB(1, 1), cB + hstepB + kstep, voffB);
        PG8_WAIT_V(6); PG8_BAR;
    } else {
        PG8_STAGE(PG8_SB(0, 0), cB, voffB); PG8_STAGE(PG8_SA(0, 0), cA, voffA); PG8_STAGE(PG8_SB(0, 1), cB + hstepB, voffB); PG8_STAGE(PG8_SA(0, 1), cA + hstepA, voffA);
        if (wr == 1) PG8_BAR;
        PG8_WAIT_V(4); PG8_BAR;
        PG8_STAGE(PG8_SB(1, 0), cB + kstep, voffB); PG8_STAGE(PG8_SA(1, 0), cA + kstep, voffA); PG8_STAGE(PG8_SB(1, 1), cB + hstepB + kstep, voffB);
        PG8_WAIT_V(6); PG8_BAR;
    }
    for (;;) {
        const bool has_next = S.next(ui + 1, nxt);
        const char* nA = has_next ? (const char*)g.A + (size_t)nxt.pm * tstepA : cA; const char* nB = has_next ? (const char*)g.Bt + (size_t)nxt.pn * tstepB : cB;
        for (int t = 0; t < nt; t += 2) {
            const bool last = (t == nt - 2);
            const char* a1 = cA + (size_t)(t + 1) * kstep;
            const char* a2 = last ? nA : cA + (size_t)(t + 2) * kstep; const char* b2 = last ? nB : cB + (size_t)(t + 2) * kstep;
            const char* a3 = a2 + kstep; const char* b3 = b2 + kstep;
            if (last && has_next) S.a_ready(nxt);
            if constexpr (SP2) {
            PG8_LDB(B0, 0, 0); PG8_LDB(B1, 0, 1); PG8_SCHED; PG8_LDA(At, 0, 0); PG8_STAGE(PG8_SA(1, 1), a1 + hstepA, voffA);
            PG8_WAIT_V(8); PG8_WAIT_L(0); PG8_BAR; PG8_MMA(0, 0, At, B0); PG8_MMA(0, 1, At, B1); PG8_BAR; PG8_SCHED;
            PG8_LDA(At, 0, 1); PG8_STAGE(PG8_SB(0, 0), b2, voffB); PG8_STAGE(PG8_SB(0, 1), b2 + hstepB, voffB); PG8_STAGE(PG8_SA(0, 0), a2, voffA);
            PG8_WAIT_V(8); PG8_WAIT_L(0); PG8_BAR; PG8_MMA(1, 0, At, B0); PG8_MMA(1, 1, At, B1); PG8_BAR; PG8_SCHED;
            PG8_LDB(B0, 1, 0); PG8_LDB(B1, 1, 1); PG8_SCHED; PG8_LDA(At, 1, 0); PG8_STAGE(PG8_SA(0, 1), a2 + hstepA, voffA);
            PG8_WAIT_V(8); PG8_WAIT_L(0); PG8_BAR; PG8_MMA(0, 0, At, B0); PG8_MMA(0, 1, At, B1); PG8_BAR; PG8_SCHED;
            PG8_LDA(At, 1, 1); PG8_STAGE(PG8_SB(1, 0), b3, voffB); PG8_STAGE(PG8_SB(1, 1), b3 + hstepB, voffB); PG8_STAGE(PG8_SA(1, 0), a3, voffA);
            PG8_WAIT_V(8); PG8_WAIT_L(0); PG8_BAR; PG8_MMA(1, 0, At, B0); PG8_MMA(1, 1, At, B1); PG8_BAR; PG8_SCHED;
            } else {
            PG8_LDB(B0, 0, 0); PG8_SCHED; PG8_LDA(At, 0, 0); PG8_STAGE(PG8_SA(1, 1), a1 + hstepA, voffA);
            PG8_WAIT_L(8); PG8_BAR; PG8_WAIT_L(0); PG8_MMA(0, 0, At, B0); PG8_BAR; PG8_SCHED;
            PG8_LDB(B1, 0, 1); PG8_STAGE(PG8_SB(0, 0), b2, voffB);
            PG8_BAR; PG8_WAIT_L(0); PG8_MMA(0, 1, At, B1); PG8_BAR;
            PG8_LDA(At, 0, 1); PG8_STAGE(PG8_SA(0, 0), a2, voffA);
            PG8_BAR; PG8_WAIT_L(0); PG8_MMA(1, 0, At, B0); PG8_BAR; PG8_SCHED;
            PG8_STAGE(PG8_SB(0, 1), b2 + hstepB, voffB);
            PG8_WAIT_V(6); PG8_BAR; PG8_MMA(1, 1, At, B1); PG8_BAR;
            PG8_LDB(B0, 1, 0); PG8_SCHED; PG8_LDA(At, 1, 0); PG8_STAGE(PG8_SA(0, 1), a2 + hstepA, voffA);
            PG8_WAIT_L(8); PG8_BAR; PG8_WAIT_L(0); PG8_MMA(0, 0, At, B0); PG8_BAR; PG8_SCHED;
            PG8_LDB(B1, 1, 1); PG8_STAGE(PG8_SB(1, 0), b3, voffB);
            PG8_BAR; PG8_WAIT_L(0); PG8_MMA(0, 1, At, B1); PG8_BAR;
            PG8_LDA(At, 1, 1); PG8_STAGE(PG8_SA(1, 0), a3, voffA);
            PG8_BAR; PG8_WAIT_L(0); PG8_MMA(1, 0, At, B0); PG8_BAR; PG8_SCHED;
            PG8_STAGE(PG8_SB(1, 1), b3 + hstepB, voffB);
            PG8_WAIT_V(6); PG8_BAR; PG8_MMA(1, 1, At, B1); PG8_BAR;
            }
        }
        if constexpr (ALIGN_EPI) { if (wr == 0) PG8_BAR; }
        if constexpr (!Epi::AFTER_DRAIN) { E(acc, cur, wr, wc, fr, fq); S.done(cur); }
        if (!has_next) break;
#pragma unroll
        for (int a = 0; a < 2; ++a)
#pragma unroll
            for (int b = 0; b < 2; ++b)
#pragma unroll
                for (int m = 0; m < 4; ++m)
#pragma unroll
                    for (int n = 0; n < 2; ++n) acc[a][b][m][n] = (f32x4){0.f, 0.f, 0.f, 0.f};
        cur = nxt; cA = nA; cB = nB; ++ui;
        if constexpr (ALIGN_EPI) { if (wr == 1) PG8_BAR; }
    }
    PG8_WAIT_V(0);
    if constexpr (!ALIGN_EPI) { if (wr == 0) PG8_BAR; }
    PG8_BAR;
    if constexpr (Epi::AFTER_DRAIN) { E.fused(acc, cur, wr, wc, fr, fq, lds, wid, lane); S.done(cur); }
#undef PG8_SA
#undef PG8_SB
#undef PG8_STAGE
#undef PG8_LDA
#undef PG8_LDB
#undef PG8_MMA
#undef PG8_WAIT_V
#undef PG8_WAIT_L
#undef PG8_BAR
#undef PG8_SCHED
}
}

#define DI __device__ __forceinline__
#define LAS __attribute__((address_space(3)))
typedef unsigned short bf16;
typedef short bf16x8 __attribute__((ext_vector_type(8)));
typedef short s16x4 __attribute__((ext_vector_type(4)));
typedef float f32x4 __attribute__((ext_vector_type(4)));
typedef float f32x16 __attribute__((ext_vector_type(16)));
typedef unsigned u32x4 __attribute__((ext_vector_type(4)));
typedef unsigned u32x2 __attribute__((ext_vector_type(2)));
typedef float f32x2_t __attribute__((ext_vector_type(2)));
typedef __bf16 bf16x2_t __attribute__((ext_vector_type(2)));
DI unsigned pk2(float lo, float hi) { f32x2_t v = {lo, hi}; bf16x2_t b = __builtin_convertvector(v, bf16x2_t); return __builtin_bit_cast(unsigned, b); }
DI float bf2f(unsigned short x) { return __uint_as_float((unsigned)x << 16); }
DI float bflo(unsigned w) { return __uint_as_float(w << 16); }
DI float bfhi(unsigned w) { return __uint_as_float(w & 0xffff0000u); }
DI unsigned short f2bf(float f) { return (unsigned short)(pk2(f, 0.f) & 0xffffu); }
#define MFMA32(a, b, c) __builtin_amdgcn_mfma_f32_32x32x16_bf16((a), (b), (c), 0, 0, 0)
DI int crow(int i, int h) { return (i & 3) + 8 * (i >> 2) + 4 * h; }
DI float sigmoidf_(float x) { return 1.f / (1.f + __expf(-x)); }
DI float wave_sum(float v) {
#pragma unroll
    for (int o = 1; o < 64; o <<= 1) v += __shfl_xor(v, o);
    return v;
}
DI bf16x8 lds16(const char* p) { return *(const bf16x8*)p; }
DI bf16x8 lds8x2(const char* p) { const s16x4 a = *(const s16x4*)p, b = *(const s16x4*)(p + 8); return __builtin_shufflevector(a, b, 0, 1, 2, 3, 4, 5, 6, 7); }
typedef short v4i16_t __attribute__((ext_vector_type(4)));
DI s16x4 ldtr(const char* p) { return __builtin_bit_cast(s16x4, __builtin_amdgcn_ds_read_tr16_b64_v4i16((LAS v4i16_t*)p)); }
DI bf16x8 packf8(float a0, float a1, float a2, float a3, float a4, float a5, float a6, float a7) {
    u32x4 w; w.x = pk2(a0, a1); w.y = pk2(a2, a3); w.z = pk2(a4, a5); w.w = pk2(a6, a7); return __builtin_bit_cast(bf16x8, w);
}

constexpr int DM = 1024, TP = 16384, TS = 512, T = TP + TS, NBATCH = 32, DSEQ = 16, PAST = 2048, INW = 1696, INP = 1792, DFF = 4096;
constexpr int C_U = 0, C_HQ = 256, C_HF = 512, C_HI = 768, C_HG = 1024, C_CQ = 1280, C_CKV = 1536, C_KPE = 1664;
constexpr float EPS = 1e-5f;
constexpr float QSCALE = 0.14724444f;
constexpr int NTHR = 512, NWAVE = 8;
constexpr int LDS_BYTES = 147456;

constexpr size_t O_X = 0, O_PKV = 17301504, O_PPE = 21495808, O_PHG = 22544384, O_PRE = 22577152, O_PIM = 22579200,
                 O_SKV = 22581248, O_SPE = 22712320, O_SHG = 22745088, O_SRE = 23793664, O_SIM = 23859200;
constexpr size_t WS_ZERO = 0, ZERO_BYTES = 1048576, WS_SSQ = 4096, SSQ_STRIDE = (size_t)T * 4;
constexpr size_t WS_W = 1048576, W_LAYER = 23330816, W_IN = 0, W_UQ = 3670016, W_KV = 4063232, W_OUT = 4325376, W_UP = 6422528, W_DN = 14811136, W_GLU = 23199744;
constexpr size_t WS_MISC = WS_W + 2 * W_LAYER;
constexpr size_t M_AB = 0, M_BBRE = 16384, M_BBIM = M_BBRE + 131072, M_LB = M_BBIM + 131072, M_COS = M_LB + 2048, M_SIN = M_COS + 1048576, M_KCN = M_SIN + 1048576;
constexpr size_t WS_XB = WS_MISC + 4194304;
constexpr size_t WS_OV = WS_XB + (size_t)T * DM * 2;
constexpr size_t OV_PROJ = 0, OV_QF = OV_PROJ + (size_t)T * INP * 2, OV_KVF = OV_QF + (size_t)T * 768 * 2, OV_KPE = OV_KVF + (size_t)TP * 1024 * 2,
                 OV_MIX = OV_KPE + (size_t)TP * 32 * 2, OV_GT = OV_MIX + (size_t)T * DM * 2, OV_DD = OV_GT + (size_t)288 * 4 * 4096 * 4, OV_EBM = OV_DD + (size_t)288 * 256 * 4,
                 OV_E5 = OV_EBM + (size_t)288 * 256 * 4, OV_END = OV_E5 + (size_t)256 * 16 * 64 * 2 * 4;
constexpr size_t WS_END = WS_OV + OV_END;
static_assert(OV_END >= (size_t)T * DFF * 2, "hidden overlay fits");
static_assert(M_KCN + (size_t)2 * 32 * 64 * 160 * 2 <= 4194304, "misc region");
static_assert(WS_END <= 268435456, "workspace map within 256 MiB");
enum { SQ_X0 = 0, SQ_X1 = 1, SQ_XF = 2, SQ_2A = 3, SQ_2B = 4, SQ_QA = 5, SQ_QB = 6, SQ_KVA = 7, SQ_KVB = 8, SQ_MA = 9, SQ_MB = 10 };

struct Args { const float* in[31]; float* out; unsigned char* ws; };
enum { I_XP = 0, I_XS, I_CKV, I_CPE, I_SHG, I_S5RE, I_S5IM, I_N1G, I_WIN, I_LRE, I_LIM, I_LDT, I_BRE, I_BIM, I_CRE, I_CIM, I_S5D, I_WGLU, I_BGLU, I_LBL, I_QNG, I_WUQ, I_KVNG,
       I_WUK, I_WUV, I_ONG, I_WOUT, I_N2G, I_WUP, I_WDN, I_FNG };

struct Ctx {
    const float* const* in; float* out; unsigned char* ws; char* lds; int tid, lane, wave, G, blk;
    DI float* ssq(int i) const { return (float*)(ws + WS_SSQ + (size_t)i * SSQ_STRIDE); }
    DI bf16* wgt(int l, size_t off) const { return (bf16*)(ws + WS_W + (size_t)l * W_LAYER + off); }
    DI bf16* XB() const { return (bf16*)(ws + WS_XB); }
    DI bf16* PROJ() const { return (bf16*)(ws + WS_OV + OV_PROJ); }
    DI bf16* QF() const { return (bf16*)(ws + WS_OV + OV_QF); }
    DI bf16* KVF() const { return (bf16*)(ws + WS_OV + OV_KVF); }
    DI bf16* KPEB() const { return (bf16*)(ws + WS_OV + OV_KPE); }
    DI bf16* MIX() const { return (bf16*)(ws + WS_OV + OV_MIX); }
    DI bf16* HID() const { return (bf16*)(ws + WS_OV); }
    DI float* GT() const { return (float*)(ws + WS_OV + OV_GT); }
    DI float* DD() const { return (float*)(ws + WS_OV + OV_DD); }
    DI float* EBM() const { return (float*)(ws + WS_OV + OV_EBM); }
    DI float* E5() const { return (float*)(ws + WS_OV + OV_E5); }
    DI float* misc(size_t off) const { return (float*)(ws + WS_MISC + off); }
    DI bf16* KCN() const { return (bf16*)(ws + WS_MISC + M_KCN); }
    DI unsigned* ctr() const { return (unsigned*)(ws + WS_ZERO); }
};
DI int pos_of_row(int row) { return row < TP ? row : PAST + ((row - TP) & 15); }

namespace pg8 {
struct EpiG1 {
    static constexpr bool PERM = true, AFTER_DRAIN = false;
    bf16_t* O; const float* ssq; float* ssq_q; float* ssq_kv;
    __device__ __forceinline__ void operator()(const f32x4 (&acc)[2][2][4][2], const Unit& u, int wr, int wc, int fr, int fq) const {
        const int row0 = u.pm * BM + wr * 64 + fr, col0 = u.pn * BM + wc * 32 + 8 * fq;
#pragma unroll
        for (int ai = 0; ai < 2; ++ai)
#pragma unroll
            for (int m = 0; m < 4; ++m) {
                const int row = row0 + ai * HALF + m * 16; const float sc = rsqrtf(ssq[row] * (1.f / 1024.f) + 1e-5f); float s2[2];
#pragma unroll
                for (int bj = 0; bj < 2; ++bj) { const f32x4 v0 = acc[ai][bj][m][0] * sc, v1 = acc[ai][bj][m][1] * sc;
                    u32x4 w; w.x = cvt_pk_bf16(v0[0], v0[1]); w.y = cvt_pk_bf16(v0[2], v0[3]); w.z = cvt_pk_bf16(v1[0], v1[1]); w.w = cvt_pk_bf16(v1[2], v1[3]);
                    *(u32x4*)(O + (size_t)row * 1792 + col0 + bj * HALF) = w;
                    s2[bj] = (v0[0] * v0[0] + v0[1] * v0[1]) + (v0[2] * v0[2] + v0[3] * v0[3]) + (v1[0] * v1[0] + v1[1] * v1[1]) + (v1[2] * v1[2] + v1[3] * v1[3]); }
                if (u.pn == 5 || u.pn == 6) { float s = (u.pn == 5) ? s2[0] + s2[1] : s2[0]; s += __shfl_xor(s, 16); s += __shfl_xor(s, 32);
                    if (fq == 0) atomicAdd((u.pn == 5 ? ssq_q : ssq_kv) + row, s); }
            }
    }
};
struct EpiQ {
    static constexpr bool PERM = true, AFTER_DRAIN = false;
    bf16_t* O; const float* ssq;
    __device__ __forceinline__ void operator()(const f32x4 (&acc)[2][2][4][2], const Unit& u, int wr, int wc, int fr, int fq) const {
        const int row0 = u.pm * BM + wr * 64 + fr;
#pragma unroll
        for (int ai = 0; ai < 2; ++ai)
#pragma unroll
            for (int m = 0; m < 4; ++m) {
                const int row = row0 + ai * HALF + m * 16; const float sc = rsqrtf(ssq[row] * (1.f / 256.f) + 1e-5f) * 0.14724444f;
#pragma unroll
                for (int bj = 0; bj < 2; ++bj) { const int c = u.pn * BM + bj * HALF + wc * 32 + 8 * fq; int h, d;
                    if (c < 512) { h = c >> 6; d = c & 63; } else { const int j = (c - 512) & 127; h = j >> 4; d = 64 + 16 * ((c - 512) >> 7) + (j & 15); }
                    const f32x4 v0 = acc[ai][bj][m][0] * sc, v1 = acc[ai][bj][m][1] * sc;
                    u32x4 w; w.x = cvt_pk_bf16(v0[0], v0[1]); w.y = cvt_pk_bf16(v0[2], v0[3]); w.z = cvt_pk_bf16(v1[0], v1[1]); w.w = cvt_pk_bf16(v1[2], v1[3]);
                    *(u32x4*)(O + (size_t)row * 768 + h * 96 + d) = w; }
            }
    }
};
struct EpiScaleStore {
    static constexpr bool PERM = true, AFTER_DRAIN = false;
    bf16_t* O; int ldc; const float* ssq; float inv_n;
    __device__ __forceinline__ void operator()(const f32x4 (&acc)[2][2][4][2], const Unit& u, int wr, int wc, int fr, int fq) const {
        const int row0 = u.pm * BM + wr * 64 + fr, col0 = u.pn * BM + wc * 32 + 8 * fq;
#pragma unroll
        for (int ai = 0; ai < 2; ++ai)
#pragma unroll
            for (int m = 0; m < 4; ++m) {
                const int row = row0 + ai * HALF + m * 16; const float sc = rsqrtf(ssq[row] * inv_n + 1e-5f);
#pragma unroll
                for (int bj = 0; bj < 2; ++bj) { const f32x4 v0 = acc[ai][bj][m][0] * sc, v1 = acc[ai][bj][m][1] * sc;
                    u32x4 w; w.x = cvt_pk_bf16(v0[0], v0[1]); w.y = cvt_pk_bf16(v0[2], v0[3]); w.z = cvt_pk_bf16(v1[0], v1[1]); w.w = cvt_pk_bf16(v1[2], v1[3]);
                    *(u32x4*)(O + (size_t)row * ldc + col0 + bj * HALF) = w; }
            }
    }
};
struct EpiUp {
    static constexpr bool PERM = true, AFTER_DRAIN = false;
    bf16_t* O; const float* ssq;
    __device__ __forceinline__ void operator()(const f32x4 (&acc)[2][2][4][2], const Unit& u, int wr, int wc, int fr, int fq) const {
        const int row0 = u.pm * BM + wr * 64 + fr, col0 = u.pn * BM + wc * 32 + 8 * fq;
#pragma unroll
        for (int ai = 0; ai < 2; ++ai)
#pragma unroll
            for (int m = 0; m < 4; ++m) {
                const int row = row0 + ai * HALF + m * 16; const float sc = rsqrtf(ssq[row] * (1.f / 1024.f) + 1e-5f);
#pragma unroll
                for (int bj = 0; bj < 2; ++bj) { f32x4 v0 = acc[ai][bj][m][0] * sc, v1 = acc[ai][bj][m][1] * sc;
#pragma unroll
                    for (int e = 0; e < 4; ++e) { v0[e] = fmaxf(v0[e], 0.f); v1[e] = fmaxf(v1[e], 0.f); }
                    v0 = v0 * v0; v1 = v1 * v1;
                    u32x4 w; w.x = cvt_pk_bf16(v0[0], v0[1]); w.y = cvt_pk_bf16(v0[2], v0[3]); w.z = cvt_pk_bf16(v1[0], v1[1]); w.w = cvt_pk_bf16(v1[2], v1[3]);
                    *(u32x4*)(O + (size_t)row * 4096 + col0 + bj * HALF) = w; }
            }
    }
};
struct EpiRes {
    static constexpr bool PERM = true, AFTER_DRAIN = false;
    float* X; bf16_t* XB; float* ssq_out;
    __device__ __forceinline__ void operator()(const f32x4 (&acc)[2][2][4][2], const Unit& u, int wr, int wc, int fr, int fq) const {
        const int row0 = u.pm * BM + wr * 64 + fr, col0 = u.pn * BM + wc * 32 + 8 * fq;
#pragma unroll
        for (int ai = 0; ai < 2; ++ai)
#pragma unroll
            for (int m = 0; m < 4; ++m) {
                const int row = row0 + ai * HALF + m * 16; float s = 0.f;
#pragma unroll
                for (int bj = 0; bj < 2; ++bj) { float* xp = X + (size_t)row * 1024 + col0 + bj * HALF;
                    const f32x4 v0 = *(const f32x4*)xp + acc[ai][bj][m][0], v1 = *(const f32x4*)(xp + 4) + acc[ai][bj][m][1];
                    *(f32x4*)xp = v0; *(f32x4*)(xp + 4) = v1;
                    u32x4 w; w.x = cvt_pk_bf16(v0[0], v0[1]); w.y = cvt_pk_bf16(v0[2], v0[3]); w.z = cvt_pk_bf16(v1[0], v1[1]); w.w = cvt_pk_bf16(v1[2], v1[3]);
                    *(u32x4*)(XB + (size_t)row * 1024 + col0 + bj * HALF) = w;
                    s += (v0[0] * v0[0] + v0[1] * v0[1]) + (v0[2] * v0[2] + v0[3] * v0[3]) + (v1[0] * v1[0] + v1[1] * v1[1]) + (v1[2] * v1[2] + v1[3] * v1[3]); }
                s += __shfl_xor(s, 16); s += __shfl_xor(s, 32);
                if (fq == 0) atomicAdd(ssq_out + row, s);
            }
    }
};
}

DI int uq_dest(int n) { const int h = n / 96, d = n - h * 96; return d < 64 ? h * 64 + d : (d < 80 ? 512 + h * 16 + (d - 64) : 640 + h * 16 + (d - 80)); }
DI void p0_transpose_item(const float* W, int K, int N, const float* gain, bf16* WT, int row_off, int kind, float* scr, int item, int lane) {
    const int nblk = N / 32, kb = item / nblk, nb = item % nblk, k0 = 64 * kb, n0 = 32 * nb;
#pragma unroll 8
    for (int i = 0; i < 32; ++i) { const int kk = 2 * i + (lane >> 5); float v = W[(size_t)(k0 + kk) * N + n0 + (lane & 31)]; if (gain) v *= gain[k0 + kk]; scr[kk * 33 + (lane & 31)] = v; }
    __builtin_amdgcn_s_waitcnt(0); asm volatile("" ::: "memory");
    const int c = lane & 7;
#pragma unroll
    for (int j = 0; j < 4; ++j) { const int n = (lane >> 3) + 8 * j; const float* s = scr + (8 * c) * 33 + n;
        u32x4 o; o.x = pk2(s[0 * 33], s[1 * 33]); o.y = pk2(s[2 * 33], s[3 * 33]); o.z = pk2(s[4 * 33], s[5 * 33]); o.w = pk2(s[6 * 33], s[7 * 33]);
        const int dr = kind == 0 ? row_off + n0 + n : uq_dest(n0 + n);
        *(u32x4*)(WT + (size_t)dr * K + k0 + 8 * c) = o; }
    __builtin_amdgcn_s_waitcnt(0); asm volatile("" ::: "memory");
}
DI void p0_prologue(const Ctx& C) {
    float* scr = (float*)(C.lds + C.wave * 16384);
    const int gw = C.blk * NWAVE + C.wave, NGW = C.G * NWAVE, gt = C.blk * NTHR + C.tid, NGT = C.G * NTHR;
    constexpr int I_IN = 16 * 53, I_UQ = 4 * 24, I_UK = 2 * 16, I_OUT = 16 * 32, I_UPN = 16 * 128, I_DNN = 64 * 32, I_GL = 4 * 8;
    constexpr int PER_L = I_IN + I_UQ + 2 * I_UK + I_OUT + I_UPN + I_DNN + I_GL;
    for (int it = gw; it < 2 * PER_L; it += NGW) {
        const int l = it / PER_L; int r = it - l * PER_L;
        if (r < I_IN) { p0_transpose_item(C.in[I_WIN] + (size_t)l * 1024 * INW, 1024, INW, C.in[I_N1G] + l * 1024, C.wgt(l, W_IN), 0, 0, scr, r, C.lane); continue; } r -= I_IN;
        if (r < I_UQ) { p0_transpose_item(C.in[I_WUQ] + (size_t)l * 256 * 768, 256, 768, C.in[I_QNG] + l * 256, C.wgt(l, W_UQ), 0, 1, scr, r, C.lane); continue; } r -= I_UQ;
        if (r < I_UK) { p0_transpose_item(C.in[I_WUK] + (size_t)l * 128 * 512, 128, 512, C.in[I_KVNG] + l * 128, C.wgt(l, W_KV), 0, 0, scr, r, C.lane); continue; } r -= I_UK;
        if (r < I_UK) { p0_transpose_item(C.in[I_WUV] + (size_t)l * 128 * 512, 128, 512, C.in[I_KVNG] + l * 128, C.wgt(l, W_KV), 512, 0, scr, r, C.lane); continue; } r -= I_UK;
        if (r < I_OUT) { p0_transpose_item(C.in[I_WOUT] + (size_t)l * 1024 * 1024, 1024, 1024, C.in[I_ONG] + l * 1024, C.wgt(l, W_OUT), 0, 0, scr, r, C.lane); continue; } r -= I_OUT;
        if (r < I_UPN) { p0_transpose_item(C.in[I_WUP] + (size_t)l * 1024 * 4096, 1024, 4096, C.in[I_N2G] + l * 1024, C.wgt(l, W_UP), 0, 0, scr, r, C.lane); continue; } r -= I_UPN;
        if (r < I_DNN) { p0_transpose_item(C.in[I_WDN] + (size_t)l * 4096 * 1024, 4096, 1024, nullptr, C.wgt(l, W_DN), 0, 0, scr, r, C.lane); continue; } r -= I_DNN;
        p0_transpose_item(C.in[I_WGLU] + (size_t)l * 256 * 256, 256, 256, nullptr, C.wgt(l, W_GLU), 0, 0, scr, r, C.lane);
    }
    for (int i = gt; i < 2 * 96 * 1024 / 8; i += NGT) { const int l = i / (96 * 128), r = i - l * (96 * 128); *(u32x4*)(C.wgt(l, W_IN) + (size_t)INW * 1024 + (size_t)r * 8) = (u32x4){0u, 0u, 0u, 0u}; }
    for (int i = gt; i < 2 * 32 * 64 * 160 / 8; i += NGT) *(u32x4*)(C.KCN() + (size_t)i * 8) = (u32x4){0u, 0u, 0u, 0u};
    float* X = C.out + O_X; bf16* XB = C.XB(); float* sq = C.ssq(SQ_X0);
    for (int m = gw; m < T; m += NGW) {
        const float* src = m < TP ? C.in[I_XP] + (size_t)m * DM : C.in[I_XS] + (size_t)(m - TP) * DM; float s = 0.f;
#pragma unroll
        for (int j = 0; j < 4; ++j) { const f32x4 v = *(const f32x4*)(src + 256 * j + 4 * C.lane); *(f32x4*)(X + (size_t)m * DM + 256 * j + 4 * C.lane) = v;
            u32x2 w; w.x = pk2(v[0], v[1]); w.y = pk2(v[2], v[3]); *(u32x2*)(XB + (size_t)m * DM + 256 * j + 4 * C.lane) = w; s += (v[0] * v[0] + v[1] * v[1]) + (v[2] * v[2] + v[3] * v[3]); }
        s = wave_sum(s); if (C.lane == 0) sq[m] = s;
    }
    for (int i = gt; i < 2 * 16 * 64; i += NGT) {
        const int l = i >> 10, g = (i >> 6) & 15;
        const float dt = expf(C.in[I_LDT][l * 16 + g]), lr = C.in[I_LRE][i], li = C.in[I_LIM][i];
        const float mag = expf(lr * dt); float sn, cs; sincosf(li * dt, &sn, &cs); const float abr = mag * cs, abi = mag * sn;
        const float den = lr * lr + li * li, ir = lr / den, ii = -li / den;
        const float zr = (abr - 1.f) * ir - abi * ii, zi = (abr - 1.f) * ii + abi * ir;
        float* AB = C.misc(M_AB); AB[2 * i] = abr; AB[2 * i + 1] = abi;
        float* BR = C.misc(M_BBRE) + (size_t)i * 16; float* BI = C.misc(M_BBIM) + (size_t)i * 16;
        for (int h = 0; h < 16; ++h) { const float br = C.in[I_BRE][(size_t)i * 16 + h], bi = C.in[I_BIM][(size_t)i * 16 + h]; BR[h] = zr * br - zi * bi; BI[h] = zr * bi + zi * br; }
    }
    for (int i = gt; i < 256; i += NGT) { const float a = C.in[I_LBL][i], b = C.in[I_LBL][256 + i]; const float mx = fmaxf(a, b), ea = expf(a - mx), eb = expf(b - mx);
        C.misc(M_LB)[i] = 0.f; C.misc(M_LB)[256 + i] = eb / (ea + eb); }
    for (int i = gt; i < 16384 * 16; i += NGT) { const int pos = i >> 4, k = i & 15; const double inv = pow(10000.0, -(double)k / 16.0); const double a = (double)pos * inv;
        C.misc(M_COS)[i] = (float)cos(a); C.misc(M_SIN)[i] = (float)sin(a); }
}

DI void misc_rows(const Ctx& C, int l) {
    const int gw = C.blk * NWAVE + C.wave, NGW = C.G * NWAVE; const bf16* P = C.PROJ(); const float* sq = C.ssq(SQ_KVA + l);
    const float* g = C.in[I_KVNG] + l * 128; const float* cs = C.misc(M_COS); const float* sn = C.misc(M_SIN);
    for (int m = gw; m < T; m += NGW) {
        const float r = rsqrtf(sq[m] * (1.f / 128.f) + EPS); const int lane = C.lane;
        const unsigned w = *(const unsigned*)(P + (size_t)m * INP + C_CKV + 2 * lane);
        const float c0 = bflo(w) * r * g[2 * lane], c1 = bfhi(w) * r * g[2 * lane + 1];
        float k1 = 0.f, k2 = 0.f;
        if (lane < 16) { const float x1 = bf2f(P[(size_t)m * INP + C_KPE + lane]), x2 = bf2f(P[(size_t)m * INP + C_KPE + 16 + lane]); const int pos = pos_of_row(m);
            const float c = cs[pos * 16 + lane], s = sn[pos * 16 + lane]; k1 = x1 * c - x2 * s; k2 = x2 * c + x1 * s; }
        if (m < TP) {
            float* okv = C.out + O_PKV + ((size_t)l * TP + m) * 128; *(f32x2_t*)(okv + 2 * lane) = (f32x2_t){c0, c1};
            if (lane < 16) { float* ope = C.out + O_PPE + ((size_t)l * TP + m) * 32; ope[lane] = k1; ope[16 + lane] = k2; bf16* kb = C.KPEB() + (size_t)m * 32; kb[lane] = f2bf(k1); kb[16 + lane] = f2bf(k2); }
        } else {
            const int bi = m - TP, b = bi >> 4, i = bi & 15;
            float* okv = C.out + O_SKV + ((size_t)l * TS + bi) * 128; *(f32x2_t*)(okv + 2 * lane) = (f32x2_t){c0, c1};
            bf16* kc = C.KCN() + ((size_t)(l * 32 + b) * 64 + i) * 160; *(unsigned*)(kc + 2 * lane) = pk2(c0, c1);
            if (lane < 16) { float* ope = C.out + O_SPE + ((size_t)l * TS + bi) * 32; ope[lane] = k1; ope[16 + lane] = k2; kc[128 + lane] = f2bf(k1); kc[144 + lane] = f2bf(k2); }
        }
    }
}

constexpr int S5_UP = 528, S5_HP = 272, S5_HS = 33792;
template <bool FINAL> DI void s5_item(const Ctx& C, int l, int ci) {
    const int lane = C.lane, w = C.wave, r = lane & 31, h = lane >> 5;
    const bool samp = ci >= 256; const int b = ci - 256; const int row0 = samp ? TP + b * 16 : ci * 64; const int ntok = samp ? 16 : 64;
    char* UZ = C.lds; char* HS = C.lds + S5_HS + w * (32 * S5_HP);
    const bf16* P = C.PROJ();
    for (int i = C.tid; i < 2048; i += NTHR) { const int t = i >> 5, c8 = i & 31; u32x4 v = (u32x4){0u, 0u, 0u, 0u}; if (t < ntok) v = *(const u32x4*)(P + (size_t)(row0 + t) * INP + c8 * 8); *(u32x4*)(UZ + t * S5_UP + c8 * 16) = v; }
    __syncthreads();
    for (int gi = 0; gi < 2; ++gi) {
        const int g = 2 * w + gi; const int sidx = (l * 16 + g) * 64 + lane;
        float bbr[16], bbi[16];
        { const float* BR = C.misc(M_BBRE) + (size_t)sidx * 16; const float* BI = C.misc(M_BBIM) + (size_t)sidx * 16;
#pragma unroll
          for (int q = 0; q < 4; ++q) { const f32x4 a = *(const f32x4*)(BR + 4 * q), c = *(const f32x4*)(BI + 4 * q);
#pragma unroll
              for (int e = 0; e < 4; ++e) { bbr[4 * q + e] = a[e]; bbi[4 * q + e] = c[e]; } } }
        const float abr = C.misc(M_AB)[2 * sidx], abi = C.misc(M_AB)[2 * sidx + 1];
        float hr = 0.f, hi = 0.f;
        if (FINAL) {
            if (samp) { hr = C.in[I_S5RE][((size_t)(l * 32 + b) * 16 + g) * 64 + lane]; hi = C.in[I_S5IM][((size_t)(l * 32 + b) * 16 + g) * 64 + lane]; }
            else { float pr = abr, pi = abi;
#pragma unroll
                for (int q = 0; q < 6; ++q) { const float nr = pr * pr - pi * pi, ni = 2.f * pr * pi; pr = nr; pi = ni; }
                const float* E = C.E5() + ((size_t)g * 64 + lane) * 2;
                for (int c = 0; c < ci; ++c) { const f32x2_t e = *(const f32x2_t*)(E + (size_t)c * 2048); const float nr = pr * hr - pi * hi + e.x, ni = pr * hi + pi * hr + e.y; hr = nr; hi = ni; } }
        }
        bf16x8 cf[8];
        if (FINAL) {
#pragma unroll
            for (int ks = 0; ks < 8; ++ks) { f32x4 a = (f32x4){0.f, 0.f, 0.f, 0.f}, c = a;
                if (r < 16) { const float* src = (ks < 4 ? C.in[I_CRE] : C.in[I_CIM]) + ((size_t)(l * 16 + g) * 16 + r) * 64 + 16 * (ks & 3) + 8 * h; a = *(const f32x4*)src; c = *(const f32x4*)(src + 4); if (ks >= 4) { a = -a; c = -c; } }
                cf[ks] = packf8(a[0], a[1], a[2], a[3], c[0], c[1], c[2], c[3]); }
        }
        const float dch = (FINAL && r < 16) ? C.in[I_S5D][l * 256 + g * 16 + r] : 0.f;
        for (int half = 0; half < 2; ++half) {
            if (half * 32 >= ntok) break;
            for (int tt = 0; tt < 32; ++tt) {
                const int t = half * 32 + tt;
                if (t < ntok) {
                    const u32x4 u0 = *(const u32x4*)(UZ + t * S5_UP + g * 32), u1 = *(const u32x4*)(UZ + t * S5_UP + g * 32 + 16);
                    float uu[16]; uu[0] = bflo(u0.x); uu[1] = bfhi(u0.x); uu[2] = bflo(u0.y); uu[3] = bfhi(u0.y); uu[4] = bflo(u0.z); uu[5] = bfhi(u0.z); uu[6] = bflo(u0.w); uu[7] = bfhi(u0.w);
                    uu[8] = bflo(u1.x); uu[9] = bfhi(u1.x); uu[10] = bflo(u1.y); uu[11] = bfhi(u1.y); uu[12] = bflo(u1.z); uu[13] = bfhi(u1.z); uu[14] = bflo(u1.w); uu[15] = bfhi(u1.w);
                    float br = 0.f, bi = 0.f;
#pragma unroll
                    for (int q = 0; q < 16; ++q) { br += bbr[q] * uu[q]; bi += bbi[q] * uu[q]; }
                    const float nr = abr * hr - abi * hi + br, ni = abr * hi + abi * hr + bi; hr = nr; hi = ni;
                }
                if (FINAL) { *(bf16*)(HS + tt * S5_HP + lane * 2) = f2bf(hr); *(bf16*)(HS + tt * S5_HP + 128 + lane * 2) = f2bf(hi); }
            }
            if (FINAL) {
                f32x16 acc = {};
#pragma unroll
                for (int ks = 0; ks < 8; ++ks) acc = MFMA32(lds16(HS + r * S5_HP + (16 * ks + 8 * h) * 2), cf[ks], acc);
                if (r < 16) { const int ch = g * 16 + r;
#pragma unroll
                    for (int i = 0; i < 16; ++i) { const int t = half * 32 + crow(i, h);
                        if (t < ntok) { bf16* zp = (bf16*)(UZ + t * S5_UP + ch * 2); const float y = acc[i] + dch * bf2f(*zp);
                            const float a = 0.7978845608f * (y + 0.044715f * y * y * y); const float th = 1.f - 2.f / (1.f + __expf(2.f * a)); *zp = f2bf(0.5f * y * (1.f + th)); } } }
            }
        }
        if (FINAL) {
            if (samp) { C.out[O_SRE + ((size_t)(l * 32 + b) * 16 + g) * 64 + lane] = hr; C.out[O_SIM + ((size_t)(l * 32 + b) * 16 + g) * 64 + lane] = hi; }
            else if (ci == 255) { C.out[O_PRE + ((size_t)l * 16 + g) * 64 + lane] = hr; C.out[O_PIM + ((size_t)l * 16 + g) * 64 + lane] = hi; }
        } else { *(f32x2_t*)(C.E5() + ((size_t)ci * 1024 + g * 64 + lane) * 2) = (f32x2_t){hr, hi}; }
    }
    if (FINAL) {
        __syncthreads();
        f32x16 ga[2] = {{}, {}};
        const bf16* WG = C.wgt(l, W_GLU);
#pragma unroll 4
        for (int ks = 0; ks < 16; ++ks) { const bf16x8 bfr = *(const bf16x8*)(WG + (size_t)(32 * w + r) * 256 + 16 * ks + 8 * h);
            ga[0] = MFMA32(lds16(UZ + r * S5_UP + (16 * ks + 8 * h) * 2), bfr, ga[0]); ga[1] = MFMA32(lds16(UZ + (32 + r) * S5_UP + (16 * ks + 8 * h) * 2), bfr, ga[1]); }
        __syncthreads();
        const int n = 32 * w + r; const float bg = C.in[I_BGLU][l * 256 + n];
#pragma unroll
        for (int rb = 0; rb < 2; ++rb)
#pragma unroll
            for (int i = 0; i < 16; ++i) { const int t = 32 * rb + crow(i, h); bf16* zp = (bf16*)(UZ + t * S5_UP + n * 2); const float z = bf2f(*zp); *zp = f2bf(z * sigmoidf_(ga[rb][i] + bg)); }
        __syncthreads();
        { const int t = C.tid >> 3, s8 = C.tid & 7; float v[32]; float s = 0.f;
#pragma unroll
          for (int q = 0; q < 4; ++q) { const u32x4 u = *(const u32x4*)(UZ + t * S5_UP + s8 * 64 + q * 16);
              v[8 * q] = bflo(u.x); v[8 * q + 1] = bfhi(u.x); v[8 * q + 2] = bflo(u.y); v[8 * q + 3] = bfhi(u.y); v[8 * q + 4] = bflo(u.z); v[8 * q + 5] = bfhi(u.z); v[8 * q + 6] = bflo(u.w); v[8 * q + 7] = bfhi(u.w); }
#pragma unroll
          for (int q = 0; q < 32; ++q) s += v[q] * v[q];
          s += __shfl_xor(s, 1); s += __shfl_xor(s, 2); s += __shfl_xor(s, 4);
          const float rn = rsqrtf(s * (1.f / 256.f) + EPS);
          if (t < ntok) { bf16* dst = C.MIX() + (size_t)(row0 + t) * DM + s8 * 32;
#pragma unroll
              for (int q = 0; q < 4; ++q) { u32x4 o; o.x = pk2(v[8 * q] * rn, v[8 * q + 1] * rn); o.y = pk2(v[8 * q + 2] * rn, v[8 * q + 3] * rn); o.z = pk2(v[8 * q + 4] * rn, v[8 * q + 5] * rn); o.w = pk2(v[8 * q + 6] * rn, v[8 * q + 7] * rn);
                  *(u32x4*)(dst + 8 * q) = o; } } }
    }
    __syncthreads();
}

constexpr int HG_P = 136, HG_WB = 2 * 64 * HG_P;
DI void hgrn_local(const Ctx& C, int l, int it) {
    const int lane = C.lane, r = lane & 31, h = lane >> 5; const int ci = it >> 2, hd = it & 3;
    const bool samp = ci >= 256; const int row0 = samp ? TP + (ci - 256) * 16 : ci * 64; const int ntok = samp ? 16 : 64, tref = (ntok >> 1) - 1;
    char* KT = C.lds + C.wave * HG_WB; char* VT = KT + 64 * HG_P; bf16* P = C.PROJ();
    const float lb = C.misc(M_LB)[l * 256 + hd * 64 + lane], omlb = 1.f - lb;
    float b = 0.f, bref = 0.f;
    for (int t = 0; t < ntok; ++t) { const float fp = bf2f(P[(size_t)(row0 + t) * INP + C_HF + hd * 64 + lane]); const float f = lb + omlb * sigmoidf_(fp); b += __logf(f); if (t == tref) bref = b; }
    const float blast = b; b = 0.f;
    for (int t = 0; t < 64; ++t) {
        float qt = 0.f, kt = 0.f, vv = 0.f;
        if (t < ntok) { bf16* pq = P + (size_t)(row0 + t) * INP + C_HQ + hd * 64 + lane; bf16* pf = P + (size_t)(row0 + t) * INP + C_HF + hd * 64 + lane;
            const float fp = bf2f(*pf), hq = bf2f(*pq); const float sg = sigmoidf_(fp); const float f = lb + omlb * sg; b += __logf(f);
            qt = hq * sigmoidf_(hq) * __expf(b - bref); kt = omlb * (1.f - sg) * __expf(bref - b);
            *pq = f2bf(qt); *pf = f2bf(kt); vv = bf2f(P[(size_t)(row0 + t) * INP + C_HI + hd * 64 + lane]); }
        *(bf16*)(KT + lane * HG_P + t * 2) = f2bf(kt); *(bf16*)(VT + lane * HG_P + t * 2) = f2bf(vv);
    }
    C.DD()[(size_t)ci * 256 + hd * 64 + lane] = __expf(blast); C.EBM()[(size_t)ci * 256 + hd * 64 + lane] = __expf(bref);
    const float scg = __expf(blast - bref);
    f32x16 acc[2][2] = {{{}, {}}, {{}, {}}};
#pragma unroll
    for (int ks = 0; ks < 4; ++ks) { bf16x8 a[2], bb[2];
#pragma unroll
        for (int q = 0; q < 2; ++q) { a[q] = lds8x2(VT + (32 * q + r) * HG_P + (16 * ks + 8 * h) * 2); bb[q] = lds8x2(KT + (32 * q + r) * HG_P + (16 * ks + 8 * h) * 2); }
#pragma unroll
        for (int vb = 0; vb < 2; ++vb)
#pragma unroll
            for (int db = 0; db < 2; ++db) acc[vb][db] = MFMA32(a[vb], bb[db], acc[vb][db]); }
    float* G = C.GT() + ((size_t)ci * 4 + hd) * 4096;
#pragma unroll
    for (int db = 0; db < 2; ++db) { const float sc = __shfl(scg, 32 * db + r);
#pragma unroll
        for (int vb = 0; vb < 2; ++vb)
#pragma unroll
            for (int i = 0; i < 16; ++i) G[(32 * vb + crow(i, h)) * 64 + 32 * db + r] = acc[vb][db][i] * sc; }
}
DI void hgrn_prefix(const Ctx& C, int l) {
    const int e = C.blk * NTHR + C.tid;
    if (e < 16384) { const int hd = e >> 12, vd = e & 4095, d = vd & 63, v = vd >> 6; float* G = C.GT() + (size_t)hd * 4096 + vd; const float* D = C.DD() + hd * 64 + d; float S = 0.f;
        for (int c0 = 0; c0 < 256; c0 += 16) { float g[16], dd[16];
#pragma unroll
            for (int q = 0; q < 16; ++q) { g[q] = G[(size_t)(c0 + q) * 16384]; dd[q] = D[(size_t)(c0 + q) * 256]; }
#pragma unroll
            for (int q = 0; q < 16; ++q) { G[(size_t)(c0 + q) * 16384] = S; S = dd[q] * S + g[q]; } }
        C.out[O_PHG + (size_t)l * 16384 + hd * 4096 + d * 64 + v] = S; }
    for (int i = e; i < 32 * 16384; i += C.G * NTHR) { const int b = i >> 14, hv = i & 16383, hd = hv >> 12, vd = hv & 4095, d = vd & 63, v = vd >> 6;
        const float S0 = C.in[I_SHG][((size_t)(l * 32 + b) * 4 + hd) * 4096 + d * 64 + v]; float* G = C.GT() + (size_t)(256 + b) * 16384 + hv;
        const float S1 = C.DD()[(size_t)(256 + b) * 256 + hd * 64 + d] * S0 + *G; *G = S0; C.out[O_SHG + ((size_t)(l * 32 + b) * 4 + hd) * 4096 + d * 64 + v] = S1; }
}
DI void hgrn_final(const Ctx& C, int l, int bi) {
    const int lane = C.lane, r = lane & 31, h = lane >> 5; const int it = bi * 8 + C.wave, ci = it >> 2, hd = it & 3;
    const bool samp = ci >= 256; const int row0 = samp ? TP + (ci - 256) * 16 : ci * 64; const int ntok = samp ? 16 : 64;
    char* VT = C.lds + C.wave * HG_WB; float* SS = (float*)(C.lds + 8 * HG_WB); const bf16* P = C.PROJ();
    for (int t = 0; t < 64; ++t) { float vv = 0.f; if (t < ntok) vv = bf2f(P[(size_t)(row0 + t) * INP + C_HI + hd * 64 + lane]); *(bf16*)(VT + lane * HG_P + t * 2) = f2bf(vv); }
    bf16x8 qf[2][4];
    f32x16 at[2][2] = {{{}, {}}, {{}, {}}};
    const bf16x8 zf = {0, 0, 0, 0, 0, 0, 0, 0};
#pragma unroll
    for (int ks = 0; ks < 4; ++ks) { bf16x8 kf[2];
#pragma unroll
        for (int q = 0; q < 2; ++q) { const int t = 32 * q + r; const bool ok = t < ntok;
            qf[q][ks] = ok ? *(const bf16x8*)(P + (size_t)(row0 + t) * INP + C_HQ + hd * 64 + 16 * ks + 8 * h) : zf;
            kf[q] = ok ? *(const bf16x8*)(P + (size_t)(row0 + t) * INP + C_HF + hd * 64 + 16 * ks + 8 * h) : zf; }
        at[0][0] = MFMA32(kf[0], qf[0][ks], at[0][0]); at[0][1] = MFMA32(kf[0], qf[1][ks], at[0][1]); at[1][1] = MFMA32(kf[1], qf[1][ks], at[1][1]); }
#pragma unroll
    for (int i = 0; i < 16; ++i) { const int s = crow(i, h); if (s > r) { at[0][0][i] = 0.f; at[1][1][i] = 0.f; } }
    f32x16 o[2][2] = {{{}, {}}, {{}, {}}};
#pragma unroll
    for (int sb = 0; sb < 2; ++sb)
#pragma unroll
        for (int tb = sb; tb < 2; ++tb)
#pragma unroll
            for (int s2 = 0; s2 < 2; ++s2) { const f32x16& x = at[sb][tb];
                const bf16x8 pkx = packf8(x[8 * s2], x[8 * s2 + 1], x[8 * s2 + 2], x[8 * s2 + 3], x[8 * s2 + 4], x[8 * s2 + 5], x[8 * s2 + 6], x[8 * s2 + 7]);
#pragma unroll
                for (int vb = 0; vb < 2; ++vb) { const char* vp = VT + (32 * vb + r) * HG_P + (32 * sb + 16 * s2 + 4 * h) * 2;
                    const s16x4 lo = *(const s16x4*)vp, hi = *(const s16x4*)(vp + 16); const bf16x8 a2 = __builtin_shufflevector(lo, hi, 0, 1, 2, 3, 4, 5, 6, 7);
                    o[vb][tb] = MFMA32(a2, pkx, o[vb][tb]); } }
    { const float* S = C.GT() + ((size_t)ci * 4 + hd) * 4096; const float* EB = C.EBM() + (size_t)ci * 256 + hd * 64;
#pragma unroll
      for (int ks = 0; ks < 4; ++ks) { const f32x4 e0 = *(const f32x4*)(EB + 16 * ks + 8 * h), e1 = *(const f32x4*)(EB + 16 * ks + 8 * h + 4);
#pragma unroll
          for (int vb = 0; vb < 2; ++vb) { const float* sp = S + (32 * vb + r) * 64 + 16 * ks + 8 * h; const f32x4 s0 = *(const f32x4*)sp * e0, s1 = *(const f32x4*)(sp + 4) * e1;
              const bf16x8 sf = packf8(s0[0], s0[1], s0[2], s0[3], s1[0], s1[1], s1[2], s1[3]);
              o[vb][0] = MFMA32(sf, qf[0][ks], o[vb][0]); o[vb][1] = MFMA32(sf, qf[1][ks], o[vb][1]); } } }
    float sq[2];
#pragma unroll
    for (int tb = 0; tb < 2; ++tb) { float s = 0.f;
#pragma unroll
        for (int vb = 0; vb < 2; ++vb)
#pragma unroll
            for (int i = 0; i < 16; ++i) s += o[vb][tb][i] * o[vb][tb][i];
        s += __shfl_xor(s, 32); sq[tb] = s; if (h == 0) SS[C.wave * 64 + 32 * tb + r] = s; }
    __syncthreads();
    const int wb = C.wave & 4;
#pragma unroll
    for (int tb = 0; tb < 2; ++tb) { const int t = 32 * tb + r; const float tot = SS[(wb + 0) * 64 + t] + SS[(wb + 1) * 64 + t] + SS[(wb + 2) * 64 + t] + SS[(wb + 3) * 64 + t];
        const float rn = rsqrtf(tot * (1.f / 256.f) + EPS);
        if (t < ntok) {
#pragma unroll
            for (int vb = 0; vb < 2; ++vb)
#pragma unroll
                for (int g4 = 0; g4 < 4; ++g4) { const int v = 32 * vb + 8 * g4 + 4 * h; const u32x2 gw = *(const u32x2*)(P + (size_t)(row0 + t) * INP + C_HG + hd * 64 + v);
                    const float g0 = bflo(gw.x), g1 = bfhi(gw.x), g2 = bflo(gw.y), g3 = bfhi(gw.y);
                    u32x2 ow; ow.x = pk2(o[vb][tb][4 * g4] * rn * g0 * sigmoidf_(g0), o[vb][tb][4 * g4 + 1] * rn * g1 * sigmoidf_(g1)); ow.y = pk2(o[vb][tb][4 * g4 + 2] * rn * g2 * sigmoidf_(g2), o[vb][tb][4 * g4 + 3] * rn * g3 * sigmoidf_(g3));
                    *(u32x2*)(C.MIX() + (size_t)(row0 + t) * DM + 256 + hd * 64 + v) = ow; } } }
    __syncthreads();
}

#ifndef ATT_VTRANS
#define ATT_VTRANS 0
#endif
constexpr int AT_VB = 21504, AT_QS = 32768, AT_OLP = 132;
template <bool SAMPLE> DI void attn_unit(const Ctx& C, int l, int hd_or_b, int qb) {
    constexpr int DQK = SAMPLE ? 160 : 96, DV = SAMPLE ? 128 : 64, KP = SAMPLE ? 336 : 208, VP = SAMPLE ? 336 : 144, NKS = DQK / 16, NVB = DV / 32;
    const int tid = C.tid, lane = C.lane, w = C.wave, r = lane & 31, h = lane >> 5;
    constexpr bool VTR = (!SAMPLE) && (ATT_VTRANS != 0);
    char* KB = C.lds; char* VB = SAMPLE ? C.lds : C.lds + AT_VB; char* QS = C.lds + AT_QS;
    const int ntiles = SAMPLE ? 33 : 4 * qb + 4;
    const int q0 = SAMPLE ? 0 : qb * 256;
    const bool wave_on = SAMPLE ? (w < 4) : true;
    const int wchunk = SAMPLE ? 1000 : 4 * qb + (w >> 1);
    bf16x8 qf[SAMPLE ? 1 : NKS];
    const bf16* KVF = C.KVF(); const bf16* KPE = C.KPEB();
    const float* ckv = SAMPLE ? C.in[I_CKV] + (size_t)(l * 32 + hd_or_b) * PAST * 128 : nullptr;
    const float* cpe = SAMPLE ? C.in[I_CPE] + (size_t)(l * 32 + hd_or_b) * PAST * 32 : nullptr;
    const bf16* kcn = SAMPLE ? C.KCN() + (size_t)(l * 32 + hd_or_b) * 64 * 160 : nullptr;
    u32x4 st0, st1, st2; f32x4 sf[5];
#define AT_PREFETCH(j) do { \
        if (!SAMPLE) { \
            const int key = tm >> 3, part = tm & 7; const size_t row = (size_t)(64 * (j) + key); \
            st0 = *(const u32x4*)(KVF + row * 1024 + hd_or_b * 64 + part * 8); \
            st1 = *(const u32x4*)(KVF + row * 1024 + 512 + hd_or_b * 64 + part * 8); \
            if (tm < 256) st2 = *(const u32x4*)(KPE + (size_t)(64 * (j) + (tm >> 2)) * 32 + (tm & 3) * 8); \
        } else if ((j) < 32) { \
            _Pragma("unroll") \
            for (int i = 0; i < 4; ++i) { const int idx = tm + 512 * i; sf[i] = *(const f32x4*)(ckv + (size_t)(64 * (j) + (idx >> 5)) * 128 + (idx & 31) * 4); } \
            sf[4] = *(const f32x4*)(cpe + (size_t)(64 * (j) + (tm >> 3)) * 32 + (tm & 7) * 4); \
        } else { \
            st0 = *(const u32x4*)(kcn + (size_t)tm * 8); st1 = *(const u32x4*)(kcn + (size_t)(tm + 512) * 8); if (tm < 256) st2 = *(const u32x4*)(kcn + (size_t)(tm + 1024) * 8); \
        } \
    } while (0)
#define AT_COMMIT(j) do { \
        if (!SAMPLE) { \
            const int key = tm >> 3, part = tm & 7; \
            *(u32x4*)(KB + key * KP + part * 16) = st0; \
            if (VTR) { _Pragma("unroll") for (int e_ = 0; e_ < 4; ++e_) { *(bf16*)(VB + (part * 8 + 2 * e_) * 136 + key * 2) = (bf16)(st1[e_] & 0xffffu); *(bf16*)(VB + (part * 8 + 2 * e_ + 1) * 136 + key * 2) = (bf16)(st1[e_] >> 16); } } \
            else *(u32x4*)(VB + key * VP + part * 16) = st1; \
            if (tm < 256) *(u32x4*)(KB + (tm >> 2) * KP + 128 + (tm & 3) * 16) = st2; \
        } else if ((j) < 32) { \
            _Pragma("unroll") \
            for (int i = 0; i < 4; ++i) { const int idx = tm + 512 * i; u32x2 wv; wv.x = pk2(sf[i][0], sf[i][1]); wv.y = pk2(sf[i][2], sf[i][3]); *(u32x2*)(KB + (idx >> 5) * KP + (idx & 31) * 8) = wv; } \
            { u32x2 wv; wv.x = pk2(sf[4][0], sf[4][1]); wv.y = pk2(sf[4][2], sf[4][3]); *(u32x2*)(KB + (tm >> 3) * KP + 256 + (tm & 7) * 8) = wv; } \
        } else { \
            { const int c = tm; *(u32x4*)(KB + (c / 20) * KP + (c % 20) * 16) = st0; } \
            { const int c = tm + 512; *(u32x4*)(KB + (c / 20) * KP + (c % 20) * 16) = st1; } \
            if (tm < 256) { const int c = tm + 1024; *(u32x4*)(KB + (c / 20) * KP + (c % 20) * 16) = st2; } \
        } \
    } while (0)
    int tm = tid;
    if (!SAMPLE) AT_PREFETCH(0);
    if (SAMPLE) {
        const int R = tid >> 2, part = tid & 3, hh = R >> 4, i = R & 15; const bf16* qrow = C.QF() + (size_t)(TP + hd_or_b * 16 + i) * 768 + hh * 96;
        float* QN = (float*)(C.lds + 76800) + R * 64;
        { const u32x4 u0 = *(const u32x4*)(qrow + part * 16), u1 = *(const u32x4*)(qrow + part * 16 + 8);
          *(f32x4*)(QN + part * 16) = (f32x4){bflo(u0.x), bfhi(u0.x), bflo(u0.y), bfhi(u0.y)}; *(f32x4*)(QN + part * 16 + 4) = (f32x4){bflo(u0.z), bfhi(u0.z), bflo(u0.w), bfhi(u0.w)};
          *(f32x4*)(QN + part * 16 + 8) = (f32x4){bflo(u1.x), bfhi(u1.x), bflo(u1.y), bfhi(u1.y)}; *(f32x4*)(QN + part * 16 + 12) = (f32x4){bflo(u1.z), bfhi(u1.z), bflo(u1.w), bfhi(u1.w)}; }
        __syncthreads();
        const float* wuk = C.in[I_WUK] + (size_t)l * 128 * 512 + hh * 64;
#pragma unroll 1
        for (int cc = 0; cc < 32; cc += 2) { float a0 = 0.f, a1 = 0.f; const float* w0 = wuk + (size_t)(part * 32 + cc) * 512; const float* w1 = w0 + 512;
#pragma unroll 2
            for (int q = 0; q < 16; ++q) { const f32x4 qv = *(const f32x4*)(QN + 4 * q); const f32x4 x0 = *(const f32x4*)(w0 + 4 * q), x1 = *(const f32x4*)(w1 + 4 * q);
                a0 += qv[0] * x0[0] + qv[1] * x0[1] + qv[2] * x0[2] + qv[3] * x0[3]; a1 += qv[0] * x1[0] + qv[1] * x1[1] + qv[2] * x1[2] + qv[3] * x1[3]; }
            *(unsigned*)(QS + R * 336 + (part * 32 + cc) * 2) = pk2(a0, a1); }
        if (part < 2) { const int pos = PAST + i; const float* cs = C.misc(M_COS) + pos * 16 + 8 * part; const float* sn = C.misc(M_SIN) + pos * 16 + 8 * part;
            const u32x4 x1 = *(const u32x4*)(qrow + 64 + part * 8), x2 = *(const u32x4*)(qrow + 80 + part * 8); u32x4 y1, y2;
#pragma unroll
            for (int e = 0; e < 4; ++e) { const float a0 = bflo(x1[e]), a1 = bfhi(x1[e]), b0 = bflo(x2[e]), b1 = bfhi(x2[e]); const float c0 = cs[2 * e], c1 = cs[2 * e + 1], s0 = sn[2 * e], s1 = sn[2 * e + 1];
                y1[e] = pk2(a0 * c0 - b0 * s0, a1 * c1 - b1 * s1); y2[e] = pk2(b0 * c0 + a0 * s0, b1 * c1 + a1 * s1); }
            *(u32x4*)(QS + R * 336 + 256 + part * 16) = y1; *(u32x4*)(QS + R * 336 + 288 + part * 16) = y2; }
        __syncthreads();
    } else {
        const bf16* qrow = C.QF() + (size_t)(q0 + 32 * w + r) * 768 + hd_or_b * 96;
#pragma unroll
        for (int ks = 0; ks < NKS; ++ks) qf[ks] = *(const bf16x8*)(qrow + 16 * ks + 8 * h);
        { const int pos = q0 + 32 * w + r; const float* cs = C.misc(M_COS) + pos * 16 + 8 * h; const float* sn = C.misc(M_SIN) + pos * 16 + 8 * h;
          const u32x4 x1 = __builtin_bit_cast(u32x4, qf[4]), x2 = __builtin_bit_cast(u32x4, qf[5]); u32x4 y1, y2;
#pragma unroll
          for (int e = 0; e < 4; ++e) { const float a0 = bflo(x1[e]), a1 = bfhi(x1[e]), b0 = bflo(x2[e]), b1 = bfhi(x2[e]); const float c0 = cs[2 * e], c1 = cs[2 * e + 1], s0 = sn[2 * e], s1 = sn[2 * e + 1];
              y1[e] = pk2(a0 * c0 - b0 * s0, a1 * c1 - b1 * s1); y2[e] = pk2(b0 * c0 + a0 * s0, b1 * c1 + a1 * s1); }
          qf[4] = __builtin_bit_cast(bf16x8, y1); qf[5] = __builtin_bit_cast(bf16x8, y2); }
    }
    if (SAMPLE) { asm volatile("" : "+v"(tm)); AT_PREFETCH(0); }
    float mrun = -1e30f, lrun = 0.f; f32x16 o[NVB];
#pragma unroll
    for (int vb = 0; vb < NVB; ++vb) o[vb] = f32x16{};
    const int i16 = lane & 15, gg = (lane >> 4) & 1;
    const char* vlane = VB + (4 * h + (i16 >> 2)) * VP + (16 * gg + 4 * (i16 & 3)) * 2;
    for (int j = 0; j < ntiles; ++j) {
        __syncthreads();
        AT_COMMIT(j);
        __syncthreads();
        if (j + 1 < ntiles) AT_PREFETCH(j + 1);
        if (wave_on && j <= wchunk) {
            f32x16 p0 = {}, p1 = {};
#pragma unroll
            for (int ks = 0; ks < NKS; ++ks) { const bf16x8 qv = SAMPLE ? lds16(QS + (32 * w + r) * 336 + (16 * ks + 8 * h) * 2) : qf[ks]; p0 = MFMA32(lds16(KB + r * KP + (16 * ks + 8 * h) * 2), qv, p0); p1 = MFMA32(lds16(KB + (32 + r) * KP + (16 * ks + 8 * h) * 2), qv, p1); }
            if (SAMPLE && j == 32) {
#pragma unroll
                for (int i = 0; i < 16; ++i) { if (crow(i, h) >= 16) p0[i] = -1e30f; p1[i] = -1e30f; }
            }
            float mx = p0[0];
#pragma unroll
            for (int i = 1; i < 16; ++i) mx = fmaxf(mx, p0[i]);
#pragma unroll
            for (int i = 0; i < 16; ++i) mx = fmaxf(mx, p1[i]);
            mx = fmaxf(mx, __shfl_xor(mx, 32));
            const float mnew = fmaxf(mrun, mx), alpha = __builtin_amdgcn_exp2f(mrun - mnew); mrun = mnew;
            float ls = 0.f;
#pragma unroll
            for (int i = 0; i < 16; ++i) { p0[i] = __builtin_amdgcn_exp2f(p0[i] - mnew); p1[i] = __builtin_amdgcn_exp2f(p1[i] - mnew); ls += p0[i] + p1[i]; }
            lrun = lrun * alpha + ls;
#pragma unroll
            for (int vb = 0; vb < NVB; ++vb)
#pragma unroll
                for (int i = 0; i < 16; ++i) o[vb][i] *= alpha;
#pragma unroll
            for (int kb = 0; kb < 2; ++kb)
#pragma unroll
                for (int s2 = 0; s2 < 2; ++s2) { const f32x16& x = kb ? p1 : p0;
                    const bf16x8 pkx = packf8(x[8 * s2], x[8 * s2 + 1], x[8 * s2 + 2], x[8 * s2 + 3], x[8 * s2 + 4], x[8 * s2 + 5], x[8 * s2 + 6], x[8 * s2 + 7]);
#pragma unroll
                    for (int vb = 0; vb < NVB; ++vb) { const char* vp = vlane + (32 * kb + 16 * s2) * VP + 64 * vb;
                        s16x4 lo, hi; if (VTR) { const char* vq = VB + (32 * vb + r) * 136 + (32 * kb + 16 * s2 + 4 * h) * 2; lo = *(const s16x4*)vq; hi = *(const s16x4*)(vq + 16); } else { lo = ldtr(vp); hi = ldtr(vp + 8 * VP); }
                        const bf16x8 a2 = __builtin_shufflevector(lo, hi, 0, 1, 2, 3, 4, 5, 6, 7);
                        o[vb] = MFMA32(a2, pkx, o[vb]); }
                    asm volatile("" ::: "memory"); }
        }
    }
    lrun += __shfl_xor(lrun, 32); const float inv = 1.f / lrun;
    if (!SAMPLE) {
        const int row = q0 + 32 * w + r; float s = 0.f; bf16* dst = C.MIX() + (size_t)row * DM + 512 + hd_or_b * 64;
#pragma unroll
        for (int vb = 0; vb < NVB; ++vb)
#pragma unroll
            for (int g4 = 0; g4 < 4; ++g4) { const float a0 = o[vb][4 * g4] * inv, a1 = o[vb][4 * g4 + 1] * inv, a2 = o[vb][4 * g4 + 2] * inv, a3 = o[vb][4 * g4 + 3] * inv;
                s += (a0 * a0 + a1 * a1) + (a2 * a2 + a3 * a3); u32x2 ow; ow.x = pk2(a0, a1); ow.y = pk2(a2, a3); *(u32x2*)(dst + 32 * vb + 8 * g4 + 4 * h) = ow; }
        s += __shfl_xor(s, 32); if (h == 0) atomicAdd(C.ssq(SQ_MA + l) + row, s);
    } else {
        __syncthreads();
        float* OL = (float*)C.lds;
        if (wave_on) {
#pragma unroll
            for (int vb = 0; vb < NVB; ++vb)
#pragma unroll
                for (int i = 0; i < 16; ++i) OL[(32 * w + r) * AT_OLP + 32 * vb + crow(i, h)] = o[vb][i] * inv;
        }
        __syncthreads();
        const int R = tid >> 2, part = tid & 3, hh = R >> 4, i = R & 15; const int row = TP + hd_or_b * 16 + i;
        float acc[16];
#pragma unroll
        for (int q = 0; q < 16; ++q) acc[q] = 0.f;
        const float* wuv = C.in[I_WUV] + (size_t)l * 128 * 512 + hh * 64 + part * 16;
        for (int c = 0; c < 128; ++c) { const float ol = OL[R * AT_OLP + c];
#pragma unroll
            for (int q = 0; q < 4; ++q) { const f32x4 x = *(const f32x4*)(wuv + (size_t)c * 512 + 4 * q); acc[4 * q] += ol * x[0]; acc[4 * q + 1] += ol * x[1]; acc[4 * q + 2] += ol * x[2]; acc[4 * q + 3] += ol * x[3]; } }
        float s = 0.f;
#pragma unroll
        for (int q = 0; q < 16; ++q) s += acc[q] * acc[q];
        bf16* dst = C.MIX() + (size_t)row * DM + 512 + hh * 64 + part * 16;
        u32x4 o0, o1; o0.x = pk2(acc[0], acc[1]); o0.y = pk2(acc[2], acc[3]); o0.z = pk2(acc[4], acc[5]); o0.w = pk2(acc[6], acc[7]); o1.x = pk2(acc[8], acc[9]); o1.y = pk2(acc[10], acc[11]); o1.z = pk2(acc[12], acc[13]); o1.w = pk2(acc[14], acc[15]);
        *(u32x4*)dst = o0; *(u32x4*)(dst + 8) = o1;
        s += __shfl_xor(s, 1); s += __shfl_xor(s, 2); if (part == 0) atomicAdd(C.ssq(SQ_MA + l) + row, s);
    }
}
template <bool SAMPLE> DI void attn_phase(const Ctx& C, int l) {
    unsigned* sched = (unsigned*)(C.lds + LDS_BYTES - 64);
    for (;;) {
        __syncthreads();
        if (C.tid == 0) *sched = atomicAdd(C.ctr() + (SAMPLE ? 24 : 16) + l, 1u);
        __syncthreads();
        const int u = (int)*sched;
        if (u >= (SAMPLE ? 32 : 512)) break;
        if (SAMPLE) attn_unit<true>(C, l, u, 0); else attn_unit<false>(C, l, u & 7, 63 - (u >> 3));
    }
}
DI void mla_finalize(const Ctx& C, int l) {
    const int gw = C.blk * NWAVE + C.wave, NGW = C.G * NWAVE; const float* sq = C.ssq(SQ_MA + l);
    for (int m = gw; m < T; m += NGW) { const float rn = rsqrtf(sq[m] * (1.f / 512.f) + EPS); u32x4* p = (u32x4*)(C.MIX() + (size_t)m * DM + 512 + C.lane * 8); const u32x4 u = *p;
        u32x4 o; o.x = pk2(bflo(u.x) * rn, bfhi(u.x) * rn); o.y = pk2(bflo(u.y) * rn, bfhi(u.y) * rn); o.z = pk2(bflo(u.z) * rn, bfhi(u.z) * rn); o.w = pk2(bflo(u.w) * rn, bfhi(u.w) * rn); *p = o; }
}
DI void final_norm(const Ctx& C) {
    const int gw = C.blk * NWAVE + C.wave, NGW = C.G * NWAVE; const float* sq = C.ssq(SQ_XF); const float* g = C.in[I_FNG];
    for (int m = gw; m < T; m += NGW) { const float rn = rsqrtf(sq[m] * (1.f / 1024.f) + EPS); float* x = C.out + O_X + (size_t)m * DM;
#pragma unroll
        for (int j = 0; j < 4; ++j) { f32x4 v = *(f32x4*)(x + 256 * j + 4 * C.lane); const f32x4 gg = *(const f32x4*)(g + 256 * j + 4 * C.lane); v = v * rn * gg; *(f32x4*)(x + 256 * j + 4 * C.lane) = v; } }
}


#ifndef NAIVE_QKV
#define NAIVE_QKV 0
#endif
DI void naive_q(const Ctx& C, int l) {
    const bf16* P = C.PROJ(); const float* W = C.in[I_WUQ] + (size_t)l * 256 * 768; const float* g = C.in[I_QNG] + l * 256; const float* sq = C.ssq(SQ_QA + l);
    for (size_t i = (size_t)C.blk * NTHR + C.tid; i < (size_t)T * 768; i += (size_t)C.G * NTHR) { const int row = (int)(i / 768), n = (int)(i % 768); float a = 0.f;
        for (int k = 0; k < 256; ++k) a += bf2f(P[(size_t)row * INP + C_CQ + k]) * g[k] * W[(size_t)k * 768 + n];
        C.QF()[i] = f2bf(a * rsqrtf(sq[row] * (1.f / 256.f) + EPS) * QSCALE); }
}
DI void naive_kv(const Ctx& C, int l) {
    const bf16* P = C.PROJ(); const float* Wk = C.in[I_WUK] + (size_t)l * 128 * 512; const float* Wv = C.in[I_WUV] + (size_t)l * 128 * 512; const float* g = C.in[I_KVNG] + l * 128; const float* sq = C.ssq(SQ_KVA + l);
    for (size_t i = (size_t)C.blk * NTHR + C.tid; i < (size_t)TP * 1024; i += (size_t)C.G * NTHR) { const int row = (int)(i >> 10), n = (int)(i & 1023); const float* W = n < 512 ? Wk + n : Wv + (n - 512); float a = 0.f;
        for (int k = 0; k < 128; ++k) a += bf2f(P[(size_t)row * INP + C_CKV + k]) * g[k] * W[(size_t)k * 512];
        C.KVF()[i] = f2bf(a * rsqrtf(sq[row] * (1.f / 128.f) + EPS)); }
}

#ifndef NAIVE_S5
#define NAIVE_S5 0
#endif
#ifndef NAIVE_HG
#define NAIVE_HG 0
#endif
DI void naive_s5_scan(const Ctx& C, int l, float* TMP) {
    const int gw = C.blk * NWAVE + C.wave, NGW = C.G * NWAVE, lane = C.lane; const bf16* P = C.PROJ();
    for (int it = gw; it < 33 * 16; it += NGW) { const int sq = it >> 4, g = it & 15; const bool samp = sq > 0; const int b = sq - 1; const int row0 = samp ? TP + b * 16 : 0, n = samp ? 16 : TP;
        const int sidx = (l * 16 + g) * 64 + lane;
        const float dt = expf(C.in[I_LDT][l * 16 + g]), lr = C.in[I_LRE][sidx], li = C.in[I_LIM][sidx]; const float mag = expf(lr * dt); const float abr = mag * cosf(li * dt), abi = mag * sinf(li * dt);
        const float den = lr * lr + li * li, ir = lr / den, ii = -li / den; const float zr = (abr - 1.f) * ir - abi * ii, zi = (abr - 1.f) * ii + abi * ir;
        float bbr[16], bbi[16], cr[16], cim[16];
#pragma unroll
        for (int h = 0; h < 16; ++h) { const float br = C.in[I_BRE][(size_t)sidx * 16 + h], bi = C.in[I_BIM][(size_t)sidx * 16 + h]; bbr[h] = zr * br - zi * bi; bbi[h] = zr * bi + zi * br;
            cr[h] = C.in[I_CRE][((size_t)(l * 16 + g) * 16 + h) * 64 + lane]; cim[h] = C.in[I_CIM][((size_t)(l * 16 + g) * 16 + h) * 64 + lane]; }
        float hr = 0.f, hi = 0.f; if (samp) { hr = C.in[I_S5RE][((size_t)(l * 32 + b) * 16 + g) * 64 + lane]; hi = C.in[I_S5IM][((size_t)(l * 32 + b) * 16 + g) * 64 + lane]; }
        const float dch = lane < 16 ? C.in[I_S5D][l * 256 + g * 16 + lane] : 0.f;
        for (int t = 0; t < n; ++t) { const bf16* up = P + (size_t)(row0 + t) * INP + g * 16; float br = 0.f, bi = 0.f; float myu = 0.f;
#pragma unroll
            for (int h = 0; h < 16; ++h) { const float u = bf2f(up[h]); br += bbr[h] * u; bi += bbi[h] * u; if (h == lane) myu = u; }
            const float nr = abr * hr - abi * hi + br, ni = abr * hi + abi * hr + bi; hr = nr; hi = ni; float yk = 0.f;
#pragma unroll
            for (int h = 0; h < 16; ++h) { const float v = wave_sum(cr[h] * hr - cim[h] * hi); if (h == lane) yk = v; }
            if (lane < 16) { const float y = yk + dch * myu; const float a = 0.7978845608f * (y + 0.044715f * y * y * y); TMP[(size_t)(row0 + t) * 256 + g * 16 + lane] = 0.5f * y * (1.f + tanhf(a)); } }
        if (samp) { C.out[O_SRE + ((size_t)(l * 32 + b) * 16 + g) * 64 + lane] = hr; C.out[O_SIM + ((size_t)(l * 32 + b) * 16 + g) * 64 + lane] = hi; }
        else { C.out[O_PRE + ((size_t)l * 16 + g) * 64 + lane] = hr; C.out[O_PIM + ((size_t)l * 16 + g) * 64 + lane] = hi; } }
}
DI void naive_s5_glu(const Ctx& C, int l, const float* TMP) {
    float* zs = (float*)C.lds; float* red = zs + 256; const int tid = C.tid;
    for (int row = C.blk; row < T; row += C.G) { __syncthreads(); if (tid < 256) zs[tid] = TMP[(size_t)row * 256 + tid]; __syncthreads();
        float o = 0.f; if (tid < 256) { float a = C.in[I_BGLU][l * 256 + tid]; const float* W = C.in[I_WGLU] + (size_t)l * 65536 + tid; for (int k = 0; k < 256; ++k) a += zs[k] * W[(size_t)k * 256]; o = zs[tid] / (1.f + expf(-a)); }
        float s = wave_sum(o * o); if (C.lane == 0) red[C.wave] = s; __syncthreads(); const float tot = red[0] + red[1] + red[2] + red[3];
        if (tid < 256) C.MIX()[(size_t)row * DM + tid] = f2bf(o * rsqrtf(tot * (1.f / 256.f) + EPS)); }
}
DI void naive_hg_scan(const Ctx& C, int l, float* TMP) {
    const bf16* P = C.PROJ(); const float* LB = C.misc(M_LB) + l * 256;
    for (int it = C.blk * NTHR + C.tid; it < 33 * 256; it += C.G * NTHR) { const int sq = it >> 8, hd = (it >> 6) & 3, v = it & 63; const bool samp = sq > 0; const int b = sq - 1; const int row0 = samp ? TP + b * 16 : 0, n = samp ? 16 : TP;
        float S[64];
#pragma unroll
        for (int d = 0; d < 64; ++d) S[d] = samp ? C.in[I_SHG][((size_t)(l * 32 + b) * 4 + hd) * 4096 + d * 64 + v] : 0.f;
        for (int t = 0; t < n; ++t) { const bf16* pr = P + (size_t)(row0 + t) * INP; const float vv = bf2f(pr[C_HI + hd * 64 + v]); float o = 0.f;
#pragma unroll
            for (int d = 0; d < 64; ++d) { const float lb = LB[hd * 64 + d], fp = bf2f(pr[C_HF + hd * 64 + d]), hq = bf2f(pr[C_HQ + hd * 64 + d]); const float sg = 1.f / (1.f + expf(-fp));
                const float f = lb + (1.f - lb) * sg, k = (1.f - lb) * (1.f - sg), q = hq / (1.f + expf(-hq)); S[d] = f * S[d] + k * vv; o += q * S[d]; }
            TMP[(size_t)(row0 + t) * 256 + hd * 64 + v] = o; }
#pragma unroll
        for (int d = 0; d < 64; ++d) { if (samp) C.out[O_SHG + ((size_t)(l * 32 + b) * 4 + hd) * 4096 + d * 64 + v] = S[d]; else C.out[O_PHG + (size_t)l * 16384 + hd * 4096 + d * 64 + v] = S[d]; } }
}
DI void naive_hg_norm(const Ctx& C, int l, const float* TMP) {
    const int gw = C.blk * NWAVE + C.wave, NGW = C.G * NWAVE, lane = C.lane; const bf16* P = C.PROJ();
    for (int m = gw; m < T; m += NGW) { float o[4]; float s = 0.f;
#pragma unroll
        for (int j = 0; j < 4; ++j) { o[j] = TMP[(size_t)m * 256 + 64 * j + lane]; s += o[j] * o[j]; }
        s = wave_sum(s); const float rn = rsqrtf(s * (1.f / 256.f) + EPS);
#pragma unroll
        for (int j = 0; j < 4; ++j) { const float g = bf2f(P[(size_t)m * INP + C_HG + 64 * j + lane]); C.MIX()[(size_t)m * DM + 256 + 64 * j + lane] = f2bf(o[j] * rn * g / (1.f + expf(-g))); } }
}

#ifndef NAIVE_ATTP
#define NAIVE_ATTP 0
#endif
#ifndef NAIVE_ATTS
#define NAIVE_ATTS 0
#endif
DI float wave_max(float v) {
#pragma unroll
    for (int o = 1; o < 64; o <<= 1) v = fmaxf(v, __shfl_xor(v, o));
    return v;
}
DI void naive_attn_prompt(const Ctx& C, int l) {
    const int gw = C.blk * NWAVE + C.wave, NGW = C.G * NWAVE, lane = C.lane; const bf16* QF = C.QF(); const bf16* KVF = C.KVF(); const bf16* KPE = C.KPEB();
    for (int it = gw; it < TP * 8; it += NGW) { const int row = it >> 3, hd = it & 7; float q[96];
#pragma unroll
        for (int d = 0; d < 96; ++d) q[d] = bf2f(QF[(size_t)row * 768 + hd * 96 + d]);
#pragma unroll
        for (int i = 0; i < 16; ++i) { const float c = C.misc(M_COS)[row * 16 + i], s = C.misc(M_SIN)[row * 16 + i]; const float x1 = q[64 + i], x2 = q[80 + i]; q[64 + i] = x1 * c - x2 * s; q[80 + i] = x2 * c + x1 * s; }
        const int nk = 64 * (row / 64 + 1); float m = -1e30f, ls = 0.f; float acc[64];
#pragma unroll
        for (int d = 0; d < 64; ++d) acc[d] = 0.f;
        for (int k = lane; k < nk; k += 64) { float sc = 0.f;
#pragma unroll
            for (int d = 0; d < 64; ++d) sc += q[d] * bf2f(KVF[(size_t)k * 1024 + hd * 64 + d]);
#pragma unroll
            for (int d = 0; d < 32; ++d) sc += q[64 + d] * bf2f(KPE[(size_t)k * 32 + d]);
            const float mn = fmaxf(m, sc), a = exp2f(m - mn), p = exp2f(sc - mn); m = mn; ls = ls * a + p;
#pragma unroll
            for (int d = 0; d < 64; ++d) acc[d] = acc[d] * a + p * bf2f(KVF[(size_t)k * 1024 + 512 + hd * 64 + d]); }
        const float M = wave_max(m), f = exp2f(m - M); const float L = wave_sum(ls * f); float mine = 0.f;
#pragma unroll
        for (int d = 0; d < 64; ++d) { const float v = wave_sum(acc[d] * f) / L; if (d == lane) mine = v; }
        C.MIX()[(size_t)row * DM + 512 + hd * 64 + lane] = f2bf(mine); const float s2 = wave_sum(mine * mine); if (lane == 0) atomicAdd(C.ssq(SQ_MA + l) + row, s2); }
}
DI void naive_attn_sample(const Ctx& C, int l) {
    const int gw = C.blk * NWAVE + C.wave, NGW = C.G * NWAVE, lane = C.lane; const bf16* QF = C.QF(); float* qs = (float*)C.lds + C.wave * 512; float* os = qs + 256;
    for (int it = gw; it < TS * 8; it += NGW) { const int bi = it >> 3, hh = it & 7, b = bi >> 4, i = bi & 15, row = TP + bi, pos = PAST + i;
        const bf16* qr = QF + (size_t)row * 768 + hh * 96;
        for (int c = lane; c < 128; c += 64) { float a = 0.f; const float* w = C.in[I_WUK] + (size_t)l * 65536 + (size_t)c * 512 + hh * 64; for (int d = 0; d < 64; ++d) a += bf2f(qr[d]) * w[d]; qs[c] = a; }
        if (lane < 16) { const float c = C.misc(M_COS)[pos * 16 + lane], s = C.misc(M_SIN)[pos * 16 + lane]; const float x1 = bf2f(qr[64 + lane]), x2 = bf2f(qr[80 + lane]); qs[128 + lane] = x1 * c - x2 * s; qs[144 + lane] = x2 * c + x1 * s; }
        __builtin_amdgcn_s_waitcnt(0); asm volatile("" ::: "memory");
        float m = -1e30f, ls = 0.f; float acc[128];
#pragma unroll
        for (int d = 0; d < 128; ++d) acc[d] = 0.f;
        for (int k = lane; k < PAST + 16; k += 64) { const float* kv = k < PAST ? C.in[I_CKV] + ((size_t)(l * 32 + b) * PAST + k) * 128 : C.out + O_SKV + ((size_t)l * TS + b * 16 + (k - PAST)) * 128;
            const float* pe = k < PAST ? C.in[I_CPE] + ((size_t)(l * 32 + b) * PAST + k) * 32 : C.out + O_SPE + ((size_t)l * TS + b * 16 + (k - PAST)) * 32; float sc = 0.f;
            for (int d = 0; d < 128; ++d) sc += qs[d] * kv[d];
            for (int d = 0; d < 32; ++d) sc += qs[128 + d] * pe[d];
            const float mn = fmaxf(m, sc), a = exp2f(m - mn), p = exp2f(sc - mn); m = mn; ls = ls * a + p;
#pragma unroll
            for (int d = 0; d < 128; ++d) acc[d] = acc[d] * a + p * kv[d]; }
        const float M = wave_max(m), f = exp2f(m - M); const float L = wave_sum(ls * f);
#pragma unroll
        for (int d = 0; d < 128; ++d) { const float v = wave_sum(acc[d] * f) / L; if ((d & 63) == lane) os[d] = v; }
        __builtin_amdgcn_s_waitcnt(0); asm volatile("" ::: "memory");
        float o = 0.f; const float* wv = C.in[I_WUV] + (size_t)l * 65536 + hh * 64 + lane; for (int c = 0; c < 128; ++c) o += os[c] * wv[(size_t)c * 512];
        C.MIX()[(size_t)row * DM + 512 + hh * 64 + lane] = f2bf(o); const float s2 = wave_sum(o * o); if (lane == 0) atomicAdd(C.ssq(SQ_MA + l) + row, s2);
        __builtin_amdgcn_s_waitcnt(0); asm volatile("" ::: "memory"); }
}
template <int K> DI void run_kind(const Ctx& C, int l, LAS unsigned char* ldsg) {
    if constexpr (K == 0) p0_prologue(C);
    else if constexpr (K == 1) { pg8::Gemm g{C.XB(), C.wgt(l, W_IN), T, INP, DM, DM, DM}; pg8::StaticOrder S; S.init(T, INP, C.G, C.blk);
        pg8::EpiG1 E{C.PROJ(), C.ssq(SQ_X0 + l), C.ssq(SQ_QA + l), C.ssq(SQ_KVA + l)}; pg8::gemm_phase<pg8::EpiG1, pg8::StaticOrder, true, true>(ldsg, g, S, E); }
    else if constexpr (K == 2 && NAIVE_QKV) naive_q(C, l);
    else if constexpr (K == 3 && NAIVE_QKV) naive_kv(C, l);
    else if constexpr (K == 2) { pg8::Gemm g{C.PROJ() + C_CQ, C.wgt(l, W_UQ), T, 768, 256, INP, 256}; pg8::StaticOrder S; S.init(T, 768, C.G, C.blk);
        pg8::EpiQ E{C.QF(), C.ssq(SQ_QA + l)}; pg8::gemm_phase<pg8::EpiQ, pg8::StaticOrder, true, true>(ldsg, g, S, E); }
    else if constexpr (K == 3) { pg8::Gemm g{C.PROJ() + C_CKV, C.wgt(l, W_KV), TP, 1024, 128, INP, 128}; pg8::StaticOrder S; S.init(TP, 1024, C.G, C.blk);
        pg8::EpiScaleStore E{C.KVF(), 1024, C.ssq(SQ_KVA + l), 1.f / 128.f}; pg8::gemm_phase<pg8::EpiScaleStore, pg8::StaticOrder, true, true>(ldsg, g, S, E); }
    else if constexpr (K == 4) { __syncthreads(); misc_rows(C, l);
        if (!NAIVE_S5) for (int ci = C.blk; ci < 256; ci += C.G) s5_item<false>(C, l, ci);
        __syncthreads();
        if (!NAIVE_HG) for (int bi = C.G - 1 - C.blk; bi < 144; bi += C.G) hgrn_local(C, l, bi * 8 + C.wave); }
    else if constexpr (K == 5) { if (NAIVE_HG) naive_hg_scan(C, l, C.GT()); else hgrn_prefix(C, l);
        if (NAIVE_S5) naive_s5_scan(C, l, (float*)C.XB()); else for (int ci = C.blk; ci < 288; ci += C.G) s5_item<true>(C, l, ci); }
    else if constexpr (K == 6) { if (NAIVE_ATTS) naive_attn_sample(C, l); else attn_phase<true>(C, l); }
    else if constexpr (K == 7) { if (NAIVE_ATTP) naive_attn_prompt(C, l); else attn_phase<false>(C, l); }
    else if constexpr (K == 8) { if (NAIVE_HG) naive_hg_norm(C, l, C.GT()); else for (int bi = C.blk; bi < 144; bi += C.G) hgrn_final(C, l, bi);
        if (NAIVE_S5) naive_s5_glu(C, l, (const float*)C.XB());
        mla_finalize(C, l); }
    else if constexpr (K == 9) { pg8::Gemm g{C.MIX(), C.wgt(l, W_OUT), T, DM, DM, DM, DM}; pg8::StaticOrder S; S.init(T, DM, C.G, C.blk);
        pg8::EpiRes E{C.out + O_X, C.XB(), C.ssq(SQ_2A + l)}; pg8::gemm_phase<pg8::EpiRes, pg8::StaticOrder, true, true>(ldsg, g, S, E); }
    else if constexpr (K == 10) { pg8::Gemm g{C.XB(), C.wgt(l, W_UP), T, DFF, DM, DM, DM}; pg8::StaticOrder S; S.init(T, DFF, C.G, C.blk);
        pg8::EpiUp E{C.HID(), C.ssq(SQ_2A + l)}; pg8::gemm_phase<pg8::EpiUp, pg8::StaticOrder, true, true>(ldsg, g, S, E); }
    else if constexpr (K == 11) { pg8::Gemm g{C.HID(), C.wgt(l, W_DN), T, DM, DFF, DFF, DFF}; pg8::StaticOrder S; S.init(T, DM, C.G, C.blk);
        pg8::EpiRes E{C.out + O_X, C.XB(), C.ssq(SQ_X1 + l)}; pg8::gemm_phase<pg8::EpiRes, pg8::StaticOrder, true, true>(ldsg, g, S, E); }
    else final_norm(C);
}
DI Ctx make_ctx(const Args& args, unsigned char* lds_raw) {
    Ctx C; C.in = args.in; C.out = args.out; C.ws = args.ws; C.lds = (char*)lds_raw; C.tid = threadIdx.x; C.lane = C.tid & 63; C.wave = __builtin_amdgcn_readfirstlane(C.tid >> 6); C.G = gridDim.x; C.blk = blockIdx.x; return C;
}
template <int K> __global__ void __launch_bounds__(NTHR, 2) phase_kernel(Args args, int l) {
    extern __shared__ __attribute__((aligned(16))) unsigned char lds_raw[];
    const Ctx C = make_ctx(args, lds_raw);
    run_kind<K>(C, l, (LAS unsigned char*)lds_raw);
}
#ifndef MK_MEGA
#define MK_MEGA 0
#endif
#if MK_MEGA
__global__ void __launch_bounds__(NTHR, 2) trunk_fwd(Args args) {
    extern __shared__ __attribute__((aligned(16))) unsigned char lds_raw[];
    cg::grid_group grid = cg::this_grid();
    const Ctx C = make_ctx(args, lds_raw); LAS unsigned char* ldsg = (LAS unsigned char*)lds_raw;
#define GSYNC() do { __threadfence(); grid.sync(); __threadfence(); } while (0)
    run_kind<0>(C, 0, ldsg); GSYNC();
    for (int l = 0; l < 2; ++l) {
        run_kind<1>(C, l, ldsg); GSYNC();
        run_kind<2>(C, l, ldsg); run_kind<3>(C, l, ldsg); run_kind<4>(C, l, ldsg); GSYNC();
        run_kind<5>(C, l, ldsg); run_kind<6>(C, l, ldsg); run_kind<7>(C, l, ldsg); GSYNC();
        run_kind<8>(C, l, ldsg); GSYNC();
        run_kind<9>(C, l, ldsg); GSYNC();
        run_kind<10>(C, l, ldsg); GSYNC();
        run_kind<11>(C, l, ldsg); GSYNC();
    }
    run_kind<12>(C, 0, ldsg);
}
#endif

template <int K> static void launch_kind(const Args& a, int l, int grid, hipStream_t stream) {
    static bool attr_set = false;
    if (!attr_set) { (void)hipFuncSetAttribute((const void*)phase_kernel<K>, hipFuncAttributeMaxDynamicSharedMemorySize, LDS_BYTES); attr_set = true; }
    hipLaunchKernelGGL(phase_kernel<K>, dim3(grid), dim3(NTHR), LDS_BYTES, stream, a, l);
}
extern "C" void kernel_launch(void* const* d_in, const int* in_sizes, int n_in, void* d_out, int out_size, void* d_ws, size_t ws_size, hipStream_t stream) {
    static int grid = 0;
    if (grid == 0) {
        int dev = 0, cus = 0;
        if (n_in != 31 || ws_size < WS_END) { fprintf(stderr, "kernel_launch: unexpected inputs (n_in %d, ws %zu < %zu)\n", n_in, ws_size, (size_t)WS_END); grid = -1; return; }
        (void)hipGetDevice(&dev); (void)hipDeviceGetAttribute(&cus, hipDeviceAttributeMultiprocessorCount, dev);
#if MK_MEGA
        int per_cu = 0;
        (void)hipFuncSetAttribute((const void*)trunk_fwd, hipFuncAttributeMaxDynamicSharedMemorySize, LDS_BYTES);
        (void)hipOccupancyMaxActiveBlocksPerMultiprocessor(&per_cu, (const void*)trunk_fwd, NTHR, LDS_BYTES);
        (void)hipGetLastError();
        if (per_cu < 1) fprintf(stderr, "kernel_launch: occupancy query says %d blocks per CU\n", per_cu);
#endif
        grid = cus > 0 ? cus : 256;
    }
    if (grid < 0) return;
    (void)hipMemsetAsync((char*)d_ws + WS_ZERO, 0, ZERO_BYTES, stream);
    Args a{};
    for (int i = 0; i < 31; ++i) a.in[i] = (const float*)d_in[i];
    a.out = (float*)d_out; a.ws = (unsigned char*)d_ws;
#if MK_MEGA
    void* kargs[] = {&a};
    hipError_t e = hipLaunchCooperativeKernel((const void*)trunk_fwd, dim3(grid), dim3(NTHR), kargs, LDS_BYTES, stream);
    if (e != hipSuccess) fprintf(stderr, "cooperative launch failed: %s (grid %d)\n", hipGetErrorString(e), grid);
#else
    launch_kind<0>(a, 0, grid, stream);
    for (int l = 0; l < 2; ++l) {
        launch_kind<1>(a, l, grid, stream); launch_kind<2>(a, l, grid, stream); launch_kind<3>(a, l, grid, stream); launch_kind<4>(a, l, grid, stream);
        launch_kind<5>(a, l, grid, stream); launch_kind<6>(a, l, grid, stream); launch_kind<7>(a, l, grid, stream); launch_kind<8>(a, l, grid, stream);
        launch_kind<9>(a, l, grid, stream); launch_kind<10>(a, l, grid, stream); launch_kind<11>(a, l, grid, stream);
    }
    launch_kind<12>(a, 0, grid, stream);
#endif
}
```

```cpp
#include <hip/hip_runtime.h>
#include <hip/hip_cooperative_groups.h>
#include <cstdio>
#include <cstdint>
namespace cg = cooperative_groups;
namespace pg8 {
#define PG8_LAS __attribute__((address_space(3)))
typedef unsigned short bf16_t;
typedef short bf16x8 __attribute__((ext_vector_type(8)));
typedef float f32x4 __attribute__((ext_vector_type(4)));
typedef unsigned u32x4 __attribute__((ext_vector_type(4)));
constexpr int BM = 256, BK = 64, HALF = 128, HTB = HALF * BK * 2  , STAGE_BYTES = 8 * HTB, NXCD = 8, WGM = 8;

__host__ __device__ __forceinline__ int lds_byte(int r, int c) { const int st = (r >> 4) * 2 + (c >> 5), rr = r & 15, cc = c & 31, ob = rr * 64 + cc * 2; return st * 1024 + (ob ^ (((ob >> 9) & 1) << 5)); }
__host__ __device__ __forceinline__ void stage_rc(int b, int& R, int& C) { const int st = b / 1024, sb = b % 1024, swz = sb ^ (((sb >> 9) & 1) << 5); R = (st >> 1) * 16 + swz / 64; C = (st & 1) * 32 + (swz % 64) / 2; }
__host__ __device__ __forceinline__ int perm32(int rho) { const int n = rho >> 4, i = rho & 15; return 8 * (i >> 2) + 4 * n + (i & 3); }

struct Unit { int pm, pn; };
struct Gemm { const bf16_t* A; const bf16_t* Bt; int M, N, K, lda, ldb; };

struct StaticOrder {
    int nM, nN, nwg, G, c;
    __host__ __device__ void init(int M, int N, int G_, int c_) { nM = M / BM; nN = N / BM; nwg = nM * nN; G = G_; c = c_; }
    __host__ __device__ bool next(int i, Unit& u) const {
        const long L = (long)i * G + c; if (L >= nwg) return false;
        int wgid = (int)L; { const int q = nwg / NXCD, r = nwg % NXCD, xcd = wgid % NXCD, off = wgid / NXCD; wgid = (xcd < r ? xcd * (q + 1) : r * (q + 1) + (xcd - r) * q) + off; }
        const int nig = WGM * nN, gid = wgid / nig, fm = gid * WGM, gsz = (nM - fm) < WGM ? (nM - fm) : WGM;
        u.pm = fm + ((wgid % nig) % gsz); u.pn = (wgid % nig) / gsz; return true;
    }
    __device__ __forceinline__ void a_ready(const Unit&) const {}
    __device__ __forceinline__ void done(const Unit&) const {}
};

__device__ __forceinline__ unsigned cvt_pk_bf16(float lo, float hi) { unsigned r; asm volatile("v_cvt_pk_bf16_f32 %0, %1, %2" : "=v"(r) : "v"(lo), "v"(hi)); return r; }
typedef float f32x2 __attribute__((ext_vector_type(2)));
__device__ __forceinline__ f32x2 gelu_pk(f32x2 v) {
    const f32x2 av = __builtin_elementwise_abs(v), d = av * 0.2316418882f + 1.0f;
    f32x2 t; t.x = __builtin_amdgcn_rcpf(d.x); t.y = __builtin_amdgcn_rcpf(d.y);
    f32x2 q = t * 0.5307027145f + (-0.7265760135f); q = q * t + 0.7107068705f; q = q * t + (-0.142248368f); q = q * t + 0.127414796f; q = q * t;
    const f32x2 s = (v * v) * (-0.72134752044f);
    f32x2 e; e.x = __builtin_amdgcn_exp2f(s.x); e.y = __builtin_amdgcn_exp2f(s.y);
    const f32x2 m = v * (q * e), r = v - m;
    f32x2 o; o.x = v.x < 0.f ? m.x : r.x; o.y = v.y < 0.f ? m.y : r.y; return o;
}

template <class Epi, class Sched, bool ALIGN_EPI = false, bool SP2 = false>
__device__ __forceinline__ void gemm_phase(PG8_LAS unsigned char* lds, const Gemm g, const Sched& S, const Epi& E) {
    int tid_ = threadIdx.x; asm volatile("" : "+v"(tid_)); const int tid = tid_, wid = __builtin_amdgcn_readfirstlane(tid >> 6), lane = tid & 63, wr = wid >> 2, wc = wid & 3, fr = lane & 15, fq = lane >> 4;
    const int K = g.K, nt = K / BK;
    unsigned voffA[2], voffB[2];
#pragma unroll
    for (int i = 0; i < 2; ++i) { int R, C; stage_rc(tid * 16 + i * 8192, R, C); const int Rb = Epi::PERM ? ((R & ~31) + perm32(R & 31)) : R;
        voffA[i] = (unsigned)(R * g.lda + C) * 2u; voffB[i] = (unsigned)(Rb * g.ldb + C) * 2u; }
    const size_t kstep = (size_t)(BK * 2);
    const size_t hstepA = (size_t)HALF * g.lda * 2, hstepB = (size_t)HALF * g.ldb * 2;
    const size_t tstepA = 2 * hstepA, tstepB = 2 * hstepB;
    const unsigned ldsw = (unsigned)wid * 1024u;
    const int aoff = lds_byte(wr * 64 + fr, fq * 8), boff = lds_byte(wc * 32 + fr, fq * 8);
#define PG8_SA(b, h) (((b) * 2 + (h)) * HTB)
#define PG8_SB(b, h) ((4 + (b) * 2 + (h)) * HTB)
#define PG8_STAGE(bufoff, gbase, voff) do { _Pragma("unroll") for (int _i = 0; _i < 2; ++_i) \
        __builtin_amdgcn_global_load_lds((const unsigned*)((const char*)(gbase) + (voff)[_i]), (PG8_LAS unsigned*)(lds + (bufoff) + ldsw + _i * 8192), 16, 0, 0); } while (0)
#define PG8_LDA(dst, b, h) do { _Pragma("unroll") for (int m = 0; m < 4; ++m) _Pragma("unroll") for (int k = 0; k < 2; ++k) dst[m][k] = *(const PG8_LAS bf16x8*)(lds + PG8_SA(b, h) + aoff + m * 2048 + k * 1024); } while (0)
#define PG8_LDB(dst, b, h) do { _Pragma("unroll") for (int n = 0; n < 2; ++n) _Pragma("unroll") for (int k = 0; k < 2; ++k) dst[n][k] = *(const PG8_LAS bf16x8*)(lds + PG8_SB(b, h) + boff + n * 2048 + k * 1024); } while (0)
#define PG8_MMA(ai, bj, At, Bt) do { __builtin_amdgcn_s_setprio(1); _Pragma("unroll") for (int m = 0; m < 4; ++m) _Pragma("unroll") for (int n = 0; n < 2; ++n) _Pragma("unroll") for (int k = 0; k < 2; ++k) \
        acc[ai][bj][m][n] = __builtin_amdgcn_mfma_f32_16x16x32_bf16(Bt[n][k], At[m][k], acc[ai][bj][m][n], 0, 0, 0); __builtin_amdgcn_s_setprio(0); } while (0)
#define PG8_WAIT_V(n) asm volatile("s_waitcnt vmcnt(" #n ")" ::: "memory")
#define PG8_WAIT_L(n) asm volatile("s_waitcnt lgkmcnt(" #n ")" ::: "memory")
#define PG8_BAR __builtin_amdgcn_s_barrier()
#define PG8_SCHED __builtin_amdgcn_sched_barrier(0)
    Unit cur, nxt; int ui = 0;
    if (!S.next(0, cur)) return;
    f32x4 acc[2][2][4][2];
#pragma unroll
    for (int a = 0; a < 2; ++a)
#pragma unroll
        for (int b = 0; b < 2; ++b)
#pragma unroll
            for (int m = 0; m < 4; ++m)
#pragma unroll
                for (int n = 0; n < 2; ++n) acc[a][b][m][n] = (f32x4){0.f, 0.f, 0.f, 0.f};
    bf16x8 At[4][2], B0[2][2], B1[2][2];
    const char* cA = (const char*)g.A + (size_t)cur.pm * tstepA; const char* cB = (const char*)g.Bt + (size_t)cur.pn * tstepB;
    S.a_ready(cur);
    if constexpr (SP2) {
        PG8_STAGE(PG8_SB(0, 0), cB, voffB); PG8_STAGE(PG8_SB(0, 1), cB + hstepB, voffB); PG8_STAGE(PG8_SA(0, 0), cA, voffA); PG8_STAGE(PG8_SA(0, 1), cA + hstepA, voffA);
        if (wr == 1) PG8_BAR;
        PG8_WAIT_V(2); PG8_BAR;
        PG8_STAGE(PG8_SB(1, 0), cB + kstep, voffB); PG8_STAGE(PG8_SA(1, 0), cA + kstep, voffA); PG8_STAGE(PG8_SB(1, 1), cB + hstepB + kstep, voffB);
        PG8_WAIT_V(6); PG8_BAR;
    } else {
        PG8_STAGE(PG8_SB(0, 0), cB, voffB); PG8_STAGE(PG8_SA(0, 0), cA, voffA); PG8_STAGE(PG8_SB(0, 1), cB + hstepB, voffB); PG8_STAGE(PG8_SA(0, 1), cA + hstepA, voffA);
        if (wr == 1) PG8_BAR;
        PG8_WAIT_V(4); PG8_BAR;
        PG8_STAGE(PG8_SB(1, 0), cB + kstep, voffB); PG8_STAGE(PG8_SA(1, 0), cA + kstep, voffA); PG8_STAGE(PG8_SB(1, 1), cB + hstepB + kstep, voffB);
        PG8_WAIT_V(6); PG8_BAR;
    }
    for (;;) {
        const bool has_next = S.next(ui + 1, nxt);
        const char* nA = has_next ? (const char*)g.A + (size_t)nxt.pm * tstepA : cA; const char* nB = has_next ? (const char*)g.Bt + (size_t)nxt.pn * tstepB : cB;
        for (int t = 0; t < nt; t += 2) {
            const bool last = (t == nt - 2);
            const char* a1 = cA + (size_t)(t + 1) * kstep;
            const char* a2 = last ? nA : cA + (size_t)(t + 2) * kstep; const char* b2 = last ? nB : cB + (size_t)(t + 2) * kstep;
            const char* a3 = a2 + kstep; const char* b3 = b2 + kstep;
            if (last && has_next) S.a_ready(nxt);
            if constexpr (SP2) {
            PG8_LDB(B0, 0, 0); PG8_LDB(B1, 0, 1); PG8_SCHED; PG8_LDA(At, 0, 0); PG8_STAGE(PG8_SA(1, 1), a1 + hstepA, voffA);
            PG8_WAIT_V(8); PG8_WAIT_L(0); PG8_BAR; PG8_MMA(0, 0, At, B0); PG8_MMA(0, 1, At, B1); PG8_BAR; PG8_SCHED;
            PG8_LDA(At, 0, 1); PG8_STAGE(PG8_SB(0, 0), b2, voffB); PG8_STAGE(PG8_SB(0, 1), b2 + hstepB, voffB); PG8_STAGE(PG8_SA(0, 0), a2, voffA);
            PG8_WAIT_V(8); PG8_WAIT_L(0); PG8_BAR; PG8_MMA(1, 0, At, B0); PG8_MMA(1, 1, At, B1); PG8_BAR; PG8_SCHED;
            PG8_LDB(B0, 1, 0); PG8_LDB(B1, 1, 1); PG8_SCHED; PG8_LDA(At, 1, 0); PG8_STAGE(PG8_SA(0, 1), a2 + hstepA, voffA);
            PG8_WAIT_V(8); PG8_WAIT_L(0); PG8_BAR; PG8_MMA(0, 0, At, B0); PG8_MMA(0, 1, At, B1); PG8_BAR; PG8_SCHED;
            PG8_LDA(At, 1, 1); PG8_STAGE(PG8_SB(1, 0), b3, voffB); PG8_STAGE(PG8_SB(1, 1), b3 + hstepB, voffB); PG8_STAGE(PG8_SA(1, 0), a3, voffA);
            PG8_WAIT_V(8); PG8_WAIT_L(0); PG8_BAR; PG8_MMA(1, 0, At, B0); PG8_MMA(1, 1, At, B1); PG8_BAR; PG8_SCHED;
            } else {
            PG8_LDB(B0, 0, 0); PG8_SCHED; PG8_LDA(At, 0, 0); PG8_STAGE(PG8_SA(1, 1), a1 + hstepA, voffA);
            PG8_WAIT_L(8); PG8_BAR; PG8_WAIT_L(0); PG8_MMA(0, 0, At, B0); PG8_BAR; PG8_SCHED;
            PG8_LDB(B1, 0, 1); PG8_STAGE(PG8_SB(0, 0), b2, voffB);
            PG8_BAR; PG8_WAIT_L(0); PG8_MMA(0, 1, At, B1); PG8_BAR;
            PG8_LDA(At, 0, 1); PG8_STAGE(PG8_SA(0, 0), a2, voffA);
            PG8_BAR; PG8_WAIT_L(0); PG8_MMA(1, 0, At, B0); PG8_BAR; PG8_SCHED;
            PG8_STAGE(PG8_SB(0, 1), b2 + hstepB, voffB);
            PG8_WAIT_V(6); PG8_BAR; PG8_MMA(1, 1, At, B1); PG8_BAR;
            PG8_LDB(B0, 1, 0); PG8_SCHED; PG8_LDA(At, 1, 0); PG8_STAGE(PG8_SA(0, 1), a2 + hstepA, voffA);
            PG8_WAIT_L(8); PG8_BAR; PG8_WAIT_L(0); PG8_MMA(0, 0, At, B0); PG8_BAR; PG8_SCHED;
            PG8_LDB(B1, 1, 1); PG8_STAGE(PG8_SB(1, 0), b3, voffB);
            PG8_BAR; PG8_WAIT_L(0); PG8_MMA(0, 1, At, B1); PG8_BAR;
            PG8_LDA(At, 1, 1); PG8_STAGE(PG8_SA(1, 0), a3, voffA);
            PG8_BAR; PG8_WAIT_L(0); PG8_MMA(1, 0, At, B0); PG8_BAR; PG8_SCHED;
            PG8_STAGE(PG8_SB(1, 1), b3 + hstepB, voffB);
            PG8_WAIT_V(6); PG8_BAR; PG8_MMA(1, 1, At, B1); PG8_BAR;
            }
        }
        if constexpr (ALIGN_EPI) { if (wr == 0) PG8_BAR; }
        if constexpr (!Epi::AFTER_DRAIN) { E(acc, cur, wr, wc, fr, fq); S.done(cur); }
        if (!has_next) break;
#pragma unroll
        for (int a = 0; a < 2; ++a)
#pragma unroll
            for (int b = 0; b < 2; ++b)
#pragma unroll
                for (int m = 0; m < 4; ++m)
#pragma unroll
                    for (int n = 0; n < 2; ++n) acc[a][b][m][n] = (f32x4){0.f, 0.f, 0.f, 0.f};
        cur = nxt; cA = nA; cB = nB; ++ui;
        if constexpr (ALIGN_EPI) { if (wr == 1) PG8_BAR; }
    }
    PG8_WAIT_V(0);
    if constexpr (!ALIGN_EPI) { if (wr == 0) PG8_BAR; }
    PG8_BAR;
    if constexpr (Epi::AFTER_DRAIN) { E.fused(acc, cur, wr, wc, fr, fq, lds, wid, lane); S.done(cur); }
#undef PG8_SA
#undef PG8_SB
#undef PG8_STAGE
#undef PG8_LDA
#undef PG8_LDB
#undef PG8_MMA
#undef PG8_WAIT_V
#undef PG8_WAIT_L
#undef PG8_BAR
#undef PG8_SCHED
}
}

#define DI __device__ __forceinline__
#define LAS __attribute__((address_space(3)))
typedef unsigned short bf16;
typedef short bf16x8 __attribute__((ext_vector_type(8)));
typedef short s16x4 __attribute__((ext_vector_type(4)));
typedef float f32x4 __attribute__((ext_vector_type(4)));
typedef float f32x16 __attribute__((ext_vector_type(16)));
typedef unsigned u32x4 __attribute__((ext_vector_type(4)));
typedef unsigned u32x2 __attribute__((ext_vector_type(2)));
typedef float f32x2_t __attribute__((ext_vector_type(2)));
typedef __bf16 bf16x2_t __attribute__((ext_vector_type(2)));
DI unsigned pk2(float lo, float hi) { f32x2_t v = {lo, hi}; bf16x2_t b = __builtin_convertvector(v, bf16x2_t); return __builtin_bit_cast(unsigned, b); }
DI float bf2f(unsigned short x) { return __uint_as_float((unsigned)x << 16); }
DI float bflo(unsigned w) { return __uint_as_float(w << 16); }
DI float bfhi(unsigned w) { return __uint_as_float(w & 0xffff0000u); }
DI unsigned short f2bf(float f) { return (unsigned short)(pk2(f, 0.f) & 0xffffu); }
#define MFMA32(a, b, c) __builtin_amdgcn_mfma_f32_32x32x16_bf16((a), (b), (c), 0, 0, 0)
DI int crow(int i, int h) { return (i & 3) + 8 * (i >> 2) + 4 * h; }
DI float sigmoidf_(float x) { return 1.f / (1.f + __expf(-x)); }
DI float wave_sum(float v) {
#pragma unroll
    for (int o = 1; o < 64; o <<= 1) v += __shfl_xor(v, o);
    return v;
}
DI bf16x8 lds16(const char* p) { return *(const bf16x8*)p; }
DI bf16x8 lds8x2(const char* p) { const s16x4 a = *(const s16x4*)p, b = *(const s16x4*)(p + 8); return __builtin_shufflevector(a, b, 0, 1, 2, 3, 4, 5, 6, 7); }
typedef short v4i16_t __attribute__((ext_vector_type(4)));
DI s16x4 ldtr(const char* p) { return __builtin_bit_cast(s16x4, __builtin_amdgcn_ds_read_tr16_b64_v4i16((LAS v4i16_t*)p)); }
DI bf16x8 packf8(float a0, float a1, float a2, float a3, float a4, float a5, float a6, float a7) {
    u32x4 w; w.x = pk2(a0, a1); w.y = pk2(a2, a3); w.z = pk2(a4, a5); w.w = pk2(a6, a7); return __builtin_bit_cast(bf16x8, w);
}

constexpr int DM = 1024, TP = 16384, TS = 512, T = TP + TS, NBATCH = 32, DSEQ = 16, PAST = 2048, INW = 1696, INP = 1792, DFF = 4096;
constexpr int C_U = 0, C_HQ = 256, C_HF = 512, C_HI = 768, C_HG = 1024, C_CQ = 1280, C_CKV = 1536, C_KPE = 1664;
constexpr float EPS = 1e-5f;
constexpr float QSCALE = 0.14724444f;
constexpr int NTHR = 512, NWAVE = 8;
constexpr int LDS_BYTES = 147456;

constexpr size_t O_X = 0, O_PKV = 17301504, O_PPE = 21495808, O_PHG = 22544384, O_PRE = 22577152, O_PIM = 22579200,
                 O_SKV = 22581248, O_SPE = 22712320, O_SHG = 22745088, O_SRE = 23793664, O_SIM = 23859200;
constexpr size_t WS_ZERO = 0, ZERO_BYTES = 1048576, WS_SSQ = 65536, SSQ_STRIDE = (size_t)T * 4;
constexpr size_t WS_W = 1048576, W_LAYER = 23330816, W_IN = 0, W_UQ = 3670016, W_KV = 4063232, W_OUT = 4325376, W_UP = 6422528, W_DN = 14811136, W_GLU = 23199744;
constexpr size_t WS_MISC = WS_W + 2 * W_LAYER;
constexpr size_t M_AB = 0, M_BBRE = 16384, M_BBIM = M_BBRE + 131072, M_LB = M_BBIM + 131072, M_COS = M_LB + 2048, M_SIN = M_COS + 1048576, M_KCN = M_SIN + 1048576;
constexpr size_t WS_XB = WS_MISC + 4194304;
constexpr size_t WS_OV = WS_XB + (size_t)T * DM * 2;
constexpr size_t OV_PROJ = 0, OV_QF = OV_PROJ + (size_t)T * INP * 2, OV_KVF = OV_QF + (size_t)T * 768 * 2, OV_KPE = OV_KVF + (size_t)TP * 1024 * 2,
                 OV_MIX = OV_KPE + (size_t)TP * 32 * 2, OV_GT = OV_MIX + (size_t)T * DM * 2, OV_DD = OV_GT + (size_t)288 * 4 * 4096 * 4, OV_EBM = OV_DD + (size_t)288 * 256 * 4,
                 OV_E5 = OV_EBM + (size_t)288 * 256 * 4, OV_END = OV_E5 + (size_t)256 * 16 * 64 * 2 * 4;
constexpr size_t WS_END = WS_OV + OV_END;
static_assert(OV_END >= (size_t)T * DFF * 2, "hidden overlay fits");
static_assert(M_KCN + (size_t)2 * 32 * 64 * 160 * 2 <= 4194304, "misc region");
static_assert(WS_END <= 268435456, "workspace map within 256 MiB");
enum { SQ_X0 = 0, SQ_X1 = 1, SQ_XF = 2, SQ_2A = 3, SQ_2B = 4, SQ_QA = 5, SQ_QB = 6, SQ_KVA = 7, SQ_KVB = 8, SQ_MA = 9, SQ_MB = 10 };

struct Args { const float* in[31]; float* out; unsigned char* ws; };
enum { I_XP = 0, I_XS, I_CKV, I_CPE, I_SHG, I_S5RE, I_S5IM, I_N1G, I_WIN, I_LRE, I_LIM, I_LDT, I_BRE, I_BIM, I_CRE, I_CIM, I_S5D, I_WGLU, I_BGLU, I_LBL, I_QNG, I_WUQ, I_KVNG,
       I_WUK, I_WUV, I_ONG, I_WOUT, I_N2G, I_WUP, I_WDN, I_FNG };

struct Ctx {
    const float* const* in; float* out; unsigned char* ws; char* lds; int tid, lane, wave, G, blk;
    DI float* ssq(int i) const { return (float*)(ws + WS_SSQ + (size_t)i * SSQ_STRIDE); }
    DI bf16* wgt(int l, size_t off) const { return (bf16*)(ws + WS_W + (size_t)l * W_LAYER + off); }
    DI bf16* XB() const { return (bf16*)(ws + WS_XB); }
    DI bf16* PROJ() const { return (bf16*)(ws + WS_OV + OV_PROJ); }
    DI bf16* QF() const { return (bf16*)(ws + WS_OV + OV_QF); }
    DI bf16* KVF() const { return (bf16*)(ws + WS_OV + OV_KVF); }
    DI bf16* KPEB() const { return (bf16*)(ws + WS_OV + OV_KPE); }
    DI bf16* MIX() const { return (bf16*)(ws + WS_OV + OV_MIX); }
    DI bf16* HID() const { return (bf16*)(ws + WS_OV); }
    DI float* GT() const { return (float*)(ws + WS_OV + OV_GT); }
    DI float* DD() const { return (float*)(ws + WS_OV + OV_DD); }
    DI float* EBM() const { return (float*)(ws + WS_OV + OV_EBM); }
    DI float* E5() const { return (float*)(ws + WS_OV + OV_E5); }
    DI float* misc(size_t off) const { return (float*)(ws + WS_MISC + off); }
    DI bf16* KCN() const { return (bf16*)(ws + WS_MISC + M_KCN); }
    DI unsigned* ctr() const { return (unsigned*)(ws + WS_ZERO); }
};
DI int pos_of_row(int row) { return row < TP ? row : PAST + ((row - TP) & 15); }

namespace pg8 {
struct EpiG1 {
    static constexpr bool PERM = true, AFTER_DRAIN = false;
    bf16_t* O; const float* ssq; float* ssq_q; float* ssq_kv;
    __device__ __forceinline__ void operator()(const f32x4 (&acc)[2][2][4][2], const Unit& u, int wr, int wc, int fr, int fq) const {
        const int row0 = u.pm * BM + wr * 64 + fr, col0 = u.pn * BM + wc * 32 + 8 * fq;
#pragma unroll
        for (int ai = 0; ai < 2; ++ai)
#pragma unroll
            for (int m = 0; m < 4; ++m) {
                const int row = row0 + ai * HALF + m * 16; const float sc = rsqrtf(ssq[row] * (1.f / 1024.f) + 1e-5f); float s2[2];
#pragma unroll
                for (int bj = 0; bj < 2; ++bj) { const f32x4 v0 = acc[ai][bj][m][0] * sc, v1 = acc[ai][bj][m][1] * sc;
                    u32x4 w; w.x = cvt_pk_bf16(v0[0], v0[1]); w.y = cvt_pk_bf16(v0[2], v0[3]); w.z = cvt_pk_bf16(v1[0], v1[1]); w.w = cvt_pk_bf16(v1[2], v1[3]);
                    *(u32x4*)(O + (size_t)row * 1792 + col0 + bj * HALF) = w;
                    s2[bj] = (v0[0] * v0[0] + v0[1] * v0[1]) + (v0[2] * v0[2] + v0[3] * v0[3]) + (v1[0] * v1[0] + v1[1] * v1[1]) + (v1[2] * v1[2] + v1[3] * v1[3]); }
                if (u.pn == 5 || u.pn == 6) { float s = (u.pn == 5) ? s2[0] + s2[1] : s2[0]; s += __shfl_xor(s, 16); s += __shfl_xor(s, 32);
                    if (fq == 0) atomicAdd((u.pn == 5 ? ssq_q : ssq_kv) + row, s); }
            }
    }
};
struct EpiQ {
    static constexpr bool PERM = true, AFTER_DRAIN = false;
    bf16_t* O; const float* ssq;
    __device__ __forceinline__ void operator()(const f32x4 (&acc)[2][2][4][2], const Unit& u, int wr, int wc, int fr, int fq) const {
        const int row0 = u.pm * BM + wr * 64 + fr; int coff[2];
#pragma unroll
        for (int bj = 0; bj < 2; ++bj) { const int c = u.pn * BM + bj * HALF + wc * 32 + 8 * fq; int h, d;
            if (c < 512) { h = c >> 6; d = c & 63; } else { const int j = (c - 512) & 127; h = j >> 4; d = 64 + 16 * ((c - 512) >> 7) + (j & 15); }
            coff[bj] = h * 96 + d; }
        bf16_t* Ob = O + (size_t)row0 * 768;
#pragma unroll
        for (int ai = 0; ai < 2; ++ai)
#pragma unroll
            for (int m = 0; m < 4; ++m) {
                const int dr = ai * HALF + m * 16; const float sc = rsqrtf(ssq[row0 + dr] * (1.f / 256.f) + 1e-5f) * 0.14724444f;
#pragma unroll
                for (int bj = 0; bj < 2; ++bj) { const f32x4 v0 = acc[ai][bj][m][0] * sc, v1 = acc[ai][bj][m][1] * sc;
                    u32x4 w; w.x = cvt_pk_bf16(v0[0], v0[1]); w.y = cvt_pk_bf16(v0[2], v0[3]); w.z = cvt_pk_bf16(v1[0], v1[1]); w.w = cvt_pk_bf16(v1[2], v1[3]);
                    *(u32x4*)(Ob + dr * 768 + coff[bj]) = w; }
                asm volatile("" ::: "memory");
            }
    }
};
struct EpiScaleStore {
    static constexpr bool PERM = true, AFTER_DRAIN = false;
    bf16_t* O; int ldc; const float* ssq; float inv_n;
    __device__ __forceinline__ void operator()(const f32x4 (&acc)[2][2][4][2], const Unit& u, int wr, int wc, int fr, int fq) const {
        const int row0 = u.pm * BM + wr * 64 + fr, col0 = u.pn * BM + wc * 32 + 8 * fq; bf16_t* Ob = O + (size_t)row0 * 1024 + col0;
#pragma unroll
        for (int ai = 0; ai < 2; ++ai)
#pragma unroll
            for (int m = 0; m < 4; ++m) {
                const int dr = ai * HALF + m * 16; const float sc = rsqrtf(ssq[row0 + dr] * (1.f / 128.f) + 1e-5f);
#pragma unroll
                for (int bj = 0; bj < 2; ++bj) { const f32x4 v0 = acc[ai][bj][m][0] * sc, v1 = acc[ai][bj][m][1] * sc;
                    u32x4 w; w.x = cvt_pk_bf16(v0[0], v0[1]); w.y = cvt_pk_bf16(v0[2], v0[3]); w.z = cvt_pk_bf16(v1[0], v1[1]); w.w = cvt_pk_bf16(v1[2], v1[3]);
                    *(u32x4*)(Ob + dr * 1024 + bj * HALF) = w; }
                asm volatile("" ::: "memory");
            }
    }
};
struct EpiUp {
    static constexpr bool PERM = true, AFTER_DRAIN = false;
    bf16_t* O; const float* ssq;
    __device__ __forceinline__ void operator()(const f32x4 (&acc)[2][2][4][2], const Unit& u, int wr, int wc, int fr, int fq) const {
        const int row0 = u.pm * BM + wr * 64 + fr, col0 = u.pn * BM + wc * 32 + 8 * fq;
#pragma unroll
        for (int ai = 0; ai < 2; ++ai)
#pragma unroll
            for (int m = 0; m < 4; ++m) {
                const int row = row0 + ai * HALF + m * 16; const float sc = rsqrtf(ssq[row] * (1.f / 1024.f) + 1e-5f);
#pragma unroll
                for (int bj = 0; bj < 2; ++bj) { f32x4 v0 = acc[ai][bj][m][0] * sc, v1 = acc[ai][bj][m][1] * sc;
#pragma unroll
                    for (int e = 0; e < 4; ++e) { v0[e] = fmaxf(v0[e], 0.f); v1[e] = fmaxf(v1[e], 0.f); }
                    v0 = v0 * v0; v1 = v1 * v1;
                    u32x4 w; w.x = cvt_pk_bf16(v0[0], v0[1]); w.y = cvt_pk_bf16(v0[2], v0[3]); w.z = cvt_pk_bf16(v1[0], v1[1]); w.w = cvt_pk_bf16(v1[2], v1[3]);
                    *(u32x4*)(O + (size_t)row * 4096 + col0 + bj * HALF) = w; }
            }
    }
};
struct EpiRes {
    static constexpr bool PERM = true, AFTER_DRAIN = false;
    float* X; bf16_t* XB; float* ssq_out;
    __device__ __forceinline__ void operator()(const f32x4 (&acc)[2][2][4][2], const Unit& u, int wr, int wc, int fr, int fq) const {
        const int row0 = u.pm * BM + wr * 64 + fr, col0 = u.pn * BM + wc * 32 + 8 * fq;
#pragma unroll
        for (int ai = 0; ai < 2; ++ai)
#pragma unroll
            for (int m = 0; m < 4; ++m) {
                const int row = row0 + ai * HALF + m * 16; float s = 0.f;
#pragma unroll
                for (int bj = 0; bj < 2; ++bj) { float* xp = X + (size_t)row * 1024 + col0 + bj * HALF;
                    const f32x4 v0 = *(const f32x4*)xp + acc[ai][bj][m][0], v1 = *(const f32x4*)(xp + 4) + acc[ai][bj][m][1];
                    *(f32x4*)xp = v0; *(f32x4*)(xp + 4) = v1;
                    u32x4 w; w.x = cvt_pk_bf16(v0[0], v0[1]); w.y = cvt_pk_bf16(v0[2], v0[3]); w.z = cvt_pk_bf16(v1[0], v1[1]); w.w = cvt_pk_bf16(v1[2], v1[3]);
                    *(u32x4*)(XB + (size_t)row * 1024 + col0 + bj * HALF) = w;
                    s += (v0[0] * v0[0] + v0[1] * v0[1]) + (v0[2] * v0[2] + v0[3] * v0[3]) + (v1[0] * v1[0] + v1[1] * v1[1]) + (v1[2] * v1[2] + v1[3] * v1[3]); }
                s += __shfl_xor(s, 16); s += __shfl_xor(s, 32);
                if (fq == 0) atomicAdd(ssq_out + row, s);
            }
    }
};
}

DI int uq_dest(int n) { const int h = n / 96, d = n - h * 96; return d < 64 ? h * 64 + d : (d < 80 ? 512 + h * 16 + (d - 64) : 640 + h * 16 + (d - 80)); }
DI void p0_transpose_item(const float* W, int K, int N, const float* gain, bf16* WT, int row_off, int kind, float* scr, int item, int lane) {
    const int nblk = N / 32, kb = item / nblk, nb = item % nblk, k0 = 64 * kb, n0 = 32 * nb;
#pragma unroll 8
    for (int i = 0; i < 32; ++i) { const int kk = 2 * i + (lane >> 5); float v = W[(size_t)(k0 + kk) * N + n0 + (lane & 31)]; if (gain) v *= gain[k0 + kk]; scr[kk * 33 + (lane & 31)] = v; }
    __builtin_amdgcn_s_waitcnt(0); asm volatile("" ::: "memory");
    const int c = lane & 7;
#pragma unroll
    for (int j = 0; j < 4; ++j) { const int n = (lane >> 3) + 8 * j; const float* s = scr + (8 * c) * 33 + n;
        u32x4 o; o.x = pk2(s[0 * 33], s[1 * 33]); o.y = pk2(s[2 * 33], s[3 * 33]); o.z = pk2(s[4 * 33], s[5 * 33]); o.w = pk2(s[6 * 33], s[7 * 33]);
        const int dr = kind == 0 ? row_off + n0 + n : uq_dest(n0 + n);
        *(u32x4*)(WT + (size_t)dr * K + k0 + 8 * c) = o; }
    __builtin_amdgcn_s_waitcnt(0); asm volatile("" ::: "memory");
}
DI void p0_prologue(const Ctx& C) {
    float* scr = (float*)(C.lds + C.wave * 16384);
    const int gw = C.blk * NWAVE + C.wave, NGW = C.G * NWAVE, gt = C.blk * NTHR + C.tid, NGT = C.G * NTHR;
    constexpr int I_IN = 16 * 53, I_UQ = 4 * 24, I_UK = 2 * 16, I_OUT = 16 * 32, I_UPN = 16 * 128, I_DNN = 64 * 32, I_GL = 4 * 8;
    constexpr int PER_L = I_IN + I_UQ + 2 * I_UK + I_OUT + I_UPN + I_DNN + I_GL;
    for (int it = gw; it < 2 * PER_L; it += NGW) {
        const int l = it / PER_L; int r = it - l * PER_L;
        if (r < I_IN) { p0_transpose_item(C.in[I_WIN] + (size_t)l * 1024 * INW, 1024, INW, C.in[I_N1G] + l * 1024, C.wgt(l, W_IN), 0, 0, scr, r, C.lane); continue; } r -= I_IN;
        if (r < I_UQ) { p0_transpose_item(C.in[I_WUQ] + (size_t)l * 256 * 768, 256, 768, C.in[I_QNG] + l * 256, C.wgt(l, W_UQ), 0, 1, scr, r, C.lane); continue; } r -= I_UQ;
        if (r < I_UK) { p0_transpose_item(C.in[I_WUK] + (size_t)l * 128 * 512, 128, 512, C.in[I_KVNG] + l * 128, C.wgt(l, W_KV), 0, 0, scr, r, C.lane); continue; } r -= I_UK;
        if (r < I_UK) { p0_transpose_item(C.in[I_WUV] + (size_t)l * 128 * 512, 128, 512, C.in[I_KVNG] + l * 128, C.wgt(l, W_KV), 512, 0, scr, r, C.lane); continue; } r -= I_UK;
        if (r < I_OUT) { p0_transpose_item(C.in[I_WOUT] + (size_t)l * 1024 * 1024, 1024, 1024, C.in[I_ONG] + l * 1024, C.wgt(l, W_OUT), 0, 0, scr, r, C.lane); continue; } r -= I_OUT;
        if (r < I_UPN) { p0_transpose_item(C.in[I_WUP] + (size_t)l * 1024 * 4096, 1024, 4096, C.in[I_N2G] + l * 1024, C.wgt(l, W_UP), 0, 0, scr, r, C.lane); continue; } r -= I_UPN;
        if (r < I_DNN) { p0_transpose_item(C.in[I_WDN] + (size_t)l * 4096 * 1024, 4096, 1024, nullptr, C.wgt(l, W_DN), 0, 0, scr, r, C.lane); continue; } r -= I_DNN;
        p0_transpose_item(C.in[I_WGLU] + (size_t)l * 256 * 256, 256, 256, nullptr, C.wgt(l, W_GLU), 0, 0, scr, r, C.lane);
    }
    for (int i = gt; i < 2 * 96 * 1024 / 8; i += NGT) { const int l = i / (96 * 128), r = i - l * (96 * 128); *(u32x4*)(C.wgt(l, W_IN) + (size_t)INW * 1024 + (size_t)r * 8) = (u32x4){0u, 0u, 0u, 0u}; }
    for (int i = gt; i < 2 * 32 * 64 * 160 / 8; i += NGT) *(u32x4*)(C.KCN() + (size_t)i * 8) = (u32x4){0u, 0u, 0u, 0u};
    float* X = C.out + O_X; bf16* XB = C.XB(); float* sq = C.ssq(SQ_X0);
    for (int m = gw; m < T; m += NGW) {
        const float* src = m < TP ? C.in[I_XP] + (size_t)m * DM : C.in[I_XS] + (size_t)(m - TP) * DM; float s = 0.f;
#pragma unroll
        for (int j = 0; j < 4; ++j) { const f32x4 v = *(const f32x4*)(src + 256 * j + 4 * C.lane); *(f32x4*)(X + (size_t)m * DM + 256 * j + 4 * C.lane) = v;
            u32x2 w; w.x = pk2(v[0], v[1]); w.y = pk2(v[2], v[3]); *(u32x2*)(XB + (size_t)m * DM + 256 * j + 4 * C.lane) = w; s += (v[0] * v[0] + v[1] * v[1]) + (v[2] * v[2] + v[3] * v[3]); }
        s = wave_sum(s); if (C.lane == 0) sq[m] = s;
    }
    for (int i = gt; i < 2 * 16 * 64; i += NGT) {
        const int l = i >> 10, g = (i >> 6) & 15;
        const float dt = expf(C.in[I_LDT][l * 16 + g]), lr = C.in[I_LRE][i], li = C.in[I_LIM][i];
        const float mag = expf(lr * dt); float sn, cs; sincosf(li * dt, &sn, &cs); const float abr = mag * cs, abi = mag * sn;
        const float den = lr * lr + li * li, ir = lr / den, ii = -li / den;
        const float zr = (abr - 1.f) * ir - abi * ii, zi = (abr - 1.f) * ii + abi * ir;
        float* AB = C.misc(M_AB); AB[2 * i] = abr; AB[2 * i + 1] = abi;
        float* BR = C.misc(M_BBRE) + (size_t)i * 16; float* BI = C.misc(M_BBIM) + (size_t)i * 16;
        for (int h = 0; h < 16; ++h) { const float br = C.in[I_BRE][(size_t)i * 16 + h], bi = C.in[I_BIM][(size_t)i * 16 + h]; BR[h] = zr * br - zi * bi; BI[h] = zr * bi + zi * br; }
    }
    for (int i = gt; i < 256; i += NGT) { const float a = C.in[I_LBL][i], b = C.in[I_LBL][256 + i]; const float mx = fmaxf(a, b), ea = expf(a - mx), eb = expf(b - mx);
        C.misc(M_LB)[i] = 0.f; C.misc(M_LB)[256 + i] = eb / (ea + eb); }
    for (int i = gt; i < 16384 * 16; i += NGT) { const int pos = i >> 4, k = i & 15; const double inv = pow(10000.0, -(double)k / 16.0); const double a = (double)pos * inv;
        C.misc(M_COS)[i] = (float)cos(a); C.misc(M_SIN)[i] = (float)sin(a); }
}

DI void misc_rows(const Ctx& C, int l) {
    const int gw = C.blk * NWAVE + C.wave, NGW = C.G * NWAVE; const bf16* P = C.PROJ(); const float* sq = C.ssq(SQ_KVA + l);
    const float* g = C.in[I_KVNG] + l * 128; const float* cs = C.misc(M_COS); const float* sn = C.misc(M_SIN);
    for (int m = gw; m < T; m += NGW) {
        const float r = rsqrtf(sq[m] * (1.f / 128.f) + EPS); const int lane = C.lane;
        const unsigned w = *(const unsigned*)(P + (size_t)m * INP + C_CKV + 2 * lane);
        const float c0 = bflo(w) * r * g[2 * lane], c1 = bfhi(w) * r * g[2 * lane + 1];
        float k1 = 0.f, k2 = 0.f;
        if (lane < 16) { const float x1 = bf2f(P[(size_t)m * INP + C_KPE + lane]), x2 = bf2f(P[(size_t)m * INP + C_KPE + 16 + lane]); const int pos = pos_of_row(m);
            const float c = cs[pos * 16 + lane], s = sn[pos * 16 + lane]; k1 = x1 * c - x2 * s; k2 = x2 * c + x1 * s; }
        if (m < TP) {
            float* okv = C.out + O_PKV + ((size_t)l * TP + m) * 128; *(f32x2_t*)(okv + 2 * lane) = (f32x2_t){c0, c1};
            if (lane < 16) { float* ope = C.out + O_PPE + ((size_t)l * TP + m) * 32; ope[lane] = k1; ope[16 + lane] = k2; bf16* kb = C.KPEB() + (size_t)m * 32; kb[lane] = f2bf(k1); kb[16 + lane] = f2bf(k2); }
        } else {
            const int bi = m - TP, b = bi >> 4, i = bi & 15;
            float* okv = C.out + O_SKV + ((size_t)l * TS + bi) * 128; *(f32x2_t*)(okv + 2 * lane) = (f32x2_t){c0, c1};
            bf16* kc = C.KCN() + ((size_t)(l * 32 + b) * 64 + i) * 160; *(unsigned*)(kc + 2 * lane) = pk2(c0, c1);
            if (lane < 16) { float* ope = C.out + O_SPE + ((size_t)l * TS + bi) * 32; ope[lane] = k1; ope[16 + lane] = k2; kc[128 + lane] = f2bf(k1); kc[144 + lane] = f2bf(k2); }
        }
    }
}

constexpr int S5_UP = 528, S5_HP = 272, S5_HS = 33792;
template <bool FINAL> DI void s5_item(const Ctx& C, int l, int ci) {
    const int lane = C.lane, w = C.wave, r = lane & 31, h = lane >> 5;
    const bool samp = ci >= 256; const int b = ci - 256; const int row0 = samp ? TP + b * 16 : ci * 64; const int ntok = samp ? 16 : 64;
    char* UZ = C.lds; char* HS = C.lds + S5_HS + w * (32 * S5_HP);
    const bf16* P = C.PROJ();
    for (int i = C.tid; i < 2048; i += NTHR) { const int t = i >> 5, c8 = i & 31; u32x4 v = (u32x4){0u, 0u, 0u, 0u}; if (t < ntok) v = *(const u32x4*)(P + (size_t)(row0 + t) * INP + c8 * 8); *(u32x4*)(UZ + t * S5_UP + c8 * 16) = v; }
    __syncthreads();
    for (int gi = 0; gi < 2; ++gi) {
        const int g = 2 * w + gi; const int sidx = (l * 16 + g) * 64 + lane;
        float bbr[16], bbi[16];
        { const float* BR = C.misc(M_BBRE) + (size_t)sidx * 16; const float* BI = C.misc(M_BBIM) + (size_t)sidx * 16;
#pragma unroll
          for (int q = 0; q < 4; ++q) { const f32x4 a = *(const f32x4*)(BR + 4 * q), c = *(const f32x4*)(BI + 4 * q);
#pragma unroll
              for (int e = 0; e < 4; ++e) { bbr[4 * q + e] = a[e]; bbi[4 * q + e] = c[e]; } } }
        const float abr = C.misc(M_AB)[2 * sidx], abi = C.misc(M_AB)[2 * sidx + 1];
        float hr = 0.f, hi = 0.f;
        if (FINAL) {
            if (samp) { hr = C.in[I_S5RE][((size_t)(l * 32 + b) * 16 + g) * 64 + lane]; hi = C.in[I_S5IM][((size_t)(l * 32 + b) * 16 + g) * 64 + lane]; }
            else { float pr = abr, pi = abi;
#pragma unroll
                for (int q = 0; q < 6; ++q) { const float nr = pr * pr - pi * pi, ni = 2.f * pr * pi; pr = nr; pi = ni; }
                const float* E = C.E5() + ((size_t)g * 64 + lane) * 2;
                for (int c = 0; c < ci; ++c) { const f32x2_t e = *(const f32x2_t*)(E + (size_t)c * 2048); const float nr = pr * hr - pi * hi + e.x, ni = pr * hi + pi * hr + e.y; hr = nr; hi = ni; } }
        }
        bf16x8 cf[8];
        if (FINAL) {
#pragma unroll
            for (int ks = 0; ks < 8; ++ks) { f32x4 a = (f32x4){0.f, 0.f, 0.f, 0.f}, c = a;
                if (r < 16) { const float* src = (ks < 4 ? C.in[I_CRE] : C.in[I_CIM]) + ((size_t)(l * 16 + g) * 16 + r) * 64 + 16 * (ks & 3) + 8 * h; a = *(const f32x4*)src; c = *(const f32x4*)(src + 4); if (ks >= 4) { a = -a; c = -c; } }
                cf[ks] = packf8(a[0], a[1], a[2], a[3], c[0], c[1], c[2], c[3]); }
        }
        const float dch = (FINAL && r < 16) ? C.in[I_S5D][l * 256 + g * 16 + r] : 0.f;
        for (int half = 0; half < 2; ++half) {
            if (half * 32 >= ntok) break;
            for (int tt = 0; tt < 32; ++tt) {
                const int t = half * 32 + tt;
                if (t < ntok) {
                    const u32x4 u0 = *(const u32x4*)(UZ + t * S5_UP + g * 32), u1 = *(const u32x4*)(UZ + t * S5_UP + g * 32 + 16);
                    float uu[16]; uu[0] = bflo(u0.x); uu[1] = bfhi(u0.x); uu[2] = bflo(u0.y); uu[3] = bfhi(u0.y); uu[4] = bflo(u0.z); uu[5] = bfhi(u0.z); uu[6] = bflo(u0.w); uu[7] = bfhi(u0.w);
                    uu[8] = bflo(u1.x); uu[9] = bfhi(u1.x); uu[10] = bflo(u1.y); uu[11] = bfhi(u1.y); uu[12] = bflo(u1.z); uu[13] = bfhi(u1.z); uu[14] = bflo(u1.w); uu[15] = bfhi(u1.w);
                    float br = 0.f, bi = 0.f;
#pragma unroll
                    for (int q = 0; q < 16; ++q) { br += bbr[q] * uu[q]; bi += bbi[q] * uu[q]; }
                    const float nr = abr * hr - abi * hi + br, ni = abr * hi + abi * hr + bi; hr = nr; hi = ni;
                }
                if (FINAL) { *(bf16*)(HS + tt * S5_HP + lane * 2) = f2bf(hr); *(bf16*)(HS + tt * S5_HP + 128 + lane * 2) = f2bf(hi); }
            }
            if (FINAL) {
                f32x16 acc = {};
#pragma unroll
                for (int ks = 0; ks < 8; ++ks) acc = MFMA32(lds16(HS + r * S5_HP + (16 * ks + 8 * h) * 2), cf[ks], acc);
                if (r < 16) { const int ch = g * 16 + r;
#pragma unroll
                    for (int i = 0; i < 16; ++i) { const int t = half * 32 + crow(i, h);
                        if (t < ntok) { bf16* zp = (bf16*)(UZ + t * S5_UP + ch * 2); const float y = acc[i] + dch * bf2f(*zp);
                            const float a = 0.7978845608f * (y + 0.044715f * y * y * y); const float th = 1.f - 2.f / (1.f + __expf(2.f * a)); *zp = f2bf(0.5f * y * (1.f + th)); } } }
            }
        }
        if (FINAL) {
            if (samp) { C.out[O_SRE + ((size_t)(l * 32 + b) * 16 + g) * 64 + lane] = hr; C.out[O_SIM + ((size_t)(l * 32 + b) * 16 + g) * 64 + lane] = hi; }
            else if (ci == 255) { C.out[O_PRE + ((size_t)l * 16 + g) * 64 + lane] = hr; C.out[O_PIM + ((size_t)l * 16 + g) * 64 + lane] = hi; }
        } else { *(f32x2_t*)(C.E5() + ((size_t)ci * 1024 + g * 64 + lane) * 2) = (f32x2_t){hr, hi}; }
    }
    if (FINAL) {
        __syncthreads();
        f32x16 ga[2] = {{}, {}};
        const bf16* WG = C.wgt(l, W_GLU);
#pragma unroll 4
        for (int ks = 0; ks < 16; ++ks) { const bf16x8 bfr = *(const bf16x8*)(WG + (size_t)(32 * w + r) * 256 + 16 * ks + 8 * h);
            ga[0] = MFMA32(lds16(UZ + r * S5_UP + (16 * ks + 8 * h) * 2), bfr, ga[0]); ga[1] = MFMA32(lds16(UZ + (32 + r) * S5_UP + (16 * ks + 8 * h) * 2), bfr, ga[1]); }
        __syncthreads();
        const int n = 32 * w + r; const float bg = C.in[I_BGLU][l * 256 + n];
#pragma unroll
        for (int rb = 0; rb < 2; ++rb)
#pragma unroll
            for (int i = 0; i < 16; ++i) { const int t = 32 * rb + crow(i, h); bf16* zp = (bf16*)(UZ + t * S5_UP + n * 2); const float z = bf2f(*zp); *zp = f2bf(z * sigmoidf_(ga[rb][i] + bg)); }
        __syncthreads();
        { const int t = C.tid >> 3, s8 = C.tid & 7; float v[32]; float s = 0.f;
#pragma unroll
          for (int q = 0; q < 4; ++q) { const u32x4 u = *(const u32x4*)(UZ + t * S5_UP + s8 * 64 + q * 16);
              v[8 * q] = bflo(u.x); v[8 * q + 1] = bfhi(u.x); v[8 * q + 2] = bflo(u.y); v[8 * q + 3] = bfhi(u.y); v[8 * q + 4] = bflo(u.z); v[8 * q + 5] = bfhi(u.z); v[8 * q + 6] = bflo(u.w); v[8 * q + 7] = bfhi(u.w); }
#pragma unroll
          for (int q = 0; q < 32; ++q) s += v[q] * v[q];
          s += __shfl_xor(s, 1); s += __shfl_xor(s, 2); s += __shfl_xor(s, 4);
          const float rn = rsqrtf(s * (1.f / 256.f) + EPS);
          if (t < ntok) { bf16* dst = C.MIX() + (size_t)(row0 + t) * DM + s8 * 32;
#pragma unroll
              for (int q = 0; q < 4; ++q) { u32x4 o; o.x = pk2(v[8 * q] * rn, v[8 * q + 1] * rn); o.y = pk2(v[8 * q + 2] * rn, v[8 * q + 3] * rn); o.z = pk2(v[8 * q + 4] * rn, v[8 * q + 5] * rn); o.w = pk2(v[8 * q + 6] * rn, v[8 * q + 7] * rn);
                  *(u32x4*)(dst + 8 * q) = o; } } }
    }
    __syncthreads();
}

constexpr int HG_P = 136, HG_WB = 2 * 64 * HG_P;
DI void hgrn_local(const Ctx& C, int l, int it) {
    const int lane = C.lane, r = lane & 31, h = lane >> 5; const int ci = it >> 2, hd = it & 3;
    const bool samp = ci >= 256; const int row0 = samp ? TP + (ci - 256) * 16 : ci * 64; const int ntok = samp ? 16 : 64, tref = (ntok >> 1) - 1;
    char* KT = C.lds + C.wave * HG_WB; char* VT = KT + 64 * HG_P; bf16* P = C.PROJ();
    const float lb = C.misc(M_LB)[l * 256 + hd * 64 + lane], omlb = 1.f - lb;
    float b = 0.f, bref = 0.f;
    for (int t = 0; t < ntok; ++t) { const float fp = bf2f(P[(size_t)(row0 + t) * INP + C_HF + hd * 64 + lane]); const float f = lb + omlb * sigmoidf_(fp); b += __logf(f); if (t == tref) bref = b; }
    const float blast = b; b = 0.f;
    for (int t = 0; t < 64; ++t) {
        float qt = 0.f, kt = 0.f, vv = 0.f;
        if (t < ntok) { bf16* pq = P + (size_t)(row0 + t) * INP + C_HQ + hd * 64 + lane; bf16* pf = P + (size_t)(row0 + t) * INP + C_HF + hd * 64 + lane;
            const float fp = bf2f(*pf), hq = bf2f(*pq); const float sg = sigmoidf_(fp); const float f = lb + omlb * sg; b += __logf(f);
            qt = hq * sigmoidf_(hq) * __expf(b - bref); kt = omlb * (1.f - sg) * __expf(bref - b);
            *pq = f2bf(qt); *pf = f2bf(kt); vv = bf2f(P[(size_t)(row0 + t) * INP + C_HI + hd * 64 + lane]); }
        *(bf16*)(KT + lane * HG_P + t * 2) = f2bf(kt); *(bf16*)(VT + lane * HG_P + t * 2) = f2bf(vv);
    }
    C.DD()[(size_t)ci * 256 + hd * 64 + lane] = __expf(blast); C.EBM()[(size_t)ci * 256 + hd * 64 + lane] = __expf(bref);
    const float scg = __expf(blast - bref);
    f32x16 acc[2][2] = {{{}, {}}, {{}, {}}};
#pragma unroll
    for (int ks = 0; ks < 4; ++ks) { bf16x8 a[2], bb[2];
#pragma unroll
        for (int q = 0; q < 2; ++q) { a[q] = lds8x2(VT + (32 * q + r) * HG_P + (16 * ks + 8 * h) * 2); bb[q] = lds8x2(KT + (32 * q + r) * HG_P + (16 * ks + 8 * h) * 2); }
#pragma unroll
        for (int vb = 0; vb < 2; ++vb)
#pragma unroll
            for (int db = 0; db < 2; ++db) acc[vb][db] = MFMA32(a[vb], bb[db], acc[vb][db]); }
    float* G = C.GT() + ((size_t)ci * 4 + hd) * 4096;
#pragma unroll
    for (int db = 0; db < 2; ++db) { const float sc = __shfl(scg, 32 * db + r);
#pragma unroll
        for (int vb = 0; vb < 2; ++vb)
#pragma unroll
            for (int i = 0; i < 16; ++i) G[(32 * vb + crow(i, h)) * 64 + 32 * db + r] = acc[vb][db][i] * sc; }
}
DI void hgrn_prefix(const Ctx& C, int l) {
    const int e = C.blk * NTHR + C.tid;
    if (e < 16384) { const int hd = e >> 12, vd = e & 4095, d = vd & 63, v = vd >> 6; float* G = C.GT() + (size_t)hd * 4096 + vd; const float* D = C.DD() + hd * 64 + d; float S = 0.f;
        for (int c0 = 0; c0 < 256; c0 += 16) { float g[16], dd[16];
#pragma unroll
            for (int q = 0; q < 16; ++q) { g[q] = G[(size_t)(c0 + q) * 16384]; dd[q] = D[(size_t)(c0 + q) * 256]; }
#pragma unroll
            for (int q = 0; q < 16; ++q) { G[(size_t)(c0 + q) * 16384] = S; S = dd[q] * S + g[q]; } }
        C.out[O_PHG + (size_t)l * 16384 + hd * 4096 + d * 64 + v] = S; }
    for (int i = e; i < 32 * 16384; i += C.G * NTHR) { const int b = i >> 14, hv = i & 16383, hd = hv >> 12, vd = hv & 4095, d = vd & 63, v = vd >> 6;
        const float S0 = C.in[I_SHG][((size_t)(l * 32 + b) * 4 + hd) * 4096 + d * 64 + v]; float* G = C.GT() + (size_t)(256 + b) * 16384 + hv;
        const float S1 = C.DD()[(size_t)(256 + b) * 256 + hd * 64 + d] * S0 + *G; *G = S0; C.out[O_SHG + ((size_t)(l * 32 + b) * 4 + hd) * 4096 + d * 64 + v] = S1; }
}
DI void hgrn_final(const Ctx& C, int l, int bi) {
    const int lane = C.lane, r = lane & 31, h = lane >> 5; const int it = bi * 8 + C.wave, ci = it >> 2, hd = it & 3;
    const bool samp = ci >= 256; const int row0 = samp ? TP + (ci - 256) * 16 : ci * 64; const int ntok = samp ? 16 : 64;
    char* VT = C.lds + C.wave * HG_WB; float* SS = (float*)(C.lds + 8 * HG_WB); const bf16* P = C.PROJ();
    for (int t = 0; t < 64; ++t) { float vv = 0.f; if (t < ntok) vv = bf2f(P[(size_t)(row0 + t) * INP + C_HI + hd * 64 + lane]); *(bf16*)(VT + lane * HG_P + t * 2) = f2bf(vv); }
    bf16x8 qf[2][4];
    f32x16 at[2][2] = {{{}, {}}, {{}, {}}};
    const bf16x8 zf = {0, 0, 0, 0, 0, 0, 0, 0};
#pragma unroll
    for (int ks = 0; ks < 4; ++ks) { bf16x8 kf[2];
#pragma unroll
        for (int q = 0; q < 2; ++q) { const int t = 32 * q + r; const bool ok = t < ntok;
            qf[q][ks] = ok ? *(const bf16x8*)(P + (size_t)(row0 + t) * INP + C_HQ + hd * 64 + 16 * ks + 8 * h) : zf;
            kf[q] = ok ? *(const bf16x8*)(P + (size_t)(row0 + t) * INP + C_HF + hd * 64 + 16 * ks + 8 * h) : zf; }
        at[0][0] = MFMA32(kf[0], qf[0][ks], at[0][0]); at[0][1] = MFMA32(kf[0], qf[1][ks], at[0][1]); at[1][1] = MFMA32(kf[1], qf[1][ks], at[1][1]); }
#pragma unroll
    for (int i = 0; i < 16; ++i) { const int s = crow(i, h); if (s > r) { at[0][0][i] = 0.f; at[1][1][i] = 0.f; } }
    f32x16 o[2][2] = {{{}, {}}, {{}, {}}};
#pragma unroll
    for (int sb = 0; sb < 2; ++sb)
#pragma unroll
        for (int tb = sb; tb < 2; ++tb)
#pragma unroll
            for (int s2 = 0; s2 < 2; ++s2) { const f32x16& x = at[sb][tb];
                const bf16x8 pkx = packf8(x[8 * s2], x[8 * s2 + 1], x[8 * s2 + 2], x[8 * s2 + 3], x[8 * s2 + 4], x[8 * s2 + 5], x[8 * s2 + 6], x[8 * s2 + 7]);
#pragma unroll
                for (int vb = 0; vb < 2; ++vb) { const char* vp = VT + (32 * vb + r) * HG_P + (32 * sb + 16 * s2 + 4 * h) * 2;
                    const s16x4 lo = *(const s16x4*)vp, hi = *(const s16x4*)(vp + 16); const bf16x8 a2 = __builtin_shufflevector(lo, hi, 0, 1, 2, 3, 4, 5, 6, 7);
                    o[vb][tb] = MFMA32(a2, pkx, o[vb][tb]); } }
    { const float* S = C.GT() + ((size_t)ci * 4 + hd) * 4096; const float* EB = C.EBM() + (size_t)ci * 256 + hd * 64;
#pragma unroll
      for (int ks = 0; ks < 4; ++ks) { const f32x4 e0 = *(const f32x4*)(EB + 16 * ks + 8 * h), e1 = *(const f32x4*)(EB + 16 * ks + 8 * h + 4);
#pragma unroll
          for (int vb = 0; vb < 2; ++vb) { const float* sp = S + (32 * vb + r) * 64 + 16 * ks + 8 * h; const f32x4 s0 = *(const f32x4*)sp * e0, s1 = *(const f32x4*)(sp + 4) * e1;
              const bf16x8 sf = packf8(s0[0], s0[1], s0[2], s0[3], s1[0], s1[1], s1[2], s1[3]);
              o[vb][0] = MFMA32(sf, qf[0][ks], o[vb][0]); o[vb][1] = MFMA32(sf, qf[1][ks], o[vb][1]); } } }
    float sq[2];
#pragma unroll
    for (int tb = 0; tb < 2; ++tb) { float s = 0.f;
#pragma unroll
        for (int vb = 0; vb < 2; ++vb)
#pragma unroll
            for (int i = 0; i < 16; ++i) s += o[vb][tb][i] * o[vb][tb][i];
        s += __shfl_xor(s, 32); sq[tb] = s; if (h == 0) SS[C.wave * 64 + 32 * tb + r] = s; }
    __syncthreads();
    const int wb = C.wave & 4;
#pragma unroll
    for (int tb = 0; tb < 2; ++tb) { const int t = 32 * tb + r; const float tot = SS[(wb + 0) * 64 + t] + SS[(wb + 1) * 64 + t] + SS[(wb + 2) * 64 + t] + SS[(wb + 3) * 64 + t];
        const float rn = rsqrtf(tot * (1.f / 256.f) + EPS);
        if (t < ntok) {
#pragma unroll
            for (int vb = 0; vb < 2; ++vb)
#pragma unroll
                for (int g4 = 0; g4 < 4; ++g4) { const int v = 32 * vb + 8 * g4 + 4 * h; const u32x2 gw = *(const u32x2*)(P + (size_t)(row0 + t) * INP + C_HG + hd * 64 + v);
                    const float g0 = bflo(gw.x), g1 = bfhi(gw.x), g2 = bflo(gw.y), g3 = bfhi(gw.y);
                    u32x2 ow; ow.x = pk2(o[vb][tb][4 * g4] * rn * g0 * sigmoidf_(g0), o[vb][tb][4 * g4 + 1] * rn * g1 * sigmoidf_(g1)); ow.y = pk2(o[vb][tb][4 * g4 + 2] * rn * g2 * sigmoidf_(g2), o[vb][tb][4 * g4 + 3] * rn * g3 * sigmoidf_(g3));
                    *(u32x2*)(C.MIX() + (size_t)(row0 + t) * DM + 256 + hd * 64 + v) = ow; } } }
    __syncthreads();
}

#ifndef ATT_VTRANS
#define ATT_VTRANS 0
#endif
constexpr int AT_VB = 21504, AT_QS = 32768, AT_OLP = 132;
template <bool SAMPLE> DI void attn_unit(const Ctx& C, int l, int hd_or_b, int qb) {
    constexpr int DQK = SAMPLE ? 160 : 96, DV = SAMPLE ? 128 : 64, KP = SAMPLE ? 336 : 208, VP = SAMPLE ? 336 : 144, NKS = DQK / 16, NVB = DV / 32;
    const int tid = C.tid, lane = C.lane, w = C.wave, r = lane & 31, h = lane >> 5;
    constexpr bool VTR = (!SAMPLE) && (ATT_VTRANS != 0);
    char* KB = C.lds; char* VB = SAMPLE ? C.lds : C.lds + AT_VB; char* QS = C.lds + AT_QS;
    const int ntiles = SAMPLE ? 33 : 4 * qb + 4;
    const int q0 = SAMPLE ? 0 : qb * 256;
    const bool wave_on = SAMPLE ? (w < 4) : true;
    const int wchunk = SAMPLE ? 1000 : 4 * qb + (w >> 1);
    bf16x8 qf[SAMPLE ? 1 : NKS];
    const bf16* KVF = C.KVF(); const bf16* KPE = C.KPEB();
    const float* ckv = SAMPLE ? C.in[I_CKV] + (size_t)(l * 32 + hd_or_b) * PAST * 128 : nullptr;
    const float* cpe = SAMPLE ? C.in[I_CPE] + (size_t)(l * 32 + hd_or_b) * PAST * 32 : nullptr;
    const bf16* kcn = SAMPLE ? C.KCN() + (size_t)(l * 32 + hd_or_b) * 64 * 160 : nullptr;
    u32x4 st0, st1, st2; f32x4 sf[5];
#define AT_PREFETCH(j) do { \
        if (!SAMPLE) { \
            const int key = tm >> 3, part = tm & 7; const size_t row = (size_t)(64 * (j) + key); \
            st0 = *(const u32x4*)(KVF + row * 1024 + hd_or_b * 64 + part * 8); \
            st1 = *(const u32x4*)(KVF + row * 1024 + 512 + hd_or_b * 64 + part * 8); \
            if (tm < 256) st2 = *(const u32x4*)(KPE + (size_t)(64 * (j) + (tm >> 2)) * 32 + (tm & 3) * 8); \
        } else if ((j) < 32) { \
            _Pragma("unroll") \
            for (int i = 0; i < 4; ++i) { const int idx = tm + 512 * i; sf[i] = *(const f32x4*)(ckv + (size_t)(64 * (j) + (idx >> 5)) * 128 + (idx & 31) * 4); } \
            sf[4] = *(const f32x4*)(cpe + (size_t)(64 * (j) + (tm >> 3)) * 32 + (tm & 7) * 4); \
        } else { \
            st0 = *(const u32x4*)(kcn + (size_t)tm * 8); st1 = *(const u32x4*)(kcn + (size_t)(tm + 512) * 8); if (tm < 256) st2 = *(const u32x4*)(kcn + (size_t)(tm + 1024) * 8); \
        } \
    } while (0)
#define AT_COMMIT(j) do { \
        if (!SAMPLE) { \
            const int key = tm >> 3, part = tm & 7; \
            *(u32x4*)(KB + key * KP + part * 16) = st0; \
            if (VTR) { _Pragma("unroll") for (int e_ = 0; e_ < 4; ++e_) { *(bf16*)(VB + (part * 8 + 2 * e_) * 136 + key * 2) = (bf16)(st1[e_] & 0xffffu); *(bf16*)(VB + (part * 8 + 2 * e_ + 1) * 136 + key * 2) = (bf16)(st1[e_] >> 16); } } \
            else *(u32x4*)(VB + key * VP + part * 16) = st1; \
            if (tm < 256) *(u32x4*)(KB + (tm >> 2) * KP + 128 + (tm & 3) * 16) = st2; \
        } else if ((j) < 32) { \
            _Pragma("unroll") \
            for (int i = 0; i < 4; ++i) { const int idx = tm + 512 * i; u32x2 wv; wv.x = pk2(sf[i][0], sf[i][1]); wv.y = pk2(sf[i][2], sf[i][3]); *(u32x2*)(KB + (idx >> 5) * KP + (idx & 31) * 8) = wv; } \
            { u32x2 wv; wv.x = pk2(sf[4][0], sf[4][1]); wv.y = pk2(sf[4][2], sf[4][3]); *(u32x2*)(KB + (tm >> 3) * KP + 256 + (tm & 7) * 8) = wv; } \
        } else { \
            { const int c = tm; *(u32x4*)(KB + (c / 20) * KP + (c % 20) * 16) = st0; } \
            { const int c = tm + 512; *(u32x4*)(KB + (c / 20) * KP + (c % 20) * 16) = st1; } \
            if (tm < 256) { const int c = tm + 1024; *(u32x4*)(KB + (c / 20) * KP + (c % 20) * 16) = st2; } \
        } \
    } while (0)
    int tm = tid;
    if (!SAMPLE) AT_PREFETCH(0);
    if (SAMPLE) {
        const int R = tid >> 2, part = tid & 3, hh = R >> 4, i = R & 15; const bf16* qrow = C.QF() + (size_t)(TP + hd_or_b * 16 + i) * 768 + hh * 96;
        float* QN = (float*)(C.lds + 76800) + R * 64;
        { const u32x4 u0 = *(const u32x4*)(qrow + part * 16), u1 = *(const u32x4*)(qrow + part * 16 + 8);
          *(f32x4*)(QN + part * 16) = (f32x4){bflo(u0.x), bfhi(u0.x), bflo(u0.y), bfhi(u0.y)}; *(f32x4*)(QN + part * 16 + 4) = (f32x4){bflo(u0.z), bfhi(u0.z), bflo(u0.w), bfhi(u0.w)};
          *(f32x4*)(QN + part * 16 + 8) = (f32x4){bflo(u1.x), bfhi(u1.x), bflo(u1.y), bfhi(u1.y)}; *(f32x4*)(QN + part * 16 + 12) = (f32x4){bflo(u1.z), bfhi(u1.z), bflo(u1.w), bfhi(u1.w)}; }
        __syncthreads();
        const float* wuk = C.in[I_WUK] + (size_t)l * 128 * 512 + hh * 64;
#pragma unroll 1
        for (int cc = 0; cc < 32; cc += 2) { float a0 = 0.f, a1 = 0.f; const float* w0 = wuk + (size_t)(part * 32 + cc) * 512; const float* w1 = w0 + 512;
#pragma unroll 2
            for (int q = 0; q < 16; ++q) { const f32x4 qv = *(const f32x4*)(QN + 4 * q); const f32x4 x0 = *(const f32x4*)(w0 + 4 * q), x1 = *(const f32x4*)(w1 + 4 * q);
                a0 += qv[0] * x0[0] + qv[1] * x0[1] + qv[2] * x0[2] + qv[3] * x0[3]; a1 += qv[0] * x1[0] + qv[1] * x1[1] + qv[2] * x1[2] + qv[3] * x1[3]; }
            *(unsigned*)(QS + R * 336 + (part * 32 + cc) * 2) = pk2(a0, a1); }
        if (part < 2) { const int pos = PAST + i; const float* cs = C.misc(M_COS) + pos * 16 + 8 * part; const float* sn = C.misc(M_SIN) + pos * 16 + 8 * part;
            const u32x4 x1 = *(const u32x4*)(qrow + 64 + part * 8), x2 = *(const u32x4*)(qrow + 80 + part * 8); u32x4 y1, y2;
#pragma unroll
            for (int e = 0; e < 4; ++e) { const float a0 = bflo(x1[e]), a1 = bfhi(x1[e]), b0 = bflo(x2[e]), b1 = bfhi(x2[e]); const float c0 = cs[2 * e], c1 = cs[2 * e + 1], s0 = sn[2 * e], s1 = sn[2 * e + 1];
                y1[e] = pk2(a0 * c0 - b0 * s0, a1 * c1 - b1 * s1); y2[e] = pk2(b0 * c0 + a0 * s0, b1 * c1 + a1 * s1); }
            *(u32x4*)(QS + R * 336 + 256 + part * 16) = y1; *(u32x4*)(QS + R * 336 + 288 + part * 16) = y2; }
        __syncthreads();
    } else {
        const bf16* qrow = C.QF() + (size_t)(q0 + 32 * w + r) * 768 + hd_or_b * 96;
#pragma unroll
        for (int ks = 0; ks < NKS; ++ks) qf[ks] = *(const bf16x8*)(qrow + 16 * ks + 8 * h);
        { const int pos = q0 + 32 * w + r; const float* cs = C.misc(M_COS) + pos * 16 + 8 * h; const float* sn = C.misc(M_SIN) + pos * 16 + 8 * h;
          const u32x4 x1 = __builtin_bit_cast(u32x4, qf[4]), x2 = __builtin_bit_cast(u32x4, qf[5]); u32x4 y1, y2;
#pragma unroll
          for (int e = 0; e < 4; ++e) { const float a0 = bflo(x1[e]), a1 = bfhi(x1[e]), b0 = bflo(x2[e]), b1 = bfhi(x2[e]); const float c0 = cs[2 * e], c1 = cs[2 * e + 1], s0 = sn[2 * e], s1 = sn[2 * e + 1];
              y1[e] = pk2(a0 * c0 - b0 * s0, a1 * c1 - b1 * s1); y2[e] = pk2(b0 * c0 + a0 * s0, b1 * c1 + a1 * s1); }
          qf[4] = __builtin_bit_cast(bf16x8, y1); qf[5] = __builtin_bit_cast(bf16x8, y2); }
    }
    if (SAMPLE) { asm volatile("" : "+v"(tm)); AT_PREFETCH(0); }
    float mrun = -1e30f, lrun = 0.f; f32x16 o[NVB];
#pragma unroll
    for (int vb = 0; vb < NVB; ++vb) o[vb] = f32x16{};
    const int i16 = lane & 15, gg = (lane >> 4) & 1;
    const char* vlane = VB + (4 * h + (i16 >> 2)) * VP + (16 * gg + 4 * (i16 & 3)) * 2;
    for (int j = 0; j < ntiles; ++j) {
        __syncthreads();
        AT_COMMIT(j);
        __syncthreads();
        if (j + 1 < ntiles) AT_PREFETCH(j + 1);
        if (wave_on && j <= wchunk) {
            f32x16 p0 = {}, p1 = {};
#pragma unroll
            for (int ks = 0; ks < NKS; ++ks) { const bf16x8 qv = SAMPLE ? lds16(QS + (32 * w + r) * 336 + (16 * ks + 8 * h) * 2) : qf[ks]; p0 = MFMA32(lds16(KB + r * KP + (16 * ks + 8 * h) * 2), qv, p0); p1 = MFMA32(lds16(KB + (32 + r) * KP + (16 * ks + 8 * h) * 2), qv, p1); }
            if (SAMPLE && j == 32) {
#pragma unroll
                for (int i = 0; i < 16; ++i) { if (crow(i, h) >= 16) p0[i] = -1e30f; p1[i] = -1e30f; }
            }
            float mx = p0[0];
#pragma unroll
            for (int i = 1; i < 16; ++i) mx = fmaxf(mx, p0[i]);
#pragma unroll
            for (int i = 0; i < 16; ++i) mx = fmaxf(mx, p1[i]);
            mx = fmaxf(mx, __shfl_xor(mx, 32));
            const float mnew = fmaxf(mrun, mx), alpha = __builtin_amdgcn_exp2f(mrun - mnew); mrun = mnew;
            float ls = 0.f;
#pragma unroll
            for (int i = 0; i < 16; ++i) { p0[i] = __builtin_amdgcn_exp2f(p0[i] - mnew); p1[i] = __builtin_amdgcn_exp2f(p1[i] - mnew); ls += p0[i] + p1[i]; }
            lrun = lrun * alpha + ls;
#pragma unroll
            for (int vb = 0; vb < NVB; ++vb)
#pragma unroll
                for (int i = 0; i < 16; ++i) o[vb][i] *= alpha;
#pragma unroll
            for (int kb = 0; kb < 2; ++kb)
#pragma unroll
                for (int s2 = 0; s2 < 2; ++s2) { const f32x16& x = kb ? p1 : p0;
                    const bf16x8 pkx = packf8(x[8 * s2], x[8 * s2 + 1], x[8 * s2 + 2], x[8 * s2 + 3], x[8 * s2 + 4], x[8 * s2 + 5], x[8 * s2 + 6], x[8 * s2 + 7]);
#pragma unroll
                    for (int vb = 0; vb < NVB; ++vb) { const char* vp = vlane + (32 * kb + 16 * s2) * VP + 64 * vb;
                        s16x4 lo, hi; if (VTR) { const char* vq = VB + (32 * vb + r) * 136 + (32 * kb + 16 * s2 + 4 * h) * 2; lo = *(const s16x4*)vq; hi = *(const s16x4*)(vq + 16); } else { lo = ldtr(vp); hi = ldtr(vp + 8 * VP); }
                        const bf16x8 a2 = __builtin_shufflevector(lo, hi, 0, 1, 2, 3, 4, 5, 6, 7);
                        o[vb] = MFMA32(a2, pkx, o[vb]); }
                    asm volatile("" ::: "memory"); }
        }
    }
    lrun += __shfl_xor(lrun, 32); const float inv = 1.f / lrun;
    if (!SAMPLE) {
        const int row = q0 + 32 * w + r; float s = 0.f; bf16* dst = C.MIX() + (size_t)row * DM + 512 + hd_or_b * 64;
#pragma unroll
        for (int vb = 0; vb < NVB; ++vb)
#pragma unroll
            for (int g4 = 0; g4 < 4; ++g4) { const float a0 = o[vb][4 * g4] * inv, a1 = o[vb][4 * g4 + 1] * inv, a2 = o[vb][4 * g4 + 2] * inv, a3 = o[vb][4 * g4 + 3] * inv;
                s += (a0 * a0 + a1 * a1) + (a2 * a2 + a3 * a3); u32x2 ow; ow.x = pk2(a0, a1); ow.y = pk2(a2, a3); *(u32x2*)(dst + 32 * vb + 8 * g4 + 4 * h) = ow; }
        s += __shfl_xor(s, 32); if (h == 0) atomicAdd(C.ssq(SQ_MA + l) + row, s);
    } else {
        __syncthreads();
        float* OL = (float*)C.lds;
        if (wave_on) {
#pragma unroll
            for (int vb = 0; vb < NVB; ++vb)
#pragma unroll
                for (int i = 0; i < 16; ++i) OL[(32 * w + r) * AT_OLP + 32 * vb + crow(i, h)] = o[vb][i] * inv;
        }
        __syncthreads();
        const int R = tid >> 2, part = tid & 3, hh = R >> 4, i = R & 15; const int row = TP + hd_or_b * 16 + i;
        float acc[16];
#pragma unroll
        for (int q = 0; q < 16; ++q) acc[q] = 0.f;
        const float* wuv = C.in[I_WUV] + (size_t)l * 128 * 512 + hh * 64 + part * 16;
        for (int c = 0; c < 128; ++c) { const float ol = OL[R * AT_OLP + c];
#pragma unroll
            for (int q = 0; q < 4; ++q) { const f32x4 x = *(const f32x4*)(wuv + (size_t)c * 512 + 4 * q); acc[4 * q] += ol * x[0]; acc[4 * q + 1] += ol * x[1]; acc[4 * q + 2] += ol * x[2]; acc[4 * q + 3] += ol * x[3]; } }
        float s = 0.f;
#pragma unroll
        for (int q = 0; q < 16; ++q) s += acc[q] * acc[q];
        bf16* dst = C.MIX() + (size_t)row * DM + 512 + hh * 64 + part * 16;
        u32x4 o0, o1; o0.x = pk2(acc[0], acc[1]); o0.y = pk2(acc[2], acc[3]); o0.z = pk2(acc[4], acc[5]); o0.w = pk2(acc[6], acc[7]); o1.x = pk2(acc[8], acc[9]); o1.y = pk2(acc[10], acc[11]); o1.z = pk2(acc[12], acc[13]); o1.w = pk2(acc[14], acc[15]);
        *(u32x4*)dst = o0; *(u32x4*)(dst + 8) = o1;
        s += __shfl_xor(s, 1); s += __shfl_xor(s, 2); if (part == 0) atomicAdd(C.ssq(SQ_MA + l) + row, s);
    }
}
template <bool SAMPLE> DI void attn_phase(const Ctx& C, int l) {
    unsigned* sched = (unsigned*)(C.lds + LDS_BYTES - 64);
    for (;;) {
        __syncthreads();
        if (C.tid == 0) *sched = atomicAdd(C.ctr() + (SAMPLE ? 24 : 16) + l, 1u);
        __syncthreads();
        const int u = (int)*sched;
        if (u >= (SAMPLE ? 32 : 512)) break;
        if (SAMPLE) attn_unit<true>(C, l, u, 0); else attn_unit<false>(C, l, u & 7, 63 - (u >> 3));
    }
}
DI void mla_finalize(const Ctx& C, int l) {
    const int gw = C.blk * NWAVE + C.wave, NGW = C.G * NWAVE; const float* sq = C.ssq(SQ_MA + l);
    for (int m = gw; m < T; m += NGW) { const float rn = rsqrtf(sq[m] * (1.f / 512.f) + EPS); u32x4* p = (u32x4*)(C.MIX() + (size_t)m * DM + 512 + C.lane * 8); const u32x4 u = *p;
        u32x4 o; o.x = pk2(bflo(u.x) * rn, bfhi(u.x) * rn); o.y = pk2(bflo(u.y) * rn, bfhi(u.y) * rn); o.z = pk2(bflo(u.z) * rn, bfhi(u.z) * rn); o.w = pk2(bflo(u.w) * rn, bfhi(u.w) * rn); *p = o; }
}
DI void final_norm(const Ctx& C) {
    const int gw = C.blk * NWAVE + C.wave, NGW = C.G * NWAVE; const float* sq = C.ssq(SQ_XF); const float* g = C.in[I_FNG];
    for (int m = gw; m < T; m += NGW) { const float rn = rsqrtf(sq[m] * (1.f / 1024.f) + EPS); float* x = C.out + O_X + (size_t)m * DM;
#pragma unroll
        for (int j = 0; j < 4; ++j) { f32x4 v = *(f32x4*)(x + 256 * j + 4 * C.lane); const f32x4 gg = *(const f32x4*)(g + 256 * j + 4 * C.lane); v = v * rn * gg; *(f32x4*)(x + 256 * j + 4 * C.lane) = v; } }
}


#ifndef NAIVE_QKV
#define NAIVE_QKV 0
#endif
DI void naive_q(const Ctx& C, int l) {
    const bf16* P = C.PROJ(); const float* W = C.in[I_WUQ] + (size_t)l * 256 * 768; const float* g = C.in[I_QNG] + l * 256; const float* sq = C.ssq(SQ_QA + l);
    for (size_t i = (size_t)C.blk * NTHR + C.tid; i < (size_t)T * 768; i += (size_t)C.G * NTHR) { const int row = (int)(i / 768), n = (int)(i % 768); float a = 0.f;
        for (int k = 0; k < 256; ++k) a += bf2f(P[(size_t)row * INP + C_CQ + k]) * g[k] * W[(size_t)k * 768 + n];
        C.QF()[i] = f2bf(a * rsqrtf(sq[row] * (1.f / 256.f) + EPS) * QSCALE); }
}
DI void naive_kv(const Ctx& C, int l) {
    const bf16* P = C.PROJ(); const float* Wk = C.in[I_WUK] + (size_t)l * 128 * 512; const float* Wv = C.in[I_WUV] + (size_t)l * 128 * 512; const float* g = C.in[I_KVNG] + l * 128; const float* sq = C.ssq(SQ_KVA + l);
    for (size_t i = (size_t)C.blk * NTHR + C.tid; i < (size_t)TP * 1024; i += (size_t)C.G * NTHR) { const int row = (int)(i >> 10), n = (int)(i & 1023); const float* W = n < 512 ? Wk + n : Wv + (n - 512); float a = 0.f;
        for (int k = 0; k < 128; ++k) a += bf2f(P[(size_t)row * INP + C_CKV + k]) * g[k] * W[(size_t)k * 512];
        C.KVF()[i] = f2bf(a * rsqrtf(sq[row] * (1.f / 128.f) + EPS)); }
}

#ifndef NAIVE_S5
#define NAIVE_S5 0
#endif
#ifndef NAIVE_HG
#define NAIVE_HG 0
#endif
DI void naive_s5_scan(const Ctx& C, int l, float* TMP) {
    const int gw = C.blk * NWAVE + C.wave, NGW = C.G * NWAVE, lane = C.lane; const bf16* P = C.PROJ();
    for (int it = gw; it < 33 * 16; it += NGW) { const int sq = it >> 4, g = it & 15; const bool samp = sq > 0; const int b = sq - 1; const int row0 = samp ? TP + b * 16 : 0, n = samp ? 16 : TP;
        const int sidx = (l * 16 + g) * 64 + lane;
        const float dt = expf(C.in[I_LDT][l * 16 + g]), lr = C.in[I_LRE][sidx], li = C.in[I_LIM][sidx]; const float mag = expf(lr * dt); const float abr = mag * cosf(li * dt), abi = mag * sinf(li * dt);
        const float den = lr * lr + li * li, ir = lr / den, ii = -li / den; const float zr = (abr - 1.f) * ir - abi * ii, zi = (abr - 1.f) * ii + abi * ir;
        float bbr[16], bbi[16], cr[16], cim[16];
#pragma unroll
        for (int h = 0; h < 16; ++h) { const float br = C.in[I_BRE][(size_t)sidx * 16 + h], bi = C.in[I_BIM][(size_t)sidx * 16 + h]; bbr[h] = zr * br - zi * bi; bbi[h] = zr * bi + zi * br;
            cr[h] = C.in[I_CRE][((size_t)(l * 16 + g) * 16 + h) * 64 + lane]; cim[h] = C.in[I_CIM][((size_t)(l * 16 + g) * 16 + h) * 64 + lane]; }
        float hr = 0.f, hi = 0.f; if (samp) { hr = C.in[I_S5RE][((size_t)(l * 32 + b) * 16 + g) * 64 + lane]; hi = C.in[I_S5IM][((size_t)(l * 32 + b) * 16 + g) * 64 + lane]; }
        const float dch = lane < 16 ? C.in[I_S5D][l * 256 + g * 16 + lane] : 0.f;
        for (int t = 0; t < n; ++t) { const bf16* up = P + (size_t)(row0 + t) * INP + g * 16; float br = 0.f, bi = 0.f; float myu = 0.f;
#pragma unroll
            for (int h = 0; h < 16; ++h) { const float u = bf2f(up[h]); br += bbr[h] * u; bi += bbi[h] * u; if (h == lane) myu = u; }
            const float nr = abr * hr - abi * hi + br, ni = abr * hi + abi * hr + bi; hr = nr; hi = ni; float yk = 0.f;
#pragma unroll
            for (int h = 0; h < 16; ++h) { const float v = wave_sum(cr[h] * hr - cim[h] * hi); if (h == lane) yk = v; }
            if (lane < 16) { const float y = yk + dch * myu; const float a = 0.7978845608f * (y + 0.044715f * y * y * y); TMP[(size_t)(row0 + t) * 256 + g * 16 + lane] = 0.5f * y * (1.f + tanhf(a)); } }
        if (samp) { C.out[O_SRE + ((size_t)(l * 32 + b) * 16 + g) * 64 + lane] = hr; C.out[O_SIM + ((size_t)(l * 32 + b) * 16 + g) * 64 + lane] = hi; }
        else { C.out[O_PRE + ((size_t)l * 16 + g) * 64 + lane] = hr; C.out[O_PIM + ((size_t)l * 16 + g) * 64 + lane] = hi; } }
}
DI void naive_s5_glu(const Ctx& C, int l, const float* TMP) {
    float* zs = (float*)C.lds; float* red = zs + 256; const int tid = C.tid;
    for (int row = C.blk; row < T; row += C.G) { __syncthreads(); if (tid < 256) zs[tid] = TMP[(size_t)row * 256 + tid]; __syncthreads();
        float o = 0.f; if (tid < 256) { float a = C.in[I_BGLU][l * 256 + tid]; const float* W = C.in[I_WGLU] + (size_t)l * 65536 + tid; for (int k = 0; k < 256; ++k) a += zs[k] * W[(size_t)k * 256]; o = zs[tid] / (1.f + expf(-a)); }
        float s = wave_sum(o * o); if (C.lane == 0) red[C.wave] = s; __syncthreads(); const float tot = red[0] + red[1] + red[2] + red[3];
        if (tid < 256) C.MIX()[(size_t)row * DM + tid] = f2bf(o * rsqrtf(tot * (1.f / 256.f) + EPS)); }
}
DI void naive_hg_scan(const Ctx& C, int l, float* TMP) {
    const bf16* P = C.PROJ(); const float* LB = C.misc(M_LB) + l * 256;
    for (int it = C.blk * NTHR + C.tid; it < 33 * 256; it += C.G * NTHR) { const int sq = it >> 8, hd = (it >> 6) & 3, v = it & 63; const bool samp = sq > 0; const int b = sq - 1; const int row0 = samp ? TP + b * 16 : 0, n = samp ? 16 : TP;
        float S[64];
#pragma unroll
        for (int d = 0; d < 64; ++d) S[d] = samp ? C.in[I_SHG][((size_t)(l * 32 + b) * 4 + hd) * 4096 + d * 64 + v] : 0.f;
        for (int t = 0; t < n; ++t) { const bf16* pr = P + (size_t)(row0 + t) * INP; const float vv = bf2f(pr[C_HI + hd * 64 + v]); float o = 0.f;
#pragma unroll
            for (int d = 0; d < 64; ++d) { const float lb = LB[hd * 64 + d], fp = bf2f(pr[C_HF + hd * 64 + d]), hq = bf2f(pr[C_HQ + hd * 64 + d]); const float sg = 1.f / (1.f + expf(-fp));
                const float f = lb + (1.f - lb) * sg, k = (1.f - lb) * (1.f - sg), q = hq / (1.f + expf(-hq)); S[d] = f * S[d] + k * vv; o += q * S[d]; }
            TMP[(size_t)(row0 + t) * 256 + hd * 64 + v] = o; }
#pragma unroll
        for (int d = 0; d < 64; ++d) { if (samp) C.out[O_SHG + ((size_t)(l * 32 + b) * 4 + hd) * 4096 + d * 64 + v] = S[d]; else C.out[O_PHG + (size_t)l * 16384 + hd * 4096 + d * 64 + v] = S[d]; } }
}
DI void naive_hg_norm(const Ctx& C, int l, const float* TMP) {
    const int gw = C.blk * NWAVE + C.wave, NGW = C.G * NWAVE, lane = C.lane; const bf16* P = C.PROJ();
    for (int m = gw; m < T; m += NGW) { float o[4]; float s = 0.f;
#pragma unroll
        for (int j = 0; j < 4; ++j) { o[j] = TMP[(size_t)m * 256 + 64 * j + lane]; s += o[j] * o[j]; }
        s = wave_sum(s); const float rn = rsqrtf(s * (1.f / 256.f) + EPS);
#pragma unroll
        for (int j = 0; j < 4; ++j) { const float g = bf2f(P[(size_t)m * INP + C_HG + 64 * j + lane]); C.MIX()[(size_t)m * DM + 256 + 64 * j + lane] = f2bf(o[j] * rn * g / (1.f + expf(-g))); } }
}

#ifndef NAIVE_ATTP
#define NAIVE_ATTP 0
#endif
#ifndef NAIVE_ATTS
#define NAIVE_ATTS 0
#endif
DI float wave_max(float v) {
#pragma unroll
    for (int o = 1; o < 64; o <<= 1) v = fmaxf(v, __shfl_xor(v, o));
    return v;
}
DI void naive_attn_prompt(const Ctx& C, int l) {
    const int gw = C.blk * NWAVE + C.wave, NGW = C.G * NWAVE, lane = C.lane; const bf16* QF = C.QF(); const bf16* KVF = C.KVF(); const bf16* KPE = C.KPEB();
    for (int it = gw; it < TP * 8; it += NGW) { const int row = it >> 3, hd = it & 7; float q[96];
#pragma unroll
        for (int d = 0; d < 96; ++d) q[d] = bf2f(QF[(size_t)row * 768 + hd * 96 + d]);
#pragma unroll
        for (int i = 0; i < 16; ++i) { const float c = C.misc(M_COS)[row * 16 + i], s = C.misc(M_SIN)[row * 16 + i]; const float x1 = q[64 + i], x2 = q[80 + i]; q[64 + i] = x1 * c - x2 * s; q[80 + i] = x2 * c + x1 * s; }
        const int nk = 64 * (row / 64 + 1); float m = -1e30f, ls = 0.f; float acc[64];
#pragma unroll
        for (int d = 0; d < 64; ++d) acc[d] = 0.f;
        for (int k = lane; k < nk; k += 64) { float sc = 0.f;
#pragma unroll
            for (int d = 0; d < 64; ++d) sc += q[d] * bf2f(KVF[(size_t)k * 1024 + hd * 64 + d]);
#pragma unroll
            for (int d = 0; d < 32; ++d) sc += q[64 + d] * bf2f(KPE[(size_t)k * 32 + d]);
            const float mn = fmaxf(m, sc), a = exp2f(m - mn), p = exp2f(sc - mn); m = mn; ls = ls * a + p;
#pragma unroll
            for (int d = 0; d < 64; ++d) acc[d] = acc[d] * a + p * bf2f(KVF[(size_t)k * 1024 + 512 + hd * 64 + d]); }
        const float M = wave_max(m), f = exp2f(m - M); const float L = wave_sum(ls * f); float mine = 0.f;
#pragma unroll
        for (int d = 0; d < 64; ++d) { const float v = wave_sum(acc[d] * f) / L; if (d == lane) mine = v; }
        C.MIX()[(size_t)row * DM + 512 + hd * 64 + lane] = f2bf(mine); const float s2 = wave_sum(mine * mine); if (lane == 0) atomicAdd(C.ssq(SQ_MA + l) + row, s2); }
}
DI void naive_attn_sample(const Ctx& C, int l) {
    const int gw = C.blk * NWAVE + C.wave, NGW = C.G * NWAVE, lane = C.lane; const bf16* QF = C.QF(); float* qs = (float*)C.lds + C.wave * 512; float* os = qs + 256;
    for (int it = gw; it < TS * 8; it += NGW) { const int bi = it >> 3, hh = it & 7, b = bi >> 4, i = bi & 15, row = TP + bi, pos = PAST + i;
        const bf16* qr = QF + (size_t)row * 768 + hh * 96;
        for (int c = lane; c < 128; c += 64) { float a = 0.f; const float* w = C.in[I_WUK] + (size_t)l * 65536 + (size_t)c * 512 + hh * 64; for (int d = 0; d < 64; ++d) a += bf2f(qr[d]) * w[d]; qs[c] = a; }
        if (lane < 16) { const float c = C.misc(M_COS)[pos * 16 + lane], s = C.misc(M_SIN)[pos * 16 + lane]; const float x1 = bf2f(qr[64 + lane]), x2 = bf2f(qr[80 + lane]); qs[128 + lane] = x1 * c - x2 * s; qs[144 + lane] = x2 * c + x1 * s; }
        __builtin_amdgcn_s_waitcnt(0); asm volatile("" ::: "memory");
        float m = -1e30f, ls = 0.f; float acc[128];
#pragma unroll
        for (int d = 0; d < 128; ++d) acc[d] = 0.f;
        for (int k = lane; k < PAST + 16; k += 64) { const float* kv = k < PAST ? C.in[I_CKV] + ((size_t)(l * 32 + b) * PAST + k) * 128 : C.out + O_SKV + ((size_t)l * TS + b * 16 + (k - PAST)) * 128;
            const float* pe = k < PAST ? C.in[I_CPE] + ((size_t)(l * 32 + b) * PAST + k) * 32 : C.out + O_SPE + ((size_t)l * TS + b * 16 + (k - PAST)) * 32; float sc = 0.f;
            for (int d = 0; d < 128; ++d) sc += qs[d] * kv[d];
            for (int d = 0; d < 32; ++d) sc += qs[128 + d] * pe[d];
            const float mn = fmaxf(m, sc), a = exp2f(m - mn), p = exp2f(sc - mn); m = mn; ls = ls * a + p;
#pragma unroll
            for (int d = 0; d < 128; ++d) acc[d] = acc[d] * a + p * kv[d]; }
        const float M = wave_max(m), f = exp2f(m - M); const float L = wave_sum(ls * f);
#pragma unroll
        for (int d = 0; d < 128; ++d) { const float v = wave_sum(acc[d] * f) / L; if ((d & 63) == lane) os[d] = v; }
        __builtin_amdgcn_s_waitcnt(0); asm volatile("" ::: "memory");
        float o = 0.f; const float* wv = C.in[I_WUV] + (size_t)l * 65536 + hh * 64 + lane; for (int c = 0; c < 128; ++c) o += os[c] * wv[(size_t)c * 512];
        C.MIX()[(size_t)row * DM + 512 + hh * 64 + lane] = f2bf(o); const float s2 = wave_sum(o * o); if (lane == 0) atomicAdd(C.ssq(SQ_MA + l) + row, s2);
        __builtin_amdgcn_s_waitcnt(0); asm volatile("" ::: "memory"); }
}
#define XB_TMO      128
#define XB_XCNT(j)  (256  + 64 * (j))
#define XB_XSUB(j)  (1280 + 64 * (j))
#define XB_XGEN(j)  (2304 + 64 * (j))
#define XB_TOP      3328
#define XB_TOPGEN   3392
#define XCD_BAR_WORDS 3456
#define XB_SPIN_CAP (1u << 18)

__device__ __forceinline__ unsigned xb_ld(unsigned* p)              { return __hip_atomic_load(p, __ATOMIC_RELAXED, __HIP_MEMORY_SCOPE_AGENT); }
__device__ __forceinline__ unsigned xb_add(unsigned* p, unsigned v) { return __hip_atomic_fetch_add(p, v, __ATOMIC_RELAXED, __HIP_MEMORY_SCOPE_AGENT); }
__device__ __forceinline__ unsigned xb_xcc_id() { return (unsigned)__builtin_amdgcn_s_getreg((3 << 11) | 20) & 0xFu; }
#define XB_SPIN(cond, bar) do { unsigned _sp = 0; while (cond) { __builtin_amdgcn_s_sleep(1); \
    if ((++_sp & 255u) == 0u) { if (xb_ld(&(bar)[XB_TMO])) break; if (_sp > XB_SPIN_CAP) { atomicAdd(&(bar)[XB_TMO], 1u); break; } } } } while (0)

struct XcdBarrier {
    unsigned* bar; unsigned x;
    volatile LAS unsigned* st;
};

__device__ __forceinline__ XcdBarrier xcd_barrier_post(unsigned* bar, volatile LAS unsigned* st) {
    XcdBarrier b; b.bar = bar; b.x = xb_xcc_id(); b.st = st;
    if (threadIdx.x == 0) (void)xb_add(&bar[XB_XCNT(b.x)], 1u);
    return b;
}
__device__ __forceinline__ void xcd_barrier_complete(unsigned* bar, unsigned x, unsigned& nloc, unsigned& nx) {
    const unsigned G = gridDim.x * gridDim.y * gridDim.z;
    unsigned sum, cnt, mine, sp = 0u;
    for (;;) {
        sum = 0u; cnt = 0u; mine = 0u;
#pragma unroll
        for (unsigned j = 0; j < 16; ++j) { const unsigned c = xb_ld(&bar[XB_XCNT(j)]); sum += c; cnt += (c > 0u) ? 1u : 0u; mine = (j == x) ? c : mine; }
        if (sum == G) break;
        __builtin_amdgcn_s_sleep(1);
        if ((++sp & 255u) == 0u) { if (xb_ld(&bar[XB_TMO])) break; if (sp > XB_SPIN_CAP) { atomicAdd(&bar[XB_TMO], 1u); break; } }
    }
    nloc = mine > 0u ? mine : 1u; nx = cnt > 0u ? cnt : 1u;
}

__device__ __forceinline__ void xcd_barrier(const XcdBarrier& b) {
    asm volatile("s_waitcnt vmcnt(0)" ::: "memory");
    __syncthreads();
    if (threadIdx.x == 0) {
        unsigned* bar = b.bar;
        __builtin_amdgcn_s_waitcnt(0);
        unsigned nloc = b.st[0], nx = b.st[1];
        if (nloc == 0u) { xcd_barrier_complete(bar, b.x, nloc, nx); b.st[0] = nloc; b.st[1] = nx; }
        const unsigned old = xb_add(&bar[XB_XSUB(b.x)], 1u);
        const unsigned gen = old / nloc;
        if (old + 1u == (gen + 1u) * nloc) {
            __builtin_amdgcn_fence(__ATOMIC_RELEASE, "agent");
            asm volatile("s_waitcnt vmcnt(0)" ::: "memory");
            const unsigned og = xb_add(&bar[XB_TOP], 1u);
            const unsigned tg = og / nx;
            if (og + 1u == (tg + 1u) * nx) xb_add(&bar[XB_TOPGEN], 1u);
            else XB_SPIN(xb_ld(&bar[XB_TOPGEN]) == tg, bar);
            __builtin_amdgcn_fence(__ATOMIC_ACQUIRE, "agent");
            xb_add(&bar[XB_XGEN(b.x)], 1u);
            asm volatile("s_waitcnt vmcnt(0)" ::: "memory");
        } else {
            XB_SPIN(xb_ld(&bar[XB_XGEN(b.x)]) == gen, bar);
            __builtin_amdgcn_fence(__ATOMIC_ACQUIRE, "agent");
            asm volatile("s_waitcnt vmcnt(0)" ::: "memory");
        }
    }
    __syncthreads();
}

template <int K> DI void run_kind(const Ctx& C0, int l0, LAS unsigned char* ldsg) {
    unsigned zz; asm volatile("s_mov_b32 %0, 0" : "=s"(zz)); Ctx C = C0; C.ws = C0.ws + zz; C.out = C0.out + zz; C.in = C0.in + zz; const int l = l0 + (int)zz;
    { int t_ = C0.tid; asm volatile("" : "+v"(t_)); C.tid = t_; C.lane = t_ & 63; C.wave = __builtin_amdgcn_readfirstlane(t_ >> 6); }
    if constexpr (K == 0) p0_prologue(C);
    else if constexpr (K == 1) { pg8::Gemm g{C.XB(), C.wgt(l, W_IN), T, INP, DM, DM, DM}; pg8::StaticOrder S; S.init(T, INP, C.G, C.blk);
        pg8::EpiG1 E{C.PROJ(), C.ssq(SQ_X0 + l), C.ssq(SQ_QA + l), C.ssq(SQ_KVA + l)}; pg8::gemm_phase<pg8::EpiG1, pg8::StaticOrder, true, true>(ldsg, g, S, E); }
    else if constexpr (K == 2 && NAIVE_QKV) naive_q(C, l);
    else if constexpr (K == 3 && NAIVE_QKV) naive_kv(C, l);
    else if constexpr (K == 2) { pg8::Gemm g{C.PROJ() + C_CQ, C.wgt(l, W_UQ), T, 768, 256, INP, 256}; pg8::StaticOrder S; S.init(T, 768, C.G, C.blk);
        pg8::EpiQ E{C.QF(), C.ssq(SQ_QA + l)}; pg8::gemm_phase<pg8::EpiQ, pg8::StaticOrder, true, true>(ldsg, g, S, E); }
    else if constexpr (K == 3) { pg8::Gemm g{C.PROJ() + C_CKV, C.wgt(l, W_KV), TP, 1024, 128, INP, 128}; pg8::StaticOrder S; S.init(TP, 1024, C.G, C.blk);
        pg8::EpiScaleStore E{C.KVF(), 1024, C.ssq(SQ_KVA + l), 1.f / 128.f}; pg8::gemm_phase<pg8::EpiScaleStore, pg8::StaticOrder, true, true>(ldsg, g, S, E); }
    else if constexpr (K == 4) { __syncthreads(); misc_rows(C, l);
        if (!NAIVE_S5) for (int ci = C.blk; ci < 256; ci += C.G) s5_item<false>(C, l, ci);
        __syncthreads();
        if (!NAIVE_HG) for (int bi = C.G - 1 - C.blk; bi < 144; bi += C.G) hgrn_local(C, l, bi * 8 + C.wave); }
    else if constexpr (K == 5) { if (NAIVE_HG) naive_hg_scan(C, l, C.GT()); else hgrn_prefix(C, l);
        if (NAIVE_S5) naive_s5_scan(C, l, (float*)C.XB()); else for (int ci = C.blk; ci < 288; ci += C.G) s5_item<true>(C, l, ci); }
    else if constexpr (K == 6) { if (NAIVE_ATTS) naive_attn_sample(C, l); else attn_phase<true>(C, l); }
    else if constexpr (K == 7) { if (NAIVE_ATTP) naive_attn_prompt(C, l); else attn_phase<false>(C, l); }
    else if constexpr (K == 8) { if (NAIVE_HG) naive_hg_norm(C, l, C.GT()); else for (int bi = C.blk; bi < 144; bi += C.G) hgrn_final(C, l, bi);
        if (NAIVE_S5) naive_s5_glu(C, l, (const float*)C.XB());
        mla_finalize(C, l); }
    else if constexpr (K == 9) { pg8::Gemm g{C.MIX(), C.wgt(l, W_OUT), T, DM, DM, DM, DM}; pg8::StaticOrder S; S.init(T, DM, C.G, C.blk);
        pg8::EpiRes E{C.out + O_X, C.XB(), C.ssq(SQ_2A + l)}; pg8::gemm_phase<pg8::EpiRes, pg8::StaticOrder, true, true>(ldsg, g, S, E); }
    else if constexpr (K == 10) { pg8::Gemm g{C.XB(), C.wgt(l, W_UP), T, DFF, DM, DM, DM}; pg8::StaticOrder S; S.init(T, DFF, C.G, C.blk);
        pg8::EpiUp E{C.HID(), C.ssq(SQ_2A + l)}; pg8::gemm_phase<pg8::EpiUp, pg8::StaticOrder, true, true>(ldsg, g, S, E); }
    else if constexpr (K == 11) { pg8::Gemm g{C.HID(), C.wgt(l, W_DN), T, DM, DFF, DFF, DFF}; pg8::StaticOrder S; S.init(T, DM, C.G, C.blk);
        pg8::EpiRes E{C.out + O_X, C.XB(), C.ssq(SQ_X1 + l)}; pg8::gemm_phase<pg8::EpiRes, pg8::StaticOrder, true, true>(ldsg, g, S, E); }
    else final_norm(C);
}
DI Ctx make_ctx(const Args& args, unsigned char* lds_raw) {
    Ctx C; C.in = args.in; C.out = args.out; C.ws = args.ws; C.lds = (char*)lds_raw; C.tid = threadIdx.x; C.lane = C.tid & 63; C.wave = __builtin_amdgcn_readfirstlane(C.tid >> 6); C.G = gridDim.x; C.blk = blockIdx.x; return C;
}
template <int K> __global__ void __launch_bounds__(NTHR, 2) phase_kernel(Args args, int l) {
    extern __shared__ __attribute__((aligned(16))) unsigned char lds_raw[];
    const Ctx C = make_ctx(args, lds_raw);
    run_kind<K>(C, l, (LAS unsigned char*)lds_raw);
}
#ifndef MK_MEGA
#define MK_MEGA 1
#endif
#if MK_MEGA
__global__ void __launch_bounds__(NTHR, 2) trunk_fwd(Args args) {
    extern __shared__ __attribute__((aligned(16))) unsigned char lds_raw[];
    cg::grid_group grid = cg::this_grid();
    const Ctx C = make_ctx(args, lds_raw); LAS unsigned char* ldsg = (LAS unsigned char*)lds_raw;
    volatile LAS unsigned* xst = (volatile LAS unsigned*)((LAS unsigned char*)lds_raw + LDS_BYTES - 32);
    if (threadIdx.x < 2) xst[threadIdx.x] = 0u;
    __syncthreads();
    grid.sync();
    const XcdBarrier xbar = xcd_barrier_post((unsigned*)(C.ctr() + 1024), xst);
#define GSYNC() xcd_barrier(xbar)
#ifndef KMASK
#define KMASK 0x1fff
#endif
#define RK(k, l) do { if ((KMASK >> (k)) & 1) run_kind<k>(C, l, ldsg); } while (0)
    RK(0, 0); GSYNC();
#define LAYER(l) do { RK(1, l); GSYNC(); RK(2, l); RK(3, l); RK(4, l); GSYNC(); RK(5, l); RK(6, l); RK(7, l); GSYNC(); RK(8, l); GSYNC(); RK(9, l); GSYNC(); RK(10, l); GSYNC(); RK(11, l); GSYNC(); } while (0)
    LAYER(0);
    LAYER(1);
    RK(12, 0);
}
#endif

template <int K> static void launch_kind(const Args& a, int l, int grid, hipStream_t stream) {
    static bool attr_set = false;
    if (!attr_set) { (void)hipFuncSetAttribute((const void*)phase_kernel<K>, hipFuncAttributeMaxDynamicSharedMemorySize, LDS_BYTES); attr_set = true; }
    hipLaunchKernelGGL(phase_kernel<K>, dim3(grid), dim3(NTHR), LDS_BYTES, stream, a, l);
}
extern "C" void kernel_launch(void* const* d_in, const int* in_sizes, int n_in, void* d_out, int out_size, void* d_ws, size_t ws_size, hipStream_t stream) {
    static int grid = 0;
    if (grid == 0) {
        int dev = 0, cus = 0;
        if (n_in != 31 || ws_size < WS_END) { fprintf(stderr, "kernel_launch: unexpected inputs (n_in %d, ws %zu < %zu)\n", n_in, ws_size, (size_t)WS_END); grid = -1; return; }
        (void)hipGetDevice(&dev); (void)hipDeviceGetAttribute(&cus, hipDeviceAttributeMultiprocessorCount, dev);
#if MK_MEGA
        int per_cu = 0;
        (void)hipFuncSetAttribute((const void*)trunk_fwd, hipFuncAttributeMaxDynamicSharedMemorySize, LDS_BYTES);
        (void)hipOccupancyMaxActiveBlocksPerMultiprocessor(&per_cu, (const void*)trunk_fwd, NTHR, LDS_BYTES);
        (void)hipGetLastError();
        if (per_cu < 1) fprintf(stderr, "kernel_launch: occupancy query says %d blocks per CU\n", per_cu);
#endif
        grid = cus > 0 ? cus : 256;
    }
    if (grid < 0) return;
    (void)hipMemsetAsync((char*)d_ws + WS_ZERO, 0, ZERO_BYTES, stream);
    Args a{};
    for (int i = 0; i < 31; ++i) a.in[i] = (const float*)d_in[i];
    a.out = (float*)d_out; a.ws = (unsigned char*)d_ws;
#if MK_MEGA
    void* kargs[] = {&a};
    hipError_t e = hipLaunchCooperativeKernel((const void*)trunk_fwd, dim3(grid), dim3(NTHR), kargs, LDS_BYTES, stream);
    if (e != hipSuccess) fprintf(stderr, "cooperative launch failed: %s (grid %d)\n", hipGetErrorString(e), grid);
#else
    launch_kind<0>(a, 0, grid, stream);
    for (int l = 0; l < 2; ++l) {
        launch_kind<1>(a, l, grid, stream); launch_kind<2>(a, l, grid, stream); launch_kind<3>(a, l, grid, stream); launch_kind<4>(a, l, grid, stream);
        launch_kind<5>(a, l, grid, stream); launch_kind<6>(a, l, grid, stream); launch_kind<7>(a, l, grid, stream); launch_kind<8>(a, l, grid, stream);
        launch_kind<9>(a, l, grid, stream); launch_kind<10>(a, l, grid, stream); launch_kind<11>(a, l, grid, stream);
    }
    launch_kind<12>(a, 0, grid, stream);
#endif
}
```

```cpp
#include <hip/hip_runtime.h>
#include <hip/hip_cooperative_groups.h>
#include <cstdio>
#include <cstdint>
namespace cg = cooperative_groups;
namespace pg8 {
#define PG8_LAS __attribute__((address_space(3)))
typedef unsigned short bf16_t;
typedef short bf16x8 __attribute__((ext_vector_type(8)));
typedef float f32x4 __attribute__((ext_vector_type(4)));
typedef unsigned u32x4 __attribute__((ext_vector_type(4)));
constexpr int BM = 256, BK = 64, HALF = 128, HTB = HALF * BK * 2  , STAGE_BYTES = 8 * HTB, NXCD = 8, WGM = 8;

__host__ __device__ __forceinline__ int lds_byte(int r, int c) { const int st = (r >> 4) * 2 + (c >> 5), rr = r & 15, cc = c & 31, ob = rr * 64 + cc * 2; return st * 1024 + (ob ^ (((ob >> 9) & 1) << 5)); }
__host__ __device__ __forceinline__ void stage_rc(int b, int& R, int& C) { const int st = b / 1024, sb = b % 1024, swz = sb ^ (((sb >> 9) & 1) << 5); R = (st >> 1) * 16 + swz / 64; C = (st & 1) * 32 + (swz % 64) / 2; }
__host__ __device__ __forceinline__ int perm32(int rho) { const int n = rho >> 4, i = rho & 15; return 8 * (i >> 2) + 4 * n + (i & 3); }

struct Unit { int pm, pn, ko; };
struct Gemm { const bf16_t* A; const bf16_t* Bt; int M, N, K, lda, ldb; };

struct StaticOrder {
    int nM, nN, nwg, G, c;
    __host__ __device__ void init(int M, int N, int G_, int c_) { nM = M / BM; nN = N / BM; nwg = nM * nN; G = G_; c = c_; }
    __host__ __device__ bool next(int i, Unit& u) const {
        const long L = (long)i * G + c; if (L >= nwg) return false;
        int wgid = (int)L; { const int q = nwg / NXCD, r = nwg % NXCD, xcd = wgid % NXCD, off = wgid / NXCD; wgid = (xcd < r ? xcd * (q + 1) : r * (q + 1) + (xcd - r) * q) + off; }
        const int nig = WGM * nN, gid = wgid / nig, fm = gid * WGM, gsz = (nM - fm) < WGM ? (nM - fm) : WGM;
        u.pm = fm + ((wgid % nig) % gsz); u.pn = (wgid % nig) / gsz; u.ko = 0; return true;
    }
    __device__ __forceinline__ void a_ready(const Unit&) const {}
    __device__ __forceinline__ void done(const Unit&) const {}
};

struct WaitOrder : StaticOrder {
    unsigned* cnt; unsigned need;
    __device__ __forceinline__ void a_ready(const Unit& u) const {
        if (u.pm >= 64 && need) { while (__hip_atomic_load(cnt, __ATOMIC_RELAXED, __HIP_MEMORY_SCOPE_AGENT) < need) __builtin_amdgcn_s_sleep(2); __builtin_amdgcn_fence(__ATOMIC_ACQUIRE, "agent"); }
    }
};
struct SplitOrder {
    int G, c, kq;
    __device__ __forceinline__ bool next(int i, Unit& u) const { const int L = i * G + c; if (L >= 32) return false; u.pm = 64 + (L & 1); u.pn = (L >> 1) & 3; u.ko = (L >> 3) * kq; return true; }
    __device__ __forceinline__ void a_ready(const Unit&) const {}
    __device__ __forceinline__ void done(const Unit&) const {}
};

__device__ __forceinline__ unsigned cvt_pk_bf16(float lo, float hi) { unsigned r; asm volatile("v_cvt_pk_bf16_f32 %0, %1, %2" : "=v"(r) : "v"(lo), "v"(hi)); return r; }
typedef float f32x2 __attribute__((ext_vector_type(2)));
__device__ __forceinline__ f32x2 gelu_pk(f32x2 v) {
    const f32x2 av = __builtin_elementwise_abs(v), d = av * 0.2316418882f + 1.0f;
    f32x2 t; t.x = __builtin_amdgcn_rcpf(d.x); t.y = __builtin_amdgcn_rcpf(d.y);
    f32x2 q = t * 0.5307027145f + (-0.7265760135f); q = q * t + 0.7107068705f; q = q * t + (-0.142248368f); q = q * t + 0.127414796f; q = q * t;
    const f32x2 s = (v * v) * (-0.72134752044f);
    f32x2 e; e.x = __builtin_amdgcn_exp2f(s.x); e.y = __builtin_amdgcn_exp2f(s.y);
    const f32x2 m = v * (q * e), r = v - m;
    f32x2 o; o.x = v.x < 0.f ? m.x : r.x; o.y = v.y < 0.f ? m.y : r.y; return o;
}

template <class Epi, class Sched, bool ALIGN_EPI = false, bool SP2 = false>
__device__ __forceinline__ void gemm_phase(PG8_LAS unsigned char* lds, const Gemm g, const Sched& S, const Epi& E) {
    int tid_ = threadIdx.x; asm volatile("" : "+v"(tid_)); const int tid = tid_, wid = __builtin_amdgcn_readfirstlane(tid >> 6), lane = tid & 63, wr = wid >> 2, wc = wid & 3, fr = lane & 15, fq = lane >> 4;
    const int K = g.K, nt = K / BK;
    unsigned voffA[2], voffB[2];
#pragma unroll
    for (int i = 0; i < 2; ++i) { int R, C; stage_rc(tid * 16 + i * 8192, R, C); const int Rb = Epi::PERM ? ((R & ~31) + perm32(R & 31)) : R;
        voffA[i] = (unsigned)(R * g.lda + C) * 2u; voffB[i] = (unsigned)(Rb * g.ldb + C) * 2u; }
    const size_t kstep = (size_t)(BK * 2);
    const size_t hstepA = (size_t)HALF * g.lda * 2, hstepB = (size_t)HALF * g.ldb * 2;
    const size_t tstepA = 2 * hstepA, tstepB = 2 * hstepB;
    const unsigned ldsw = (unsigned)wid * 1024u;
    const int aoff = lds_byte(wr * 64 + fr, fq * 8), boff = lds_byte(wc * 32 + fr, fq * 8);
#define PG8_SA(b, h) (((b) * 2 + (h)) * HTB)
#define PG8_SB(b, h) ((4 + (b) * 2 + (h)) * HTB)
#define PG8_STAGE(bufoff, gbase, voff) do { _Pragma("unroll") for (int _i = 0; _i < 2; ++_i) \
        __builtin_amdgcn_global_load_lds((const unsigned*)((const char*)(gbase) + (voff)[_i]), (PG8_LAS unsigned*)(lds + (bufoff) + ldsw + _i * 8192), 16, 0, 0); } while (0)
#define PG8_LDA(dst, b, h) do { _Pragma("unroll") for (int m = 0; m < 4; ++m) _Pragma("unroll") for (int k = 0; k < 2; ++k) dst[m][k] = *(const PG8_LAS bf16x8*)(lds + PG8_SA(b, h) + aoff + m * 2048 + k * 1024); } while (0)
#define PG8_LDB(dst, b, h) do { _Pragma("unroll") for (int n = 0; n < 2; ++n) _Pragma("unroll") for (int k = 0; k < 2; ++k) dst[n][k] = *(const PG8_LAS bf16x8*)(lds + PG8_SB(b, h) + boff + n * 2048 + k * 1024); } while (0)
#define PG8_MMA(ai, bj, At, Bt) do { __builtin_amdgcn_s_setprio(1); _Pragma("unroll") for (int m = 0; m < 4; ++m) _Pragma("unroll") for (int n = 0; n < 2; ++n) _Pragma("unroll") for (int k = 0; k < 2; ++k) \
        acc[ai][bj][m][n] = __builtin_amdgcn_mfma_f32_16x16x32_bf16(Bt[n][k], At[m][k], acc[ai][bj][m][n], 0, 0, 0); __builtin_amdgcn_s_setprio(0); } while (0)
#define PG8_WAIT_V(n) asm volatile("s_waitcnt vmcnt(" #n ")" ::: "memory")
#define PG8_WAIT_L(n) asm volatile("s_waitcnt lgkmcnt(" #n ")" ::: "memory")
#define PG8_BAR __builtin_amdgcn_s_barrier()
#define PG8_SCHED __builtin_amdgcn_sched_barrier(0)
    Unit cur, nxt; int ui = 0;
    if (!S.next(0, cur)) return;
    f32x4 acc[2][2][4][2];
#pragma unroll
    for (int a = 0; a < 2; ++a)
#pragma unroll
        for (int b = 0; b < 2; ++b)
#pragma unroll
            for (int m = 0; m < 4; ++m)
#pragma unroll
                for (int n = 0; n < 2; ++n) acc[a][b][m][n] = (f32x4){0.f, 0.f, 0.f, 0.f};
    bf16x8 At[4][2], B0[2][2], B1[2][2];
    const char* cA = (const char*)g.A + (size_t)cur.pm * tstepA + (size_t)cur.ko * 2; const char* cB = (const char*)g.Bt + (size_t)cur.pn * tstepB + (size_t)cur.ko * 2;
    S.a_ready(cur);
    if constexpr (SP2) {
        PG8_STAGE(PG8_SB(0, 0), cB, voffB); PG8_STAGE(PG8_SB(0, 1), cB + hstepB, voffB); PG8_STAGE(PG8_SA(0, 0), cA, voffA); PG8_STAGE(PG8_SA(0, 1), cA + hstepA, voffA);
        if (wr == 1) PG8_BAR;
        PG8_WAIT_V(2); PG8_BAR;
        PG8_STAGE(PG8_SB(1, 0), cB + kstep, voffB); PG8_STAGE(PG8_SA(1, 0), cA + kstep, voffA); PG8_STAGE(PG8_SB(1, 1), cB + hstepB + kstep, voffB);
        PG8_WAIT_V(6); PG8_BAR;
    } else {
        PG8_STAGE(PG8_SB(0, 0), cB, voffB); PG8_STAGE(PG8_SA(0, 0), cA, voffA); PG8_STAGE(PG8_SB(0, 1), cB + hstepB, voffB); PG8_STAGE(PG8_SA(0, 1), cA + hstepA, voffA);
        if (wr == 1) PG8_BAR;
        PG8_WAIT_V(4); PG8_BAR;
        PG8_STAGE(PG8_SB(1, 0), cB + kstep, voffB); PG8_STAGE(PG8_SA(1, 0), cA + kstep, voffA); PG8_STAGE(PG8_SB(1, 1), cB + hstepB + kstep, voffB);
        PG8_WAIT_V(6); PG8_BAR;
    }
    for (;;) {
        const bool has_next = S.next(ui + 1, nxt);
        const char* nA = has_next ? (const char*)g.A + (size_t)nxt.pm * tstepA + (size_t)nxt.ko * 2 : cA; const char* nB = has_next ? (const char*)g.Bt + (size_t)nxt.pn * tstepB + (size_t)nxt.ko * 2 : cB;
        for (int t = 0; t < nt; t += 2) {
            const bool last = (t == nt - 2);
            const char* a1 = cA + (size_t)(t + 1) * kstep;
            const char* a2 = last ? nA : cA + (size_t)(t + 2) * kstep; const char* b2 = last ? nB : cB + (size_t)(t + 2) * kstep;
            const char* a3 = a2 + kstep; const char* b3 = b2 + kstep;
            if (last && has_next) S.a_ready(nxt);
            if constexpr (SP2) {
            PG8_LDB(B0, 0, 0); PG8_LDB(B1, 0, 1); PG8_SCHED; PG8_LDA(At, 0, 0); PG8_STAGE(PG8_SA(1, 1), a1 + hstepA, voffA);
            PG8_WAIT_V(8); PG8_WAIT_L(0); PG8_BAR; PG8_MMA(0, 0, At, B0); PG8_MMA(0, 1, At, B1); PG8_BAR; PG8_SCHED;
            PG8_LDA(At, 0, 1); PG8_STAGE(PG8_SB(0, 0), b2, voffB); PG8_STAGE(PG8_SB(0, 1), b2 + hstepB, voffB); PG8_STAGE(PG8_SA(0, 0), a2, voffA);
            PG8_WAIT_V(8); PG8_WAIT_L(0); PG8_BAR; PG8_MMA(1, 0, At, B0); PG8_MMA(1, 1, At, B1); PG8_BAR; PG8_SCHED;
            PG8_LDB(B0, 1, 0); PG8_LDB(B1, 1, 1); PG8_SCHED; PG8_LDA(At, 1, 0); PG8_STAGE(PG8_SA(0, 1), a2 + hstepA, voffA);
            PG8_WAIT_V(8); PG8_WAIT_L(0); PG8_BAR; PG8_MMA(0, 0, At, B0); PG8_MMA(0, 1, At, B1); PG8_BAR; PG8_SCHED;
            PG8_LDA(At, 1, 1); PG8_STAGE(PG8_SB(1, 0), b3, voffB); PG8_STAGE(PG8_SB(1, 1), b3 + hstepB, voffB); PG8_STAGE(PG8_SA(1, 0), a3, voffA);
            PG8_WAIT_V(8); PG8_WAIT_L(0); PG8_BAR; PG8_MMA(1, 0, At, B0); PG8_MMA(1, 1, At, B1); PG8_BAR; PG8_SCHED;
            } else {
            PG8_LDB(B0, 0, 0); PG8_SCHED; PG8_LDA(At, 0, 0); PG8_STAGE(PG8_SA(1, 1), a1 + hstepA, voffA);
            PG8_WAIT_L(8); PG8_BAR; PG8_WAIT_L(0); PG8_MMA(0, 0, At, B0); PG8_BAR; PG8_SCHED;
            PG8_LDB(B1, 0, 1); PG8_STAGE(PG8_SB(0, 0), b2, voffB);
            PG8_BAR; PG8_WAIT_L(0); PG8_MMA(0, 1, At, B1); PG8_BAR;
            PG8_LDA(At, 0, 1); PG8_STAGE(PG8_SA(0, 0), a2, voffA);
            PG8_BAR; PG8_WAIT_L(0); PG8_MMA(1, 0, At, B0); PG8_BAR; PG8_SCHED;
            PG8_STAGE(PG8_SB(0, 1), b2 + hstepB, voffB);
            PG8_WAIT_V(6); PG8_BAR; PG8_MMA(1, 1, At, B1); PG8_BAR;
            PG8_LDB(B0, 1, 0); PG8_SCHED; PG8_LDA(At, 1, 0); PG8_STAGE(PG8_SA(0, 1), a2 + hstepA, voffA);
            PG8_WAIT_L(8); PG8_BAR; PG8_WAIT_L(0); PG8_MMA(0, 0, At, B0); PG8_BAR; PG8_SCHED;
            PG8_LDB(B1, 1, 1); PG8_STAGE(PG8_SB(1, 0), b3, voffB);
            PG8_BAR; PG8_WAIT_L(0); PG8_MMA(0, 1, At, B1); PG8_BAR;
            PG8_LDA(At, 1, 1); PG8_STAGE(PG8_SA(1, 0), a3, voffA);
            PG8_BAR; PG8_WAIT_L(0); PG8_MMA(1, 0, At, B0); PG8_BAR; PG8_SCHED;
            PG8_STAGE(PG8_SB(1, 1), b3 + hstepB, voffB);
            PG8_WAIT_V(6); PG8_BAR; PG8_MMA(1, 1, At, B1); PG8_BAR;
            }
        }
        if constexpr (ALIGN_EPI) { if (wr == 0) PG8_BAR; }
        if constexpr (!Epi::AFTER_DRAIN) { E(acc, cur, wr, wc, fr, fq); S.done(cur); }
        if (!has_next) break;
#pragma unroll
        for (int a = 0; a < 2; ++a)
#pragma unroll
            for (int b = 0; b < 2; ++b)
#pragma unroll
                for (int m = 0; m < 4; ++m)
#pragma unroll
                    for (int n = 0; n < 2; ++n) acc[a][b][m][n] = (f32x4){0.f, 0.f, 0.f, 0.f};
        cur = nxt; cA = nA; cB = nB; ++ui;
        if constexpr (ALIGN_EPI) { if (wr == 1) PG8_BAR; }
    }
    PG8_WAIT_V(0);
    if constexpr (!ALIGN_EPI) { if (wr == 0) PG8_BAR; }
    PG8_BAR;
    if constexpr (Epi::AFTER_DRAIN) { E.fused(acc, cur, wr, wc, fr, fq, lds, wid, lane); S.done(cur); }
#undef PG8_SA
#undef PG8_SB
#undef PG8_STAGE
#undef PG8_LDA
#undef PG8_LDB
#undef PG8_MMA
#undef PG8_WAIT_V
#undef PG8_WAIT_L
#undef PG8_BAR
#undef PG8_SCHED
}
}

#define DI __device__ __forceinline__
#define LAS __attribute__((address_space(3)))
typedef unsigned short bf16;
typedef short bf16x8 __attribute__((ext_vector_type(8)));
typedef short s16x4 __attribute__((ext_vector_type(4)));
typedef float f32x4 __attribute__((ext_vector_type(4)));
typedef float f32x16 __attribute__((ext_vector_type(16)));
typedef unsigned u32x4 __attribute__((ext_vector_type(4)));
typedef unsigned u32x2 __attribute__((ext_vector_type(2)));
typedef float f32x2_t __attribute__((ext_vector_type(2)));
typedef __bf16 bf16x2_t __attribute__((ext_vector_type(2)));
DI unsigned pk2(float lo, float hi) { f32x2_t v = {lo, hi}; bf16x2_t b = __builtin_convertvector(v, bf16x2_t); return __builtin_bit_cast(unsigned, b); }
DI float bf2f(unsigned short x) { return __uint_as_float((unsigned)x << 16); }
DI float bflo(unsigned w) { return __uint_as_float(w << 16); }
DI float bfhi(unsigned w) { return __uint_as_float(w & 0xffff0000u); }
DI unsigned short f2bf(float f) { return (unsigned short)(pk2(f, 0.f) & 0xffffu); }
#define MFMA32(a, b, c) __builtin_amdgcn_mfma_f32_32x32x16_bf16((a), (b), (c), 0, 0, 0)
DI int crow(int i, int h) { return (i & 3) + 8 * (i >> 2) + 4 * h; }
DI float sigmoidf_(float x) { return 1.f / (1.f + __expf(-x)); }
DI float wave_sum(float v) {
#pragma unroll
    for (int o = 1; o < 64; o <<= 1) v += __shfl_xor(v, o);
    return v;
}
DI bf16x8 lds16(const char* p) { return *(const bf16x8*)p; }
DI bf16x8 lds8x2(const char* p) { const s16x4 a = *(const s16x4*)p, b = *(const s16x4*)(p + 8); return __builtin_shufflevector(a, b, 0, 1, 2, 3, 4, 5, 6, 7); }
typedef short v4i16_t __attribute__((ext_vector_type(4)));
DI s16x4 ldtr(const char* p) { return __builtin_bit_cast(s16x4, __builtin_amdgcn_ds_read_tr16_b64_v4i16((LAS v4i16_t*)p)); }
DI bf16x8 packf8(float a0, float a1, float a2, float a3, float a4, float a5, float a6, float a7) {
    u32x4 w; w.x = pk2(a0, a1); w.y = pk2(a2, a3); w.z = pk2(a4, a5); w.w = pk2(a6, a7); return __builtin_bit_cast(bf16x8, w);
}

constexpr int DM = 1024, TP = 16384, TS = 512, T = TP + TS, NBATCH = 32, DSEQ = 16, PAST = 2048, INW = 1696, INP = 1792, DFF = 4096;
constexpr int C_U = 0, C_HQ = 256, C_HF = 512, C_HI = 768, C_HG = 1024, C_CQ = 1280, C_CKV = 1536, C_KPE = 1664;
constexpr float EPS = 1e-5f;
constexpr float QSCALE = 0.14724444f;
constexpr int NTHR = 512, NWAVE = 8;
constexpr int LDS_BYTES = 147456;

constexpr size_t O_X = 0, O_PKV = 17301504, O_PPE = 21495808, O_PHG = 22544384, O_PRE = 22577152, O_PIM = 22579200,
                 O_SKV = 22581248, O_SPE = 22712320, O_SHG = 22745088, O_SRE = 23793664, O_SIM = 23859200;
constexpr size_t WS_ZERO = 0, ZERO_BYTES = 1048576, WS_SSQ = 65536, SSQ_STRIDE = (size_t)T * 4;
constexpr size_t WS_W = 1048576, W_LAYER = 23330816, W_IN = 0, W_UQ = 3670016, W_KV = 4063232, W_OUT = 4325376, W_UP = 6422528, W_DN = 14811136, W_GLU = 23199744;
constexpr size_t WS_MISC = WS_W + 2 * W_LAYER;
constexpr size_t M_AB = 0, M_BBRE = 16384, M_BBIM = M_BBRE + 131072, M_LB = M_BBIM + 131072, M_COS = M_LB + 2048, M_SIN = M_COS + 1048576, M_KCN = M_SIN + 1048576;
constexpr size_t WS_XB = WS_MISC + 4194304;
constexpr size_t WS_OV = WS_XB + (size_t)T * DM * 2;
constexpr size_t OV_PROJ = 0, OV_QF = OV_PROJ + (size_t)T * INP * 2, OV_KVF = OV_QF + (size_t)T * 768 * 2, OV_KPE = OV_KVF + (size_t)TP * 1024 * 2,
                 OV_MIX = OV_KPE + (size_t)TP * 32 * 2, OV_GT = OV_MIX + (size_t)T * DM * 2, OV_DD = OV_GT + (size_t)288 * 4 * 4096 * 4, OV_EBM = OV_DD + (size_t)288 * 256 * 4,
                 OV_E5 = OV_EBM + (size_t)288 * 256 * 4, OV_END = OV_E5 + (size_t)256 * 16 * 64 * 2 * 4;
constexpr size_t WS_END = WS_OV + OV_END;
static_assert(OV_END >= (size_t)T * DFF * 2, "hidden overlay fits");
static_assert(M_KCN + (size_t)2 * 32 * 64 * 160 * 2 <= 4194304, "misc region");
static_assert(WS_END <= 268435456, "workspace map within 256 MiB");
enum { SQ_X0 = 0, SQ_X1 = 1, SQ_XF = 2, SQ_2A = 3, SQ_2B = 4, SQ_QA = 5, SQ_QB = 6, SQ_KVA = 7, SQ_KVB = 8, SQ_MA = 9, SQ_MB = 10 };

struct Args { const float* in[31]; float* out; unsigned char* ws; };
enum { I_XP = 0, I_XS, I_CKV, I_CPE, I_SHG, I_S5RE, I_S5IM, I_N1G, I_WIN, I_LRE, I_LIM, I_LDT, I_BRE, I_BIM, I_CRE, I_CIM, I_S5D, I_WGLU, I_BGLU, I_LBL, I_QNG, I_WUQ, I_KVNG,
       I_WUK, I_WUV, I_ONG, I_WOUT, I_N2G, I_WUP, I_WDN, I_FNG };

struct Ctx {
    const float* const* in; float* out; unsigned char* ws; char* lds; int tid, lane, wave, G, blk;
    DI float* ssq(int i) const { return (float*)(ws + WS_SSQ + (size_t)i * SSQ_STRIDE); }
    DI bf16* wgt(int l, size_t off) const { return (bf16*)(ws + WS_W + (size_t)l * W_LAYER + off); }
    DI bf16* XB() const { return (bf16*)(ws + WS_XB); }
    DI bf16* PROJ() const { return (bf16*)(ws + WS_OV + OV_PROJ); }
    DI bf16* QF() const { return (bf16*)(ws + WS_OV + OV_QF); }
    DI bf16* KVF() const { return (bf16*)(ws + WS_OV + OV_KVF); }
    DI bf16* KPEB() const { return (bf16*)(ws + WS_OV + OV_KPE); }
    DI bf16* MIX() const { return (bf16*)(ws + WS_OV + OV_MIX); }
    DI bf16* HID() const { return (bf16*)(ws + WS_OV); }
    DI float* GT() const { return (float*)(ws + WS_OV + OV_GT); }
    DI float* DD() const { return (float*)(ws + WS_OV + OV_DD); }
    DI float* EBM() const { return (float*)(ws + WS_OV + OV_EBM); }
    DI float* E5() const { return (float*)(ws + WS_OV + OV_E5); }
    DI float* misc(size_t off) const { return (float*)(ws + WS_MISC + off); }
    DI bf16* KCN() const { return (bf16*)(ws + WS_MISC + M_KCN); }
    DI unsigned* ctr() const { return (unsigned*)(ws + WS_ZERO); }
};
DI int pos_of_row(int row) { return row < TP ? row : PAST + ((row - TP) & 15); }

namespace pg8 {
struct EpiG1 {
    static constexpr bool PERM = true, AFTER_DRAIN = false;
    bf16_t* O; const float* ssq; float* ssq_q; float* ssq_kv;
    __device__ __forceinline__ void operator()(const f32x4 (&acc)[2][2][4][2], const Unit& u, int wr, int wc, int fr, int fq) const {
        const int row0 = u.pm * BM + wr * 64 + fr, col0 = u.pn * BM + wc * 32 + 8 * fq;
#pragma unroll
        for (int ai = 0; ai < 2; ++ai)
#pragma unroll
            for (int m = 0; m < 4; ++m) {
                const int row = row0 + ai * HALF + m * 16; const float sc = rsqrtf(ssq[row] * (1.f / 1024.f) + 1e-5f); float s2[2];
#pragma unroll
                for (int bj = 0; bj < 2; ++bj) { const f32x4 v0 = acc[ai][bj][m][0] * sc, v1 = acc[ai][bj][m][1] * sc;
                    u32x4 w; w.x = cvt_pk_bf16(v0[0], v0[1]); w.y = cvt_pk_bf16(v0[2], v0[3]); w.z = cvt_pk_bf16(v1[0], v1[1]); w.w = cvt_pk_bf16(v1[2], v1[3]);
                    *(u32x4*)(O + (size_t)row * 1792 + col0 + bj * HALF) = w;
                    s2[bj] = (v0[0] * v0[0] + v0[1] * v0[1]) + (v0[2] * v0[2] + v0[3] * v0[3]) + (v1[0] * v1[0] + v1[1] * v1[1]) + (v1[2] * v1[2] + v1[3] * v1[3]); }
                if (u.pn == 5 || u.pn == 6) { float s = (u.pn == 5) ? s2[0] + s2[1] : s2[0]; s += __shfl_xor(s, 16); s += __shfl_xor(s, 32);
                    if (fq == 0) atomicAdd((u.pn == 5 ? ssq_q : ssq_kv) + row, s); }
            }
    }
};
struct EpiQ {
    static constexpr bool PERM = true, AFTER_DRAIN = false;
    bf16_t* O; const float* ssq;
    __device__ __forceinline__ void operator()(const f32x4 (&acc)[2][2][4][2], const Unit& u, int wr, int wc, int fr, int fq) const {
        const int row0 = u.pm * BM + wr * 64 + fr; int coff[2];
#pragma unroll
        for (int bj = 0; bj < 2; ++bj) { const int c = u.pn * BM + bj * HALF + wc * 32 + 8 * fq; int h, d;
            if (c < 512) { h = c >> 6; d = c & 63; } else { const int j = (c - 512) & 127; h = j >> 4; d = 64 + 16 * ((c - 512) >> 7) + (j & 15); }
            coff[bj] = h * 96 + d; }
        bf16_t* Ob = O + (size_t)row0 * 768;
#pragma unroll
        for (int ai = 0; ai < 2; ++ai)
#pragma unroll
            for (int m = 0; m < 4; ++m) {
                const int dr = ai * HALF + m * 16; const float sc = rsqrtf(ssq[row0 + dr] * (1.f / 256.f) + 1e-5f) * 0.14724444f;
#pragma unroll
                for (int bj = 0; bj < 2; ++bj) { const f32x4 v0 = acc[ai][bj][m][0] * sc, v1 = acc[ai][bj][m][1] * sc;
                    u32x4 w; w.x = cvt_pk_bf16(v0[0], v0[1]); w.y = cvt_pk_bf16(v0[2], v0[3]); w.z = cvt_pk_bf16(v1[0], v1[1]); w.w = cvt_pk_bf16(v1[2], v1[3]);
                    *(u32x4*)(Ob + dr * 768 + coff[bj]) = w; }
                asm volatile("" ::: "memory");
            }
    }
};
struct EpiScaleStore {
    static constexpr bool PERM = true, AFTER_DRAIN = false;
    bf16_t* O; int ldc; const float* ssq; float inv_n;
    __device__ __forceinline__ void operator()(const f32x4 (&acc)[2][2][4][2], const Unit& u, int wr, int wc, int fr, int fq) const {
        const int row0 = u.pm * BM + wr * 64 + fr, col0 = u.pn * BM + wc * 32 + 8 * fq; bf16_t* Ob = O + (size_t)row0 * 1024 + col0;
#pragma unroll
        for (int ai = 0; ai < 2; ++ai)
#pragma unroll
            for (int m = 0; m < 4; ++m) {
                const int dr = ai * HALF + m * 16; const float sc = rsqrtf(ssq[row0 + dr] * (1.f / 128.f) + 1e-5f);
#pragma unroll
                for (int bj = 0; bj < 2; ++bj) { const f32x4 v0 = acc[ai][bj][m][0] * sc, v1 = acc[ai][bj][m][1] * sc;
                    u32x4 w; w.x = cvt_pk_bf16(v0[0], v0[1]); w.y = cvt_pk_bf16(v0[2], v0[3]); w.z = cvt_pk_bf16(v1[0], v1[1]); w.w = cvt_pk_bf16(v1[2], v1[3]);
                    *(u32x4*)(Ob + dr * 1024 + bj * HALF) = w; }
                asm volatile("" ::: "memory");
            }
    }
};
struct EpiUp {
    static constexpr bool PERM = true, AFTER_DRAIN = false;
    bf16_t* O; const float* ssq;
    __device__ __forceinline__ void operator()(const f32x4 (&acc)[2][2][4][2], const Unit& u, int wr, int wc, int fr, int fq) const {
        const int row0 = u.pm * BM + wr * 64 + fr, col0 = u.pn * BM + wc * 32 + 8 * fq;
#pragma unroll
        for (int ai = 0; ai < 2; ++ai)
#pragma unroll
            for (int m = 0; m < 4; ++m) {
                const int row = row0 + ai * HALF + m * 16; const float sc = rsqrtf(ssq[row] * (1.f / 1024.f) + 1e-5f);
#pragma unroll
                for (int bj = 0; bj < 2; ++bj) { f32x4 v0 = acc[ai][bj][m][0] * sc, v1 = acc[ai][bj][m][1] * sc;
#pragma unroll
                    for (int e = 0; e < 4; ++e) { v0[e] = fmaxf(v0[e], 0.f); v1[e] = fmaxf(v1[e], 0.f); }
                    v0 = v0 * v0; v1 = v1 * v1;
                    u32x4 w; w.x = cvt_pk_bf16(v0[0], v0[1]); w.y = cvt_pk_bf16(v0[2], v0[3]); w.z = cvt_pk_bf16(v1[0], v1[1]); w.w = cvt_pk_bf16(v1[2], v1[3]);
                    *(u32x4*)(O + (size_t)row * 4096 + col0 + bj * HALF) = w; }
            }
    }
};
struct EpiRes {
    static constexpr bool PERM = true, AFTER_DRAIN = false;
    float* X; bf16_t* XB; float* ssq_out;
    __device__ __forceinline__ void operator()(const f32x4 (&acc)[2][2][4][2], const Unit& u, int wr, int wc, int fr, int fq) const {
        const int row0 = u.pm * BM + wr * 64 + fr, col0 = u.pn * BM + wc * 32 + 8 * fq;
#pragma unroll
        for (int ai = 0; ai < 2; ++ai)
#pragma unroll
            for (int m = 0; m < 4; ++m) {
                const int row = row0 + ai * HALF + m * 16; float s = 0.f;
#pragma unroll
                for (int bj = 0; bj < 2; ++bj) { float* xp = X + (size_t)row * 1024 + col0 + bj * HALF;
                    const f32x4 v0 = *(const f32x4*)xp + acc[ai][bj][m][0], v1 = *(const f32x4*)(xp + 4) + acc[ai][bj][m][1];
                    *(f32x4*)xp = v0; *(f32x4*)(xp + 4) = v1;
                    u32x4 w; w.x = cvt_pk_bf16(v0[0], v0[1]); w.y = cvt_pk_bf16(v0[2], v0[3]); w.z = cvt_pk_bf16(v1[0], v1[1]); w.w = cvt_pk_bf16(v1[2], v1[3]);
                    *(u32x4*)(XB + (size_t)row * 1024 + col0 + bj * HALF) = w;
                    s += (v0[0] * v0[0] + v0[1] * v0[1]) + (v0[2] * v0[2] + v0[3] * v0[3]) + (v1[0] * v1[0] + v1[1] * v1[1]) + (v1[2] * v1[2] + v1[3] * v1[3]); }
                s += __shfl_xor(s, 16); s += __shfl_xor(s, 32);
                if (fq == 0) atomicAdd(ssq_out + row, s);
            }
    }
};
struct EpiPartial {
    static constexpr bool PERM = true, AFTER_DRAIN = false;
    float* PART; int kq;
    __device__ __forceinline__ void operator()(const f32x4 (&acc)[2][2][4][2], const Unit& u, int wr, int wc, int fr, int fq) const {
        const int row0 = (u.pm - 64) * BM + wr * 64 + fr, col0 = u.pn * BM + wc * 32 + 8 * fq; float* Pb = PART + ((size_t)(u.ko / kq) * 512 + row0) * 1024 + col0;
#pragma unroll
        for (int ai = 0; ai < 2; ++ai)
#pragma unroll
            for (int m = 0; m < 4; ++m)
#pragma unroll
                for (int bj = 0; bj < 2; ++bj) { float* xp = Pb + (size_t)(ai * HALF + m * 16) * 1024 + bj * HALF; *(f32x4*)xp = acc[ai][bj][m][0]; *(f32x4*)(xp + 4) = acc[ai][bj][m][1]; }
    }
};
}

DI int uq_dest(int n) { const int h = n / 96, d = n - h * 96; return d < 64 ? h * 64 + d : (d < 80 ? 512 + h * 16 + (d - 64) : 640 + h * 16 + (d - 80)); }
DI void p0_transpose_item(const float* W, int K, int N, const float* gain, bf16* WT, int row_off, int kind, float* scr, int item, int lane) {
    const int nblk = N / 32, kb = item / nblk, nb = item % nblk, k0 = 64 * kb, n0 = 32 * nb;
#pragma unroll 8
    for (int i = 0; i < 32; ++i) { const int kk = 2 * i + (lane >> 5); float v = W[(size_t)(k0 + kk) * N + n0 + (lane & 31)]; if (gain) v *= gain[k0 + kk]; scr[kk * 33 + (lane & 31)] = v; }
    __builtin_amdgcn_s_waitcnt(0); asm volatile("" ::: "memory");
    const int c = lane & 7;
#pragma unroll
    for (int j = 0; j < 4; ++j) { const int n = (lane >> 3) + 8 * j; const float* s = scr + (8 * c) * 33 + n;
        u32x4 o; o.x = pk2(s[0 * 33], s[1 * 33]); o.y = pk2(s[2 * 33], s[3 * 33]); o.z = pk2(s[4 * 33], s[5 * 33]); o.w = pk2(s[6 * 33], s[7 * 33]);
        const int dr = kind == 0 ? row_off + n0 + n : uq_dest(n0 + n);
        *(u32x4*)(WT + (size_t)dr * K + k0 + 8 * c) = o; }
    __builtin_amdgcn_s_waitcnt(0); asm volatile("" ::: "memory");
}
DI void p0_prologue(const Ctx& C) {
    float* scr = (float*)(C.lds + C.wave * 16384);
    const int gw = C.blk * NWAVE + C.wave, NGW = C.G * NWAVE, gt = C.blk * NTHR + C.tid, NGT = C.G * NTHR;
    constexpr int I_IN = 16 * 53, I_UQ = 4 * 24, I_UK = 2 * 16, I_OUT = 16 * 32, I_UPN = 16 * 128, I_DNN = 64 * 32, I_GL = 4 * 8;
    constexpr int PER_L = I_IN + I_UQ + 2 * I_UK + I_OUT + I_UPN + I_DNN + I_GL;
    for (int it = gw; it < 2 * PER_L; it += NGW) {
        const int l = it / PER_L; int r = it - l * PER_L;
        if (r < I_IN) { p0_transpose_item(C.in[I_WIN] + (size_t)l * 1024 * INW, 1024, INW, C.in[I_N1G] + l * 1024, C.wgt(l, W_IN), 0, 0, scr, r, C.lane); continue; } r -= I_IN;
        if (r < I_UQ) { p0_transpose_item(C.in[I_WUQ] + (size_t)l * 256 * 768, 256, 768, C.in[I_QNG] + l * 256, C.wgt(l, W_UQ), 0, 1, scr, r, C.lane); continue; } r -= I_UQ;
        if (r < I_UK) { p0_transpose_item(C.in[I_WUK] + (size_t)l * 128 * 512, 128, 512, C.in[I_KVNG] + l * 128, C.wgt(l, W_KV), 0, 0, scr, r, C.lane); continue; } r -= I_UK;
        if (r < I_UK) { p0_transpose_item(C.in[I_WUV] + (size_t)l * 128 * 512, 128, 512, C.in[I_KVNG] + l * 128, C.wgt(l, W_KV), 512, 0, scr, r, C.lane); continue; } r -= I_UK;
        if (r < I_OUT) { p0_transpose_item(C.in[I_WOUT] + (size_t)l * 1024 * 1024, 1024, 1024, C.in[I_ONG] + l * 1024, C.wgt(l, W_OUT), 0, 0, scr, r, C.lane); continue; } r -= I_OUT;
        if (r < I_UPN) { p0_transpose_item(C.in[I_WUP] + (size_t)l * 1024 * 4096, 1024, 4096, C.in[I_N2G] + l * 1024, C.wgt(l, W_UP), 0, 0, scr, r, C.lane); continue; } r -= I_UPN;
        if (r < I_DNN) { p0_transpose_item(C.in[I_WDN] + (size_t)l * 4096 * 1024, 4096, 1024, nullptr, C.wgt(l, W_DN), 0, 0, scr, r, C.lane); continue; } r -= I_DNN;
        p0_transpose_item(C.in[I_WGLU] + (size_t)l * 256 * 256, 256, 256, nullptr, C.wgt(l, W_GLU), 0, 0, scr, r, C.lane);
    }
    for (int i = gt; i < 2 * 96 * 1024 / 8; i += NGT) { const int l = i / (96 * 128), r = i - l * (96 * 128); *(u32x4*)(C.wgt(l, W_IN) + (size_t)INW * 1024 + (size_t)r * 8) = (u32x4){0u, 0u, 0u, 0u}; }
    for (int i = gt; i < 2 * 32 * 64 * 160 / 8; i += NGT) *(u32x4*)(C.KCN() + (size_t)i * 8) = (u32x4){0u, 0u, 0u, 0u};
    float* X = C.out + O_X; bf16* XB = C.XB(); float* sq = C.ssq(SQ_X0);
    for (int m = gw; m < T; m += NGW) {
        const float* src = m < TP ? C.in[I_XP] + (size_t)m * DM : C.in[I_XS] + (size_t)(m - TP) * DM; float s = 0.f;
#pragma unroll
        for (int j = 0; j < 4; ++j) { const f32x4 v = *(const f32x4*)(src + 256 * j + 4 * C.lane); *(f32x4*)(X + (size_t)m * DM + 256 * j + 4 * C.lane) = v;
            u32x2 w; w.x = pk2(v[0], v[1]); w.y = pk2(v[2], v[3]); *(u32x2*)(XB + (size_t)m * DM + 256 * j + 4 * C.lane) = w; s += (v[0] * v[0] + v[1] * v[1]) + (v[2] * v[2] + v[3] * v[3]); }
        s = wave_sum(s); if (C.lane == 0) sq[m] = s;
    }
    for (int i = gt; i < 2 * 16 * 64; i += NGT) {
        const int l = i >> 10, g = (i >> 6) & 15;
        const float dt = expf(C.in[I_LDT][l * 16 + g]), lr = C.in[I_LRE][i], li = C.in[I_LIM][i];
        const float mag = expf(lr * dt); float sn, cs; sincosf(li * dt, &sn, &cs); const float abr = mag * cs, abi = mag * sn;
        const float den = lr * lr + li * li, ir = lr / den, ii = -li / den;
        const float zr = (abr - 1.f) * ir - abi * ii, zi = (abr - 1.f) * ii + abi * ir;
        float* AB = C.misc(M_AB); AB[2 * i] = abr; AB[2 * i + 1] = abi;
        float* BR = C.misc(M_BBRE) + (size_t)i * 16; float* BI = C.misc(M_BBIM) + (size_t)i * 16;
        for (int h = 0; h < 16; ++h) { const float br = C.in[I_BRE][(size_t)i * 16 + h], bi = C.in[I_BIM][(size_t)i * 16 + h]; BR[h] = zr * br - zi * bi; BI[h] = zr * bi + zi * br; }
    }
    for (int i = gt; i < 256; i += NGT) { const float a = C.in[I_LBL][i], b = C.in[I_LBL][256 + i]; const float mx = fmaxf(a, b), ea = expf(a - mx), eb = expf(b - mx);
        C.misc(M_LB)[i] = 0.f; C.misc(M_LB)[256 + i] = eb / (ea + eb); }
    for (int i = gt; i < 16384 * 16; i += NGT) { const int pos = i >> 4, k = i & 15; const double inv = pow(10000.0, -(double)k / 16.0); const double a = (double)pos * inv;
        C.misc(M_COS)[i] = (float)cos(a); C.misc(M_SIN)[i] = (float)sin(a); }
}

DI void misc_rows(const Ctx& C, int l) {
    const int gw = C.blk * NWAVE + C.wave, NGW = C.G * NWAVE; const bf16* P = C.PROJ(); const float* sq = C.ssq(SQ_KVA + l);
    const float* g = C.in[I_KVNG] + l * 128; const float* cs = C.misc(M_COS); const float* sn = C.misc(M_SIN);
    for (int m = gw; m < T; m += NGW) {
        const float r = rsqrtf(sq[m] * (1.f / 128.f) + EPS); const int lane = C.lane;
        const unsigned w = *(const unsigned*)(P + (size_t)m * INP + C_CKV + 2 * lane);
        const float c0 = bflo(w) * r * g[2 * lane], c1 = bfhi(w) * r * g[2 * lane + 1];
        float k1 = 0.f, k2 = 0.f;
        if (lane < 16) { const float x1 = bf2f(P[(size_t)m * INP + C_KPE + lane]), x2 = bf2f(P[(size_t)m * INP + C_KPE + 16 + lane]); const int pos = pos_of_row(m);
            const float c = cs[pos * 16 + lane], s = sn[pos * 16 + lane]; k1 = x1 * c - x2 * s; k2 = x2 * c + x1 * s; }
        if (m < TP) {
            float* okv = C.out + O_PKV + ((size_t)l * TP + m) * 128; *(f32x2_t*)(okv + 2 * lane) = (f32x2_t){c0, c1};
            if (lane < 16) { float* ope = C.out + O_PPE + ((size_t)l * TP + m) * 32; ope[lane] = k1; ope[16 + lane] = k2; bf16* kb = C.KPEB() + (size_t)m * 32; kb[lane] = f2bf(k1); kb[16 + lane] = f2bf(k2); }
        } else {
            const int bi = m - TP, b = bi >> 4, i = bi & 15;
            float* okv = C.out + O_SKV + ((size_t)l * TS + bi) * 128; *(f32x2_t*)(okv + 2 * lane) = (f32x2_t){c0, c1};
            bf16* kc = C.KCN() + ((size_t)(l * 32 + b) * 64 + i) * 160; *(unsigned*)(kc + 2 * lane) = pk2(c0, c1);
            if (lane < 16) { float* ope = C.out + O_SPE + ((size_t)l * TS + bi) * 32; ope[lane] = k1; ope[16 + lane] = k2; kc[128 + lane] = f2bf(k1); kc[144 + lane] = f2bf(k2); }
        }
    }
}

constexpr int S5_UP = 528, S5_HP = 272, S5_HS = 33792;
template <bool FINAL> DI void s5_item(const Ctx& C, int l, int ci) {
    const int lane = C.lane, w = C.wave, r = lane & 31, h = lane >> 5;
    const bool samp = ci >= 256; const int b = ci - 256; const int row0 = samp ? TP + b * 16 : ci * 64; const int ntok = samp ? 16 : 64;
    char* UZ = C.lds; char* HS = C.lds + S5_HS + w * (32 * S5_HP);
    const bf16* P = C.PROJ();
    for (int i = C.tid; i < 2048; i += NTHR) { const int t = i >> 5, c8 = i & 31; u32x4 v = (u32x4){0u, 0u, 0u, 0u}; if (t < ntok) v = *(const u32x4*)(P + (size_t)(row0 + t) * INP + c8 * 8); *(u32x4*)(UZ + t * S5_UP + c8 * 16) = v; }
    __syncthreads();
    for (int gi = 0; gi < 2; ++gi) {
        const int g = 2 * w + gi; const int sidx = (l * 16 + g) * 64 + lane;
        float bbr[16], bbi[16];
        { const float* BR = C.misc(M_BBRE) + (size_t)sidx * 16; const float* BI = C.misc(M_BBIM) + (size_t)sidx * 16;
#pragma unroll
          for (int q = 0; q < 4; ++q) { const f32x4 a = *(const f32x4*)(BR + 4 * q), c = *(const f32x4*)(BI + 4 * q);
#pragma unroll
              for (int e = 0; e < 4; ++e) { bbr[4 * q + e] = a[e]; bbi[4 * q + e] = c[e]; } } }
        const float abr = C.misc(M_AB)[2 * sidx], abi = C.misc(M_AB)[2 * sidx + 1];
        float hr = 0.f, hi = 0.f;
        if (FINAL) {
            if (samp) { hr = C.in[I_S5RE][((size_t)(l * 32 + b) * 16 + g) * 64 + lane]; hi = C.in[I_S5IM][((size_t)(l * 32 + b) * 16 + g) * 64 + lane]; }
            else { float pr = abr, pi = abi;
#pragma unroll
                for (int q = 0; q < 6; ++q) { const float nr = pr * pr - pi * pi, ni = 2.f * pr * pi; pr = nr; pi = ni; }
                const float* E = C.E5() + ((size_t)g * 64 + lane) * 2;
                for (int c = 0; c < ci; ++c) { const f32x2_t e = *(const f32x2_t*)(E + (size_t)c * 2048); const float nr = pr * hr - pi * hi + e.x, ni = pr * hi + pi * hr + e.y; hr = nr; hi = ni; } }
        }
        bf16x8 cf[8];
        if (FINAL) {
#pragma unroll
            for (int ks = 0; ks < 8; ++ks) { f32x4 a = (f32x4){0.f, 0.f, 0.f, 0.f}, c = a;
                if (r < 16) { const float* src = (ks < 4 ? C.in[I_CRE] : C.in[I_CIM]) + ((size_t)(l * 16 + g) * 16 + r) * 64 + 16 * (ks & 3) + 8 * h; a = *(const f32x4*)src; c = *(const f32x4*)(src + 4); if (ks >= 4) { a = -a; c = -c; } }
                cf[ks] = packf8(a[0], a[1], a[2], a[3], c[0], c[1], c[2], c[3]); }
        }
        const float dch = (FINAL && r < 16) ? C.in[I_S5D][l * 256 + g * 16 + r] : 0.f;
        for (int half = 0; half < 2; ++half) {
            if (half * 32 >= ntok) break;
            for (int tt = 0; tt < 32; ++tt) {
                const int t = half * 32 + tt;
                if (t < ntok) {
                    const u32x4 u0 = *(const u32x4*)(UZ + t * S5_UP + g * 32), u1 = *(const u32x4*)(UZ + t * S5_UP + g * 32 + 16);
                    float uu[16]; uu[0] = bflo(u0.x); uu[1] = bfhi(u0.x); uu[2] = bflo(u0.y); uu[3] = bfhi(u0.y); uu[4] = bflo(u0.z); uu[5] = bfhi(u0.z); uu[6] = bflo(u0.w); uu[7] = bfhi(u0.w);
                    uu[8] = bflo(u1.x); uu[9] = bfhi(u1.x); uu[10] = bflo(u1.y); uu[11] = bfhi(u1.y); uu[12] = bflo(u1.z); uu[13] = bfhi(u1.z); uu[14] = bflo(u1.w); uu[15] = bfhi(u1.w);
                    float br = 0.f, bi = 0.f;
#pragma unroll
                    for (int q = 0; q < 16; ++q) { br += bbr[q] * uu[q]; bi += bbi[q] * uu[q]; }
                    const float nr = abr * hr - abi * hi + br, ni = abr * hi + abi * hr + bi; hr = nr; hi = ni;
                }
                if (FINAL) { *(bf16*)(HS + tt * S5_HP + lane * 2) = f2bf(hr); *(bf16*)(HS + tt * S5_HP + 128 + lane * 2) = f2bf(hi); }
            }
            if (FINAL) {
                f32x16 acc = {};
#pragma unroll
                for (int ks = 0; ks < 8; ++ks) acc = MFMA32(lds16(HS + r * S5_HP + (16 * ks + 8 * h) * 2), cf[ks], acc);
                if (r < 16) { const int ch = g * 16 + r;
#pragma unroll
                    for (int i = 0; i < 16; ++i) { const int t = half * 32 + crow(i, h);
                        if (t < ntok) { bf16* zp = (bf16*)(UZ + t * S5_UP + ch * 2); const float y = acc[i] + dch * bf2f(*zp);
                            const float a = 0.7978845608f * (y + 0.044715f * y * y * y); const float th = 1.f - 2.f / (1.f + __expf(2.f * a)); *zp = f2bf(0.5f * y * (1.f + th)); } } }
            }
        }
        if (FINAL) {
            if (samp) { C.out[O_SRE + ((size_t)(l * 32 + b) * 16 + g) * 64 + lane] = hr; C.out[O_SIM + ((size_t)(l * 32 + b) * 16 + g) * 64 + lane] = hi; }
            else if (ci == 255) { C.out[O_PRE + ((size_t)l * 16 + g) * 64 + lane] = hr; C.out[O_PIM + ((size_t)l * 16 + g) * 64 + lane] = hi; }
        } else { *(f32x2_t*)(C.E5() + ((size_t)ci * 1024 + g * 64 + lane) * 2) = (f32x2_t){hr, hi}; }
    }
    if (FINAL) {
        __syncthreads();
        f32x16 ga[2] = {{}, {}};
        const bf16* WG = C.wgt(l, W_GLU);
#pragma unroll 4
        for (int ks = 0; ks < 16; ++ks) { const bf16x8 bfr = *(const bf16x8*)(WG + (size_t)(32 * w + r) * 256 + 16 * ks + 8 * h);
            ga[0] = MFMA32(lds16(UZ + r * S5_UP + (16 * ks + 8 * h) * 2), bfr, ga[0]); ga[1] = MFMA32(lds16(UZ + (32 + r) * S5_UP + (16 * ks + 8 * h) * 2), bfr, ga[1]); }
        __syncthreads();
        const int n = 32 * w + r; const float bg = C.in[I_BGLU][l * 256 + n];
#pragma unroll
        for (int rb = 0; rb < 2; ++rb)
#pragma unroll
            for (int i = 0; i < 16; ++i) { const int t = 32 * rb + crow(i, h); bf16* zp = (bf16*)(UZ + t * S5_UP + n * 2); const float z = bf2f(*zp); *zp = f2bf(z * sigmoidf_(ga[rb][i] + bg)); }
        __syncthreads();
        { const int t = C.tid >> 3, s8 = C.tid & 7; float v[32]; float s = 0.f;
#pragma unroll
          for (int q = 0; q < 4; ++q) { const u32x4 u = *(const u32x4*)(UZ + t * S5_UP + s8 * 64 + q * 16);
              v[8 * q] = bflo(u.x); v[8 * q + 1] = bfhi(u.x); v[8 * q + 2] = bflo(u.y); v[8 * q + 3] = bfhi(u.y); v[8 * q + 4] = bflo(u.z); v[8 * q + 5] = bfhi(u.z); v[8 * q + 6] = bflo(u.w); v[8 * q + 7] = bfhi(u.w); }
#pragma unroll
          for (int q = 0; q < 32; ++q) s += v[q] * v[q];
          s += __shfl_xor(s, 1); s += __shfl_xor(s, 2); s += __shfl_xor(s, 4);
          const float rn = rsqrtf(s * (1.f / 256.f) + EPS);
          if (t < ntok) { bf16* dst = C.MIX() + (size_t)(row0 + t) * DM + s8 * 32;
#pragma unroll
              for (int q = 0; q < 4; ++q) { u32x4 o; o.x = pk2(v[8 * q] * rn, v[8 * q + 1] * rn); o.y = pk2(v[8 * q + 2] * rn, v[8 * q + 3] * rn); o.z = pk2(v[8 * q + 4] * rn, v[8 * q + 5] * rn); o.w = pk2(v[8 * q + 6] * rn, v[8 * q + 7] * rn);
                  *(u32x4*)(dst + 8 * q) = o; } } }
    }
    __syncthreads();
}

constexpr int HG_P = 136, HG_WB = 2 * 64 * HG_P;
DI void hgrn_local(const Ctx& C, int l, int it) {
    const int lane = C.lane, r = lane & 31, h = lane >> 5; const int ci = it >> 2, hd = it & 3;
    const bool samp = ci >= 256; const int row0 = samp ? TP + (ci - 256) * 16 : ci * 64; const int ntok = samp ? 16 : 64, tref = (ntok >> 1) - 1;
    char* KT = C.lds + C.wave * HG_WB; char* VT = KT + 64 * HG_P; bf16* P = C.PROJ();
    const float lb = C.misc(M_LB)[l * 256 + hd * 64 + lane], omlb = 1.f - lb;
    float b = 0.f, bref = 0.f;
    for (int t = 0; t < ntok; ++t) { const float fp = bf2f(P[(size_t)(row0 + t) * INP + C_HF + hd * 64 + lane]); const float f = lb + omlb * sigmoidf_(fp); b += __logf(f); if (t == tref) bref = b; }
    const float blast = b; b = 0.f;
    for (int t = 0; t < 64; ++t) {
        float qt = 0.f, kt = 0.f, vv = 0.f;
        if (t < ntok) { bf16* pq = P + (size_t)(row0 + t) * INP + C_HQ + hd * 64 + lane; bf16* pf = P + (size_t)(row0 + t) * INP + C_HF + hd * 64 + lane;
            const float fp = bf2f(*pf), hq = bf2f(*pq); const float sg = sigmoidf_(fp); const float f = lb + omlb * sg; b += __logf(f);
            qt = hq * sigmoidf_(hq) * __expf(b - bref); kt = omlb * (1.f - sg) * __expf(bref - b);
            *pq = f2bf(qt); *pf = f2bf(kt); vv = bf2f(P[(size_t)(row0 + t) * INP + C_HI + hd * 64 + lane]); }
        *(bf16*)(KT + lane * HG_P + t * 2) = f2bf(kt); *(bf16*)(VT + lane * HG_P + t * 2) = f2bf(vv);
    }
    C.DD()[(size_t)ci * 256 + hd * 64 + lane] = __expf(blast); C.EBM()[(size_t)ci * 256 + hd * 64 + lane] = __expf(bref);
    const float scg = __expf(blast - bref);
    f32x16 acc[2][2] = {{{}, {}}, {{}, {}}};
#pragma unroll
    for (int ks = 0; ks < 4; ++ks) { bf16x8 a[2], bb[2];
#pragma unroll
        for (int q = 0; q < 2; ++q) { a[q] = lds8x2(VT + (32 * q + r) * HG_P + (16 * ks + 8 * h) * 2); bb[q] = lds8x2(KT + (32 * q + r) * HG_P + (16 * ks + 8 * h) * 2); }
#pragma unroll
        for (int vb = 0; vb < 2; ++vb)
#pragma unroll
            for (int db = 0; db < 2; ++db) acc[vb][db] = MFMA32(a[vb], bb[db], acc[vb][db]); }
    float* G = C.GT() + ((size_t)ci * 4 + hd) * 4096;
#pragma unroll
    for (int db = 0; db < 2; ++db) { const float sc = __shfl(scg, 32 * db + r);
#pragma unroll
        for (int vb = 0; vb < 2; ++vb)
#pragma unroll
            for (int i = 0; i < 16; ++i) G[(32 * vb + crow(i, h)) * 64 + 32 * db + r] = acc[vb][db][i] * sc; }
}
DI void hgrn_prefix(const Ctx& C, int l) {
    const int e = C.blk * NTHR + C.tid;
    if (e < 16384) { const int hd = e >> 12, vd = e & 4095, d = vd & 63, v = vd >> 6; float* G = C.GT() + (size_t)hd * 4096 + vd; const float* D = C.DD() + hd * 64 + d; float S = 0.f;
        for (int c0 = 0; c0 < 256; c0 += 16) { float g[16], dd[16];
#pragma unroll
            for (int q = 0; q < 16; ++q) { g[q] = G[(size_t)(c0 + q) * 16384]; dd[q] = D[(size_t)(c0 + q) * 256]; }
#pragma unroll
            for (int q = 0; q < 16; ++q) { G[(size_t)(c0 + q) * 16384] = S; S = dd[q] * S + g[q]; } }
        C.out[O_PHG + (size_t)l * 16384 + hd * 4096 + d * 64 + v] = S; }
    for (int i = e; i < 32 * 16384; i += C.G * NTHR) { const int b = i >> 14, hv = i & 16383, hd = hv >> 12, vd = hv & 4095, d = vd & 63, v = vd >> 6;
        const float S0 = C.in[I_SHG][((size_t)(l * 32 + b) * 4 + hd) * 4096 + d * 64 + v]; float* G = C.GT() + (size_t)(256 + b) * 16384 + hv;
        const float S1 = C.DD()[(size_t)(256 + b) * 256 + hd * 64 + d] * S0 + *G; *G = S0; C.out[O_SHG + ((size_t)(l * 32 + b) * 4 + hd) * 4096 + d * 64 + v] = S1; }
}
DI void hgrn_final(const Ctx& C, int l, int bi) {
    const int lane = C.lane, r = lane & 31, h = lane >> 5; const int it = bi * 8 + C.wave, ci = it >> 2, hd = it & 3;
    const bool samp = ci >= 256; const int row0 = samp ? TP + (ci - 256) * 16 : ci * 64; const int ntok = samp ? 16 : 64;
    char* VT = C.lds + C.wave * HG_WB; float* SS = (float*)(C.lds + 8 * HG_WB); const bf16* P = C.PROJ();
    for (int t = 0; t < 64; ++t) { float vv = 0.f; if (t < ntok) vv = bf2f(P[(size_t)(row0 + t) * INP + C_HI + hd * 64 + lane]); *(bf16*)(VT + lane * HG_P + t * 2) = f2bf(vv); }
    bf16x8 qf[2][4];
    f32x16 at[2][2] = {{{}, {}}, {{}, {}}};
    const bf16x8 zf = {0, 0, 0, 0, 0, 0, 0, 0};
#pragma unroll
    for (int ks = 0; ks < 4; ++ks) { bf16x8 kf[2];
#pragma unroll
        for (int q = 0; q < 2; ++q) { const int t = 32 * q + r; const bool ok = t < ntok;
            qf[q][ks] = ok ? *(const bf16x8*)(P + (size_t)(row0 + t) * INP + C_HQ + hd * 64 + 16 * ks + 8 * h) : zf;
            kf[q] = ok ? *(const bf16x8*)(P + (size_t)(row0 + t) * INP + C_HF + hd * 64 + 16 * ks + 8 * h) : zf; }
        at[0][0] = MFMA32(kf[0], qf[0][ks], at[0][0]); at[0][1] = MFMA32(kf[0], qf[1][ks], at[0][1]); at[1][1] = MFMA32(kf[1], qf[1][ks], at[1][1]); }
#pragma unroll
    for (int i = 0; i < 16; ++i) { const int s = crow(i, h); if (s > r) { at[0][0][i] = 0.f; at[1][1][i] = 0.f; } }
    f32x16 o[2][2] = {{{}, {}}, {{}, {}}};
#pragma unroll
    for (int sb = 0; sb < 2; ++sb)
#pragma unroll
        for (int tb = sb; tb < 2; ++tb)
#pragma unroll
            for (int s2 = 0; s2 < 2; ++s2) { const f32x16& x = at[sb][tb];
                const bf16x8 pkx = packf8(x[8 * s2], x[8 * s2 + 1], x[8 * s2 + 2], x[8 * s2 + 3], x[8 * s2 + 4], x[8 * s2 + 5], x[8 * s2 + 6], x[8 * s2 + 7]);
#pragma unroll
                for (int vb = 0; vb < 2; ++vb) { const char* vp = VT + (32 * vb + r) * HG_P + (32 * sb + 16 * s2 + 4 * h) * 2;
                    const s16x4 lo = *(const s16x4*)vp, hi = *(const s16x4*)(vp + 16); const bf16x8 a2 = __builtin_shufflevector(lo, hi, 0, 1, 2, 3, 4, 5, 6, 7);
                    o[vb][tb] = MFMA32(a2, pkx, o[vb][tb]); } }
    { const float* S = C.GT() + ((size_t)ci * 4 + hd) * 4096; const float* EB = C.EBM() + (size_t)ci * 256 + hd * 64;
#pragma unroll
      for (int ks = 0; ks < 4; ++ks) { const f32x4 e0 = *(const f32x4*)(EB + 16 * ks + 8 * h), e1 = *(const f32x4*)(EB + 16 * ks + 8 * h + 4);
#pragma unroll
          for (int vb = 0; vb < 2; ++vb) { const float* sp = S + (32 * vb + r) * 64 + 16 * ks + 8 * h; const f32x4 s0 = *(const f32x4*)sp * e0, s1 = *(const f32x4*)(sp + 4) * e1;
              const bf16x8 sf = packf8(s0[0], s0[1], s0[2], s0[3], s1[0], s1[1], s1[2], s1[3]);
              o[vb][0] = MFMA32(sf, qf[0][ks], o[vb][0]); o[vb][1] = MFMA32(sf, qf[1][ks], o[vb][1]); } } }
    float sq[2];
#pragma unroll
    for (int tb = 0; tb < 2; ++tb) { float s = 0.f;
#pragma unroll
        for (int vb = 0; vb < 2; ++vb)
#pragma unroll
            for (int i = 0; i < 16; ++i) s += o[vb][tb][i] * o[vb][tb][i];
        s += __shfl_xor(s, 32); sq[tb] = s; if (h == 0) SS[C.wave * 64 + 32 * tb + r] = s; }
    __syncthreads();
    const int wb = C.wave & 4;
#pragma unroll
    for (int tb = 0; tb < 2; ++tb) { const int t = 32 * tb + r; const float tot = SS[(wb + 0) * 64 + t] + SS[(wb + 1) * 64 + t] + SS[(wb + 2) * 64 + t] + SS[(wb + 3) * 64 + t];
        const float rn = rsqrtf(tot * (1.f / 256.f) + EPS);
        if (t < ntok) {
#pragma unroll
            for (int vb = 0; vb < 2; ++vb)
#pragma unroll
                for (int g4 = 0; g4 < 4; ++g4) { const int v = 32 * vb + 8 * g4 + 4 * h; const u32x2 gw = *(const u32x2*)(P + (size_t)(row0 + t) * INP + C_HG + hd * 64 + v);
                    const float g0 = bflo(gw.x), g1 = bfhi(gw.x), g2 = bflo(gw.y), g3 = bfhi(gw.y);
                    u32x2 ow; ow.x = pk2(o[vb][tb][4 * g4] * rn * g0 * sigmoidf_(g0), o[vb][tb][4 * g4 + 1] * rn * g1 * sigmoidf_(g1)); ow.y = pk2(o[vb][tb][4 * g4 + 2] * rn * g2 * sigmoidf_(g2), o[vb][tb][4 * g4 + 3] * rn * g3 * sigmoidf_(g3));
                    *(u32x2*)(C.MIX() + (size_t)(row0 + t) * DM + 256 + hd * 64 + v) = ow; } } }
    __syncthreads();
}

#ifndef ATT_VTRANS
#define ATT_VTRANS 0
#endif
constexpr int AT_QS = 49152, AT_QN = 92160, AT_OLP = 132;
template <bool SAMPLE> DI void attn_unit(const Ctx& C, int l, int hd_or_b, int qb, int pass = 0) {
    constexpr int DQK = SAMPLE ? 160 : 96, DV = SAMPLE ? 128 : 64, KP = SAMPLE ? 336 : 208, VP = SAMPLE ? 336 : 144, NKS = DQK / 16, NVB = DV / 32;
    const int tid = C.tid, lane = C.lane, w = C.wave, r = lane & 31, h = lane >> 5;
    constexpr int KBUF = 64 * KP, VBUF = SAMPLE ? KBUF : 64 * VP, VOFF = SAMPLE ? 0 : 2 * KBUF;
    char* KB = C.lds; char* VB = C.lds + VOFF; char* QS = C.lds + AT_QS;
    const int ntiles = SAMPLE ? 33 : 4 * qb + 4;
    const int q0 = SAMPLE ? 0 : qb * 256;
    const bool wave_on = SAMPLE ? (w < 4) : true;
    const int wchunk = SAMPLE ? 1000 : 4 * qb + (w >> 1);
    bf16x8 qf[SAMPLE ? 1 : NKS];
    const bf16* KVF = C.KVF(); const bf16* KPE = C.KPEB();
    const float* ckv = SAMPLE ? C.in[I_CKV] + (size_t)(l * 32 + hd_or_b) * PAST * 128 : nullptr;
    const float* cpe = SAMPLE ? C.in[I_CPE] + (size_t)(l * 32 + hd_or_b) * PAST * 32 : nullptr;
    const bf16* kcn = SAMPLE ? C.KCN() + (size_t)(l * 32 + hd_or_b) * 64 * 160 : nullptr;
    u32x4 st0, st1, st2; f32x4 sf[5];
#define AT_PREFETCH(j) do { \
        if (!SAMPLE) { \
            const int key = tm >> 3, part = tm & 7; const size_t row = (size_t)(64 * (j) + key); \
            st0 = *(const u32x4*)(KVF + row * 1024 + hd_or_b * 64 + part * 8); \
            st1 = *(const u32x4*)(KVF + row * 1024 + 512 + hd_or_b * 64 + part * 8); \
            if (tm < 256) st2 = *(const u32x4*)(KPE + (size_t)(64 * (j) + (tm >> 2)) * 32 + (tm & 3) * 8); \
        } else if ((j) < 32) { \
            _Pragma("unroll") \
            for (int i = 0; i < 4; ++i) { const int idx = tm + 512 * i; sf[i] = *(const f32x4*)(ckv + (size_t)(64 * (j) + (idx >> 5)) * 128 + (idx & 31) * 4); } \
            sf[4] = *(const f32x4*)(cpe + (size_t)(64 * (j) + (tm >> 3)) * 32 + (tm & 7) * 4); \
        } else { \
            st0 = *(const u32x4*)(kcn + (size_t)tm * 8); st1 = *(const u32x4*)(kcn + (size_t)(tm + 512) * 8); if (tm < 256) st2 = *(const u32x4*)(kcn + (size_t)(tm + 1024) * 8); \
        } \
    } while (0)
#define AT_COMMIT(j, bsel) do { char* KBw = KB + (bsel) * KBUF; char* VBw = VB + (bsel) * VBUF; \
        if (!SAMPLE) { \
            const int key = tm >> 3, part = tm & 7; \
            *(u32x4*)(KBw + key * KP + part * 16) = st0; *(u32x4*)(VBw + key * VP + part * 16) = st1; \
            if (tm < 256) *(u32x4*)(KBw + (tm >> 2) * KP + 128 + (tm & 3) * 16) = st2; \
        } else if ((j) < 32) { \
            _Pragma("unroll") \
            for (int i = 0; i < 4; ++i) { const int idx = tm + 512 * i; u32x2 wv; wv.x = pk2(sf[i][0], sf[i][1]); wv.y = pk2(sf[i][2], sf[i][3]); *(u32x2*)(KBw + (idx >> 5) * KP + (idx & 31) * 8) = wv; } \
            { u32x2 wv; wv.x = pk2(sf[4][0], sf[4][1]); wv.y = pk2(sf[4][2], sf[4][3]); *(u32x2*)(KBw + (tm >> 3) * KP + 256 + (tm & 7) * 8) = wv; } \
        } else { \
            { const int c = tm; *(u32x4*)(KBw + (c / 20) * KP + (c % 20) * 16) = st0; } \
            { const int c = tm + 512; *(u32x4*)(KBw + (c / 20) * KP + (c % 20) * 16) = st1; } \
            if (tm < 256) { const int c = tm + 1024; *(u32x4*)(KBw + (c / 20) * KP + (c % 20) * 16) = st2; } \
        } \
    } while (0)
    int tm = tid;
    if (!SAMPLE) AT_PREFETCH(0);
    if (SAMPLE) {
        const int R = tid >> 2, part = tid & 3, hh = R >> 4, i = R & 15; const bf16* qrow = C.QF() + (size_t)(TP + hd_or_b * 16 + i) * 768 + hh * 96;
        float* QN = (float*)(C.lds + AT_QN) + R * 64;
        { const u32x4 u0 = *(const u32x4*)(qrow + part * 16), u1 = *(const u32x4*)(qrow + part * 16 + 8);
          *(f32x4*)(QN + part * 16) = (f32x4){bflo(u0.x), bfhi(u0.x), bflo(u0.y), bfhi(u0.y)}; *(f32x4*)(QN + part * 16 + 4) = (f32x4){bflo(u0.z), bfhi(u0.z), bflo(u0.w), bfhi(u0.w)};
          *(f32x4*)(QN + part * 16 + 8) = (f32x4){bflo(u1.x), bfhi(u1.x), bflo(u1.y), bfhi(u1.y)}; *(f32x4*)(QN + part * 16 + 12) = (f32x4){bflo(u1.z), bfhi(u1.z), bflo(u1.w), bfhi(u1.w)}; }
        __syncthreads();
        const float* wuk = C.in[I_WUK] + (size_t)l * 128 * 512 + hh * 64;
#pragma unroll 1
        for (int cc = 0; cc < 32; cc += 2) { float a0 = 0.f, a1 = 0.f; const float* w0 = wuk + (size_t)(part * 32 + cc) * 512; const float* w1 = w0 + 512;
#pragma unroll 2
            for (int q = 0; q < 16; ++q) { const f32x4 qv = *(const f32x4*)(QN + 4 * q); const f32x4 x0 = *(const f32x4*)(w0 + 4 * q), x1 = *(const f32x4*)(w1 + 4 * q);
                a0 += qv[0] * x0[0] + qv[1] * x0[1] + qv[2] * x0[2] + qv[3] * x0[3]; a1 += qv[0] * x1[0] + qv[1] * x1[1] + qv[2] * x1[2] + qv[3] * x1[3]; }
            *(unsigned*)(QS + R * 336 + (part * 32 + cc) * 2) = pk2(a0, a1); }
        if (part < 2) { const int pos = PAST + i; const float* cs = C.misc(M_COS) + pos * 16 + 8 * part; const float* sn = C.misc(M_SIN) + pos * 16 + 8 * part;
            const u32x4 x1 = *(const u32x4*)(qrow + 64 + part * 8), x2 = *(const u32x4*)(qrow + 80 + part * 8); u32x4 y1, y2;
#pragma unroll
            for (int e = 0; e < 4; ++e) { const float a0 = bflo(x1[e]), a1 = bfhi(x1[e]), b0 = bflo(x2[e]), b1 = bfhi(x2[e]); const float c0 = cs[2 * e], c1 = cs[2 * e + 1], s0 = sn[2 * e], s1 = sn[2 * e + 1];
                y1[e] = pk2(a0 * c0 - b0 * s0, a1 * c1 - b1 * s1); y2[e] = pk2(b0 * c0 + a0 * s0, b1 * c1 + a1 * s1); }
            *(u32x4*)(QS + R * 336 + 256 + part * 16) = y1; *(u32x4*)(QS + R * 336 + 288 + part * 16) = y2; }
        __syncthreads();
    } else {
        const bf16* qrow = C.QF() + (size_t)(q0 + 32 * w + r) * 768 + hd_or_b * 96;
#pragma unroll
        for (int ks = 0; ks < NKS; ++ks) qf[ks] = *(const bf16x8*)(qrow + 16 * ks + 8 * h);
        { const int pos = q0 + 32 * w + r; const float* cs = C.misc(M_COS) + pos * 16 + 8 * h; const float* sn = C.misc(M_SIN) + pos * 16 + 8 * h;
          const u32x4 x1 = __builtin_bit_cast(u32x4, qf[4]), x2 = __builtin_bit_cast(u32x4, qf[5]); u32x4 y1, y2;
#pragma unroll
          for (int e = 0; e < 4; ++e) { const float a0 = bflo(x1[e]), a1 = bfhi(x1[e]), b0 = bflo(x2[e]), b1 = bfhi(x2[e]); const float c0 = cs[2 * e], c1 = cs[2 * e + 1], s0 = sn[2 * e], s1 = sn[2 * e + 1];
              y1[e] = pk2(a0 * c0 - b0 * s0, a1 * c1 - b1 * s1); y2[e] = pk2(b0 * c0 + a0 * s0, b1 * c1 + a1 * s1); }
          qf[4] = __builtin_bit_cast(bf16x8, y1); qf[5] = __builtin_bit_cast(bf16x8, y2); }
    }
    if (SAMPLE) { asm volatile("" : "+v"(tm)); AT_PREFETCH(0); }
    float mref = 0.f, lrun = 0.f; f32x16 o[NVB]; f32x16 negm = {};
#pragma unroll
    for (int vb = 0; vb < NVB; ++vb) o[vb] = f32x16{};
    const int i16 = lane & 15, gg = (lane >> 4) & 1;
    const char* vlane = VB + (4 * h + (i16 >> 2)) * VP + (16 * gg + 4 * (i16 & 3)) * 2;
    AT_COMMIT(0, 0);
    if (ntiles > 1) AT_PREFETCH(1);
    __syncthreads();
    for (int j = 0; j < ntiles; ++j) {
        const int cb = j & 1;
        if (j + 1 < ntiles) AT_COMMIT(j + 1, cb ^ 1);
        if (j + 2 < ntiles) AT_PREFETCH(j + 2);
        if (wave_on && j <= wchunk) {
            const char* KBc = KB + cb * KBUF; const char* vlc = vlane + cb * VBUF;
            f32x16 p0 = negm, p1 = negm;
#pragma unroll
            for (int ks = 0; ks < NKS; ++ks) { const bf16x8 qv = SAMPLE ? lds16(QS + (32 * w + r) * 336 + (16 * ks + 8 * h) * 2) : qf[ks]; p0 = MFMA32(lds16(KBc + r * KP + (16 * ks + 8 * h) * 2), qv, p0); p1 = MFMA32(lds16(KBc + (32 + r) * KP + (16 * ks + 8 * h) * 2), qv, p1); }
            if (SAMPLE && j == 32) {
#pragma unroll
                for (int i = 0; i < 16; ++i) { if (crow(i, h) >= 16) p0[i] = -1e30f; p1[i] = -1e30f; }
            }
            float mx = fmaxf(fmaxf(p0[0], p0[1]), p1[0]);
#pragma unroll
            for (int i = 2; i < 16; i += 2) mx = fmaxf(fmaxf(mx, p0[i]), p0[i + 1]);
#pragma unroll
            for (int i = 1; i < 15; i += 2) mx = fmaxf(fmaxf(mx, p1[i]), p1[i + 1]);
            mx = fmaxf(mx, p1[15]);
            mx = fmaxf(mx, __shfl_xor(mx, 32));
            if (j == 0) { mref = mx;
#pragma unroll
                for (int i = 0; i < 16; ++i) { p0[i] -= mx; p1[i] -= mx; negm[i] = -mref; }
            } else if (__any(mx > 8.f)) { const float dl = fmaxf(mx, 0.f), al = __builtin_amdgcn_exp2f(-dl); mref += dl; lrun *= al;
#pragma unroll
                for (int i = 0; i < 16; ++i) { p0[i] -= dl; p1[i] -= dl; negm[i] = -mref; }
#pragma unroll
                for (int vb = 0; vb < NVB; ++vb)
#pragma unroll
                    for (int i = 0; i < 16; ++i) o[vb][i] *= al;
            }
            float ls = 0.f;
#pragma unroll
            for (int i = 0; i < 16; ++i) { p0[i] = __builtin_amdgcn_exp2f(p0[i]); p1[i] = __builtin_amdgcn_exp2f(p1[i]); ls += p0[i] + p1[i]; }
            lrun += ls;
#pragma unroll
            for (int kb = 0; kb < 2; ++kb)
#pragma unroll
                for (int s2 = 0; s2 < 2; ++s2) { const f32x16& x = kb ? p1 : p0;
                    const bf16x8 pkx = packf8(x[8 * s2], x[8 * s2 + 1], x[8 * s2 + 2], x[8 * s2 + 3], x[8 * s2 + 4], x[8 * s2 + 5], x[8 * s2 + 6], x[8 * s2 + 7]);
#pragma unroll
                    for (int vb = 0; vb < NVB; ++vb) { const char* vp = vlc + (32 * kb + 16 * s2) * VP + 64 * vb;
                        const s16x4 lo = ldtr(vp), hi = ldtr(vp + 8 * VP); const bf16x8 a2 = __builtin_shufflevector(lo, hi, 0, 1, 2, 3, 4, 5, 6, 7);
                        o[vb] = MFMA32(a2, pkx, o[vb]); }
                    asm volatile("" ::: "memory"); }
        }
        __syncthreads();
    }
    lrun += __shfl_xor(lrun, 32); const float inv = 1.f / lrun;
    if (!SAMPLE) {
        const int row = q0 + 32 * w + r; float s = 0.f; bf16* dst = C.MIX() + (size_t)row * DM + 512 + hd_or_b * 64;
#pragma unroll
        for (int vb = 0; vb < NVB; ++vb)
#pragma unroll
            for (int g4 = 0; g4 < 4; ++g4) { const float a0 = o[vb][4 * g4] * inv, a1 = o[vb][4 * g4 + 1] * inv, a2 = o[vb][4 * g4 + 2] * inv, a3 = o[vb][4 * g4 + 3] * inv;
                s += (a0 * a0 + a1 * a1) + (a2 * a2 + a3 * a3); u32x2 ow; ow.x = pk2(a0, a1); ow.y = pk2(a2, a3); *(u32x2*)(dst + 32 * vb + 8 * g4 + 4 * h) = ow; }
        s += __shfl_xor(s, 32); if (h == 0 && pass == 0) atomicAdd(C.ssq(SQ_MA + l) + row, s);
    } else {
        __syncthreads();
        float* OL = (float*)C.lds;
        if (wave_on) {
#pragma unroll
            for (int vb = 0; vb < NVB; ++vb)
#pragma unroll
                for (int i = 0; i < 16; ++i) OL[(32 * w + r) * AT_OLP + 32 * vb + crow(i, h)] = o[vb][i] * inv;
        }
        __syncthreads();
        const int R = tid >> 2, part = tid & 3, hh = R >> 4, i = R & 15; const int row = TP + hd_or_b * 16 + i;
        float acc[16];
#pragma unroll
        for (int q = 0; q < 16; ++q) acc[q] = 0.f;
        const float* wuv = C.in[I_WUV] + (size_t)l * 128 * 512 + hh * 64 + part * 16;
        for (int c = 0; c < 128; ++c) { const float ol = OL[R * AT_OLP + c];
#pragma unroll
            for (int q = 0; q < 4; ++q) { const f32x4 x = *(const f32x4*)(wuv + (size_t)c * 512 + 4 * q); acc[4 * q] += ol * x[0]; acc[4 * q + 1] += ol * x[1]; acc[4 * q + 2] += ol * x[2]; acc[4 * q + 3] += ol * x[3]; } }
        float s = 0.f;
#pragma unroll
        for (int q = 0; q < 16; ++q) s += acc[q] * acc[q];
        bf16* dst = C.MIX() + (size_t)row * DM + 512 + hh * 64 + part * 16;
        u32x4 o0, o1; o0.x = pk2(acc[0], acc[1]); o0.y = pk2(acc[2], acc[3]); o0.z = pk2(acc[4], acc[5]); o0.w = pk2(acc[6], acc[7]); o1.x = pk2(acc[8], acc[9]); o1.y = pk2(acc[10], acc[11]); o1.z = pk2(acc[12], acc[13]); o1.w = pk2(acc[14], acc[15]);
        *(u32x4*)dst = o0; *(u32x4*)(dst + 8) = o1;
        s += __shfl_xor(s, 1); s += __shfl_xor(s, 2); if (part == 0 && pass == 0) atomicAdd(C.ssq(SQ_MA + l) + row, s);
    }
}
template <bool SAMPLE> DI void attn_phase(const Ctx& C, int l, int pass = 0) {
    unsigned* sched = (unsigned*)(C.lds + LDS_BYTES - 64);
    for (;;) {
        __syncthreads();
        if (C.tid == 0) *sched = atomicAdd(C.ctr() + (SAMPLE ? 24 : 16) + l + 32 * pass, 1u);
        __syncthreads();
        const int u = (int)*sched;
        if (u >= (SAMPLE ? 32 : 512)) break;
        if (SAMPLE) attn_unit<true>(C, l, u, 0, pass); else attn_unit<false>(C, l, u & 7, 63 - (u >> 3), pass);
    }
}
DI void mla_finalize(const Ctx& C, int l) {
    const int gw = C.blk * NWAVE + C.wave, NGW = C.G * NWAVE; const float* sq = C.ssq(SQ_MA + l);
    for (int m = gw; m < T; m += NGW) { const float rn = rsqrtf(sq[m] * (1.f / 512.f) + EPS); u32x4* p = (u32x4*)(C.MIX() + (size_t)m * DM + 512 + C.lane * 8); const u32x4 u = *p;
        u32x4 o; o.x = pk2(bflo(u.x) * rn, bfhi(u.x) * rn); o.y = pk2(bflo(u.y) * rn, bfhi(u.y) * rn); o.z = pk2(bflo(u.z) * rn, bfhi(u.z) * rn); o.w = pk2(bflo(u.w) * rn, bfhi(u.w) * rn); *p = o; }
}
DI void sample_post(const Ctx& C, float* sq, unsigned* cnt) {
    const int gw = C.blk * NWAVE + C.wave, NGW = C.G * NWAVE; const float* PART = C.GT();
    for (int m = TP + gw; m < T; m += NGW) { float* x = C.out + O_X + (size_t)m * DM; float s = 0.f;
#pragma unroll
        for (int j = 0; j < 4; ++j) { f32x4 v = *(const f32x4*)(x + 256 * j + 4 * C.lane);
#pragma unroll
            for (int ks = 0; ks < 4; ++ks) v += *(const f32x4*)(PART + ((size_t)ks * 512 + (m - TP)) * 1024 + 256 * j + 4 * C.lane);
            *(f32x4*)(x + 256 * j + 4 * C.lane) = v;
            u32x2 w; w.x = pk2(v[0], v[1]); w.y = pk2(v[2], v[3]); *(u32x2*)(C.XB() + (size_t)m * DM + 256 * j + 4 * C.lane) = w;
            s += (v[0] * v[0] + v[1] * v[1]) + (v[2] * v[2] + v[3] * v[3]); }
        s = wave_sum(s); if (C.lane == 0) sq[m] = s; }
    if (TP + C.blk * NWAVE < T) { asm volatile("s_waitcnt vmcnt(0)" ::: "memory"); __syncthreads(); if (C.tid == 0) { __builtin_amdgcn_fence(__ATOMIC_RELEASE, "agent"); asm volatile("s_waitcnt vmcnt(0)" ::: "memory"); } }
    if (C.tid == 0) __hip_atomic_fetch_add(cnt, 1u, __ATOMIC_RELAXED, __HIP_MEMORY_SCOPE_AGENT);
}
DI void final_norm(const Ctx& C) {
    const int gw = C.blk * NWAVE + C.wave, NGW = C.G * NWAVE; const float* sq = C.ssq(SQ_XF); const float* g = C.in[I_FNG];
    for (int m = gw; m < T; m += NGW) { float* x = C.out + O_X + (size_t)m * DM; f32x4 v[4]; float s = 0.f;
#pragma unroll
        for (int j = 0; j < 4; ++j) { v[j] = *(f32x4*)(x + 256 * j + 4 * C.lane);
            if (m >= TP) { for (int ks = 0; ks < 4; ++ks) v[j] += *(const f32x4*)(C.GT() + ((size_t)ks * 512 + (m - TP)) * 1024 + 256 * j + 4 * C.lane); }
            s += (v[j][0] * v[j][0] + v[j][1] * v[j][1]) + (v[j][2] * v[j][2] + v[j][3] * v[j][3]); }
        s = wave_sum(s); const float rn = rsqrtf((m < TP ? sq[m] : s) * (1.f / 1024.f) + EPS);
#pragma unroll
        for (int j = 0; j < 4; ++j) { const f32x4 gg = *(const f32x4*)(g + 256 * j + 4 * C.lane); *(f32x4*)(x + 256 * j + 4 * C.lane) = v[j] * rn * gg; } }
}


#ifndef NAIVE_QKV
#define NAIVE_QKV 0
#endif
DI void naive_q(const Ctx& C, int l) {
    const bf16* P = C.PROJ(); const float* W = C.in[I_WUQ] + (size_t)l * 256 * 768; const float* g = C.in[I_QNG] + l * 256; const float* sq = C.ssq(SQ_QA + l);
    for (size_t i = (size_t)C.blk * NTHR + C.tid; i < (size_t)T * 768; i += (size_t)C.G * NTHR) { const int row = (int)(i / 768), n = (int)(i % 768); float a = 0.f;
        for (int k = 0; k < 256; ++k) a += bf2f(P[(size_t)row * INP + C_CQ + k]) * g[k] * W[(size_t)k * 768 + n];
        C.QF()[i] = f2bf(a * rsqrtf(sq[row] * (1.f / 256.f) + EPS) * QSCALE); }
}
DI void naive_kv(const Ctx& C, int l) {
    const bf16* P = C.PROJ(); const float* Wk = C.in[I_WUK] + (size_t)l * 128 * 512; const float* Wv = C.in[I_WUV] + (size_t)l * 128 * 512; const float* g = C.in[I_KVNG] + l * 128; const float* sq = C.ssq(SQ_KVA + l);
    for (size_t i = (size_t)C.blk * NTHR + C.tid; i < (size_t)TP * 1024; i += (size_t)C.G * NTHR) { const int row = (int)(i >> 10), n = (int)(i & 1023); const float* W = n < 512 ? Wk + n : Wv + (n - 512); float a = 0.f;
        for (int k = 0; k < 128; ++k) a += bf2f(P[(size_t)row * INP + C_CKV + k]) * g[k] * W[(size_t)k * 512];
        C.KVF()[i] = f2bf(a * rsqrtf(sq[row] * (1.f / 128.f) + EPS)); }
}

#ifndef NAIVE_S5
#define NAIVE_S5 0
#endif
#ifndef NAIVE_HG
#define NAIVE_HG 0
#endif
DI void naive_s5_scan(const Ctx& C, int l, float* TMP) {
    const int gw = C.blk * NWAVE + C.wave, NGW = C.G * NWAVE, lane = C.lane; const bf16* P = C.PROJ();
    for (int it = gw; it < 33 * 16; it += NGW) { const int sq = it >> 4, g = it & 15; const bool samp = sq > 0; const int b = sq - 1; const int row0 = samp ? TP + b * 16 : 0, n = samp ? 16 : TP;
        const int sidx = (l * 16 + g) * 64 + lane;
        const float dt = expf(C.in[I_LDT][l * 16 + g]), lr = C.in[I_LRE][sidx], li = C.in[I_LIM][sidx]; const float mag = expf(lr * dt); const float abr = mag * cosf(li * dt), abi = mag * sinf(li * dt);
        const float den = lr * lr + li * li, ir = lr / den, ii = -li / den; const float zr = (abr - 1.f) * ir - abi * ii, zi = (abr - 1.f) * ii + abi * ir;
        float bbr[16], bbi[16], cr[16], cim[16];
#pragma unroll
        for (int h = 0; h < 16; ++h) { const float br = C.in[I_BRE][(size_t)sidx * 16 + h], bi = C.in[I_BIM][(size_t)sidx * 16 + h]; bbr[h] = zr * br - zi * bi; bbi[h] = zr * bi + zi * br;
            cr[h] = C.in[I_CRE][((size_t)(l * 16 + g) * 16 + h) * 64 + lane]; cim[h] = C.in[I_CIM][((size_t)(l * 16 + g) * 16 + h) * 64 + lane]; }
        float hr = 0.f, hi = 0.f; if (samp) { hr = C.in[I_S5RE][((size_t)(l * 32 + b) * 16 + g) * 64 + lane]; hi = C.in[I_S5IM][((size_t)(l * 32 + b) * 16 + g) * 64 + lane]; }
        const float dch = lane < 16 ? C.in[I_S5D][l * 256 + g * 16 + lane] : 0.f;
        for (int t = 0; t < n; ++t) { const bf16* up = P + (size_t)(row0 + t) * INP + g * 16; float br = 0.f, bi = 0.f; float myu = 0.f;
#pragma unroll
            for (int h = 0; h < 16; ++h) { const float u = bf2f(up[h]); br += bbr[h] * u; bi += bbi[h] * u; if (h == lane) myu = u; }
            const float nr = abr * hr - abi * hi + br, ni = abr * hi + abi * hr + bi; hr = nr; hi = ni; float yk = 0.f;
#pragma unroll
            for (int h = 0; h < 16; ++h) { const float v = wave_sum(cr[h] * hr - cim[h] * hi); if (h == lane) yk = v; }
            if (lane < 16) { const float y = yk + dch * myu; const float a = 0.7978845608f * (y + 0.044715f * y * y * y); TMP[(size_t)(row0 + t) * 256 + g * 16 + lane] = 0.5f * y * (1.f + tanhf(a)); } }
        if (samp) { C.out[O_SRE + ((size_t)(l * 32 + b) * 16 + g) * 64 + lane] = hr; C.out[O_SIM + ((size_t)(l * 32 + b) * 16 + g) * 64 + lane] = hi; }
        else { C.out[O_PRE + ((size_t)l * 16 + g) * 64 + lane] = hr; C.out[O_PIM + ((size_t)l * 16 + g) * 64 + lane] = hi; } }
}
DI void naive_s5_glu(const Ctx& C, int l, const float* TMP) {
    float* zs = (float*)C.lds; float* red = zs + 256; const int tid = C.tid;
    for (int row = C.blk; row < T; row += C.G) { __syncthreads(); if (tid < 256) zs[tid] = TMP[(size_t)row * 256 + tid]; __syncthreads();
        float o = 0.f; if (tid < 256) { float a = C.in[I_BGLU][l * 256 + tid]; const float* W = C.in[I_WGLU] + (size_t)l * 65536 + tid; for (int k = 0; k < 256; ++k) a += zs[k] * W[(size_t)k * 256]; o = zs[tid] / (1.f + expf(-a)); }
        float s = wave_sum(o * o); if (C.lane == 0) red[C.wave] = s; __syncthreads(); const float tot = red[0] + red[1] + red[2] + red[3];
        if (tid < 256) C.MIX()[(size_t)row * DM + tid] = f2bf(o * rsqrtf(tot * (1.f / 256.f) + EPS)); }
}
DI void naive_hg_scan(const Ctx& C, int l, float* TMP) {
    const bf16* P = C.PROJ(); const float* LB = C.misc(M_LB) + l * 256;
    for (int it = C.blk * NTHR + C.tid; it < 33 * 256; it += C.G * NTHR) { const int sq = it >> 8, hd = (it >> 6) & 3, v = it & 63; const bool samp = sq > 0; const int b = sq - 1; const int row0 = samp ? TP + b * 16 : 0, n = samp ? 16 : TP;
        float S[64];
#pragma unroll
        for (int d = 0; d < 64; ++d) S[d] = samp ? C.in[I_SHG][((size_t)(l * 32 + b) * 4 + hd) * 4096 + d * 64 + v] : 0.f;
        for (int t = 0; t < n; ++t) { const bf16* pr = P + (size_t)(row0 + t) * INP; const float vv = bf2f(pr[C_HI + hd * 64 + v]); float o = 0.f;
#pragma unroll
            for (int d = 0; d < 64; ++d) { const float lb = LB[hd * 64 + d], fp = bf2f(pr[C_HF + hd * 64 + d]), hq = bf2f(pr[C_HQ + hd * 64 + d]); const float sg = 1.f / (1.f + expf(-fp));
                const float f = lb + (1.f - lb) * sg, k = (1.f - lb) * (1.f - sg), q = hq / (1.f + expf(-hq)); S[d] = f * S[d] + k * vv; o += q * S[d]; }
            TMP[(size_t)(row0 + t) * 256 + hd * 64 + v] = o; }
#pragma unroll
        for (int d = 0; d < 64; ++d) { if (samp) C.out[O_SHG + ((size_t)(l * 32 + b) * 4 + hd) * 4096 + d * 64 + v] = S[d]; else C.out[O_PHG + (size_t)l * 16384 + hd * 4096 + d * 64 + v] = S[d]; } }
}
DI void naive_hg_norm(const Ctx& C, int l, const float* TMP) {
    const int gw = C.blk * NWAVE + C.wave, NGW = C.G * NWAVE, lane = C.lane; const bf16* P = C.PROJ();
    for (int m = gw; m < T; m += NGW) { float o[4]; float s = 0.f;
#pragma unroll
        for (int j = 0; j < 4; ++j) { o[j] = TMP[(size_t)m * 256 + 64 * j + lane]; s += o[j] * o[j]; }
        s = wave_sum(s); const float rn = rsqrtf(s * (1.f / 256.f) + EPS);
#pragma unroll
        for (int j = 0; j < 4; ++j) { const float g = bf2f(P[(size_t)m * INP + C_HG + 64 * j + lane]); C.MIX()[(size_t)m * DM + 256 + 64 * j + lane] = f2bf(o[j] * rn * g / (1.f + expf(-g))); } }
}

#ifndef TIME_A
#define TIME_A 0
#endif
#ifndef TIME_B
#define TIME_B 0
#endif
#ifndef TIME_C
#define TIME_C 0
#endif
#ifndef TIME_ATTP
#define TIME_ATTP 0
#endif
#ifndef TIME_ATTS
#define TIME_ATTS 0
#endif
#ifndef NAIVE_ATTP
#define NAIVE_ATTP 0
#endif
#ifndef NAIVE_ATTS
#define NAIVE_ATTS 0
#endif
DI float wave_max(float v) {
#pragma unroll
    for (int o = 1; o < 64; o <<= 1) v = fmaxf(v, __shfl_xor(v, o));
    return v;
}
DI void naive_attn_prompt(const Ctx& C, int l) {
    const int gw = C.blk * NWAVE + C.wave, NGW = C.G * NWAVE, lane = C.lane; const bf16* QF = C.QF(); const bf16* KVF = C.KVF(); const bf16* KPE = C.KPEB();
    for (int it = gw; it < TP * 8; it += NGW) { const int row = it >> 3, hd = it & 7; float q[96];
#pragma unroll
        for (int d = 0; d < 96; ++d) q[d] = bf2f(QF[(size_t)row * 768 + hd * 96 + d]);
#pragma unroll
        for (int i = 0; i < 16; ++i) { const float c = C.misc(M_COS)[row * 16 + i], s = C.misc(M_SIN)[row * 16 + i]; const float x1 = q[64 + i], x2 = q[80 + i]; q[64 + i] = x1 * c - x2 * s; q[80 + i] = x2 * c + x1 * s; }
        const int nk = 64 * (row / 64 + 1); float m = -1e30f, ls = 0.f; float acc[64];
#pragma unroll
        for (int d = 0; d < 64; ++d) acc[d] = 0.f;
        for (int k = lane; k < nk; k += 64) { float sc = 0.f;
#pragma unroll
            for (int d = 0; d < 64; ++d) sc += q[d] * bf2f(KVF[(size_t)k * 1024 + hd * 64 + d]);
#pragma unroll
            for (int d = 0; d < 32; ++d) sc += q[64 + d] * bf2f(KPE[(size_t)k * 32 + d]);
            const float mn = fmaxf(m, sc), a = exp2f(m - mn), p = exp2f(sc - mn); m = mn; ls = ls * a + p;
#pragma unroll
            for (int d = 0; d < 64; ++d) acc[d] = acc[d] * a + p * bf2f(KVF[(size_t)k * 1024 + 512 + hd * 64 + d]); }
        const float M = wave_max(m), f = exp2f(m - M); const float L = wave_sum(ls * f); float mine = 0.f;
#pragma unroll
        for (int d = 0; d < 64; ++d) { const float v = wave_sum(acc[d] * f) / L; if (d == lane) mine = v; }
        C.MIX()[(size_t)row * DM + 512 + hd * 64 + lane] = f2bf(mine); const float s2 = wave_sum(mine * mine); if (lane == 0) atomicAdd(C.ssq(SQ_MA + l) + row, s2); }
}
DI void naive_attn_sample(const Ctx& C, int l) {
    const int gw = C.blk * NWAVE + C.wave, NGW = C.G * NWAVE, lane = C.lane; const bf16* QF = C.QF(); float* qs = (float*)C.lds + C.wave * 512; float* os = qs + 256;
    for (int it = gw; it < TS * 8; it += NGW) { const int bi = it >> 3, hh = it & 7, b = bi >> 4, i = bi & 15, row = TP + bi, pos = PAST + i;
        const bf16* qr = QF + (size_t)row * 768 + hh * 96;
        for (int c = lane; c < 128; c += 64) { float a = 0.f; const float* w = C.in[I_WUK] + (size_t)l * 65536 + (size_t)c * 512 + hh * 64; for (int d = 0; d < 64; ++d) a += bf2f(qr[d]) * w[d]; qs[c] = a; }
        if (lane < 16) { const float c = C.misc(M_COS)[pos * 16 + lane], s = C.misc(M_SIN)[pos * 16 + lane]; const float x1 = bf2f(qr[64 + lane]), x2 = bf2f(qr[80 + lane]); qs[128 + lane] = x1 * c - x2 * s; qs[144 + lane] = x2 * c + x1 * s; }
        __builtin_amdgcn_s_waitcnt(0); asm volatile("" ::: "memory");
        float m = -1e30f, ls = 0.f; float acc[128];
#pragma unroll
        for (int d = 0; d < 128; ++d) acc[d] = 0.f;
        for (int k = lane; k < PAST + 16; k += 64) { const float* kv = k < PAST ? C.in[I_CKV] + ((size_t)(l * 32 + b) * PAST + k) * 128 : C.out + O_SKV + ((size_t)l * TS + b * 16 + (k - PAST)) * 128;
            const float* pe = k < PAST ? C.in[I_CPE] + ((size_t)(l * 32 + b) * PAST + k) * 32 : C.out + O_SPE + ((size_t)l * TS + b * 16 + (k - PAST)) * 32; float sc = 0.f;
            for (int d = 0; d < 128; ++d) sc += qs[d] * kv[d];
            for (int d = 0; d < 32; ++d) sc += qs[128 + d] * pe[d];
            const float mn = fmaxf(m, sc), a = exp2f(m - mn), p = exp2f(sc - mn); m = mn; ls = ls * a + p;
#pragma unroll
            for (int d = 0; d < 128; ++d) acc[d] = acc[d] * a + p * kv[d]; }
        const float M = wave_max(m), f = exp2f(m - M); const float L = wave_sum(ls * f);
#pragma unroll
        for (int d = 0; d < 128; ++d) { const float v = wave_sum(acc[d] * f) / L; if ((d & 63) == lane) os[d] = v; }
        __builtin_amdgcn_s_waitcnt(0); asm volatile("" ::: "memory");
        float o = 0.f; const float* wv = C.in[I_WUV] + (size_t)l * 65536 + hh * 64 + lane; for (int c = 0; c < 128; ++c) o += os[c] * wv[(size_t)c * 512];
        C.MIX()[(size_t)row * DM + 512 + hh * 64 + lane] = f2bf(o); const float s2 = wave_sum(o * o); if (lane == 0) atomicAdd(C.ssq(SQ_MA + l) + row, s2);
        __builtin_amdgcn_s_waitcnt(0); asm volatile("" ::: "memory"); }
}
#define XB_TMO      128
#define XB_XCNT(j)  (256  + 64 * (j))
#define XB_XSUB(j)  (1280 + 64 * (j))
#define XB_XGEN(j)  (2304 + 64 * (j))
#define XB_TOP      3328
#define XB_TOPGEN   3392
#define XCD_BAR_WORDS 3456
#define XB_SPIN_CAP (1u << 18)

__device__ __forceinline__ unsigned xb_ld(unsigned* p)              { return __hip_atomic_load(p, __ATOMIC_RELAXED, __HIP_MEMORY_SCOPE_AGENT); }
__device__ __forceinline__ unsigned xb_add(unsigned* p, unsigned v) { return __hip_atomic_fetch_add(p, v, __ATOMIC_RELAXED, __HIP_MEMORY_SCOPE_AGENT); }
__device__ __forceinline__ unsigned xb_xcc_id() { return (unsigned)__builtin_amdgcn_s_getreg((3 << 11) | 20) & 0xFu; }
#define XB_SPIN(cond, bar) do { unsigned _sp = 0; while (cond) { __builtin_amdgcn_s_sleep(1); \
    if ((++_sp & 255u) == 0u) { if (xb_ld(&(bar)[XB_TMO])) break; if (_sp > XB_SPIN_CAP) { atomicAdd(&(bar)[XB_TMO], 1u); break; } } } } while (0)

struct XcdBarrier {
    unsigned* bar; unsigned x;
    volatile LAS unsigned* st;
};

__device__ __forceinline__ XcdBarrier xcd_barrier_post(unsigned* bar, volatile LAS unsigned* st) {
    XcdBarrier b; b.bar = bar; b.x = xb_xcc_id(); b.st = st;
    if (threadIdx.x == 0) (void)xb_add(&bar[XB_XCNT(b.x)], 1u);
    return b;
}
__device__ __forceinline__ void xcd_barrier_complete(unsigned* bar, unsigned x, unsigned& nloc, unsigned& nx) {
    const unsigned G = gridDim.x * gridDim.y * gridDim.z;
    unsigned sum, cnt, mine, sp = 0u;
    for (;;) {
        sum = 0u; cnt = 0u; mine = 0u;
#pragma unroll
        for (unsigned j = 0; j < 16; ++j) { const unsigned c = xb_ld(&bar[XB_XCNT(j)]); sum += c; cnt += (c > 0u) ? 1u : 0u; mine = (j == x) ? c : mine; }
        if (sum == G) break;
        __builtin_amdgcn_s_sleep(1);
        if ((++sp & 255u) == 0u) { if (xb_ld(&bar[XB_TMO])) break; if (sp > XB_SPIN_CAP) { atomicAdd(&bar[XB_TMO], 1u); break; } }
    }
    nloc = mine > 0u ? mine : 1u; nx = cnt > 0u ? cnt : 1u;
}

__device__ __forceinline__ void xcd_barrier(const XcdBarrier& b) {
    asm volatile("s_waitcnt vmcnt(0)" ::: "memory");
    __syncthreads();
    if (threadIdx.x == 0) {
        unsigned* bar = b.bar;
        __builtin_amdgcn_s_waitcnt(0);
        unsigned nloc = b.st[0], nx = b.st[1];
        if (nloc == 0u) { xcd_barrier_complete(bar, b.x, nloc, nx); b.st[0] = nloc; b.st[1] = nx; }
        const unsigned old = xb_add(&bar[XB_XSUB(b.x)], 1u);
        const unsigned gen = old / nloc;
        if (old + 1u == (gen + 1u) * nloc) {
            __builtin_amdgcn_fence(__ATOMIC_RELEASE, "agent");
            asm volatile("s_waitcnt vmcnt(0)" ::: "memory");
            const unsigned og = xb_add(&bar[XB_TOP], 1u);
            const unsigned tg = og / nx;
            if (og + 1u == (tg + 1u) * nx) xb_add(&bar[XB_TOPGEN], 1u);
            else XB_SPIN(xb_ld(&bar[XB_TOPGEN]) == tg, bar);
            __builtin_amdgcn_fence(__ATOMIC_ACQUIRE, "agent");
            xb_add(&bar[XB_XGEN(b.x)], 1u);
            asm volatile("s_waitcnt vmcnt(0)" ::: "memory");
        } else {
            XB_SPIN(xb_ld(&bar[XB_XGEN(b.x)]) == gen, bar);
            __builtin_amdgcn_fence(__ATOMIC_ACQUIRE, "agent");
            asm volatile("s_waitcnt vmcnt(0)" ::: "memory");
        }
    }
    __syncthreads();
}

template <int K> DI void run_kind(const Ctx& C0, int l0, LAS unsigned char* ldsg) {
    unsigned zz; asm volatile("s_mov_b32 %0, 0" : "=s"(zz)); Ctx C = C0; C.ws = C0.ws + zz; C.out = C0.out + zz; C.in = C0.in + zz; const int l = l0 + (int)zz;
    { int t_ = C0.tid; asm volatile("" : "+v"(t_)); C.tid = t_; C.lane = t_ & 63; C.wave = __builtin_amdgcn_readfirstlane(t_ >> 6); }
    if constexpr (K == 0) p0_prologue(C);
    else if constexpr (K == 1) { unsigned* cnt = C.ctr() + 128 + 64 * l; if (l > 0) sample_post(C, C.ssq(SQ_X0 + l), cnt);
        pg8::Gemm g{C.XB(), C.wgt(l, W_IN), T, INP, DM, DM, DM}; pg8::WaitOrder S; S.init(T, INP, C.G, C.blk); S.cnt = cnt; S.need = l > 0 ? (unsigned)C.G : 0u;
        pg8::EpiG1 E{C.PROJ(), C.ssq(SQ_X0 + l), C.ssq(SQ_QA + l), C.ssq(SQ_KVA + l)}; pg8::gemm_phase<pg8::EpiG1, pg8::WaitOrder, true, true>(ldsg, g, S, E); }
    else if constexpr (K == 2 && NAIVE_QKV) naive_q(C, l);
    else if constexpr (K == 3 && NAIVE_QKV) naive_kv(C, l);
    else if constexpr (K == 2) { pg8::Gemm g{C.PROJ() + C_CQ, C.wgt(l, W_UQ), T, 768, 256, INP, 256}; pg8::StaticOrder S; S.init(T, 768, C.G, C.blk);
        pg8::EpiQ E{C.QF(), C.ssq(SQ_QA + l)}; pg8::gemm_phase<pg8::EpiQ, pg8::StaticOrder, true, true>(ldsg, g, S, E); }
    else if constexpr (K == 3) { pg8::Gemm g{C.PROJ() + C_CKV, C.wgt(l, W_KV), TP, 1024, 128, INP, 128}; pg8::StaticOrder S; S.init(TP, 1024, C.G, C.blk);
        pg8::EpiScaleStore E{C.KVF(), 1024, C.ssq(SQ_KVA + l), 1.f / 128.f}; pg8::gemm_phase<pg8::EpiScaleStore, pg8::StaticOrder, true, true>(ldsg, g, S, E); }
    else if constexpr (K == 4) { __syncthreads(); misc_rows(C, l);
        if (TIME_B) misc_rows(C, l);
        if (!NAIVE_S5) for (int rep = 0; rep < 1 + TIME_B; ++rep) for (int ci = C.blk; ci < 256; ci += C.G) s5_item<false>(C, l, ci);
        __syncthreads();
        if (!NAIVE_HG) for (int bi = C.G - 1 - C.blk; bi < 144; bi += C.G) hgrn_local(C, l, bi * 8 + C.wave); }
    else if constexpr (K == 5) { if (NAIVE_HG) naive_hg_scan(C, l, C.GT()); else hgrn_prefix(C, l);
        if (NAIVE_S5) naive_s5_scan(C, l, (float*)C.XB()); else for (int rep = 0; rep < 1 + TIME_B; ++rep) for (int ci = C.blk; ci < 288; ci += C.G) s5_item<true>(C, l, ci); }
    else if constexpr (K == 6) { if (NAIVE_ATTS) naive_attn_sample(C, l); else { attn_phase<true>(C, l); if (TIME_ATTS) attn_phase<true>(C, l, 1); } }
    else if constexpr (K == 7) { if (NAIVE_ATTP) naive_attn_prompt(C, l); else { attn_phase<false>(C, l); if (TIME_ATTP) attn_phase<false>(C, l, 1); } }
    else if constexpr (K == 8) { if (NAIVE_HG) naive_hg_norm(C, l, C.GT()); else for (int rep = 0; rep < 1 + TIME_B; ++rep) for (int bi = C.blk; bi < 144; bi += C.G) hgrn_final(C, l, bi);
        if (NAIVE_S5) naive_s5_glu(C, l, (const float*)C.XB());
        mla_finalize(C, l); }
    else if constexpr (K == 9) { { pg8::Gemm g{C.MIX(), C.wgt(l, W_OUT), TP, DM, DM, DM, DM}; pg8::StaticOrder S; S.init(TP, DM, C.G, C.blk);
          pg8::EpiRes E{C.out + O_X, C.XB(), C.ssq(SQ_2A + l)}; pg8::gemm_phase<pg8::EpiRes, pg8::StaticOrder, true, true>(ldsg, g, S, E); }
        { pg8::Gemm g{C.MIX(), C.wgt(l, W_OUT), T, DM, 256, DM, DM}; pg8::SplitOrder S{C.G, C.blk, 256}; pg8::EpiPartial E{C.GT(), 256}; pg8::gemm_phase<pg8::EpiPartial, pg8::SplitOrder, true, true>(ldsg, g, S, E); } }
    else if constexpr (K == 10) { unsigned* cnt = C.ctr() + 256 + 64 * l; sample_post(C, C.ssq(SQ_2A + l), cnt);
        pg8::Gemm g{C.XB(), C.wgt(l, W_UP), T, DFF, DM, DM, DM}; pg8::WaitOrder S; S.init(T, DFF, C.G, C.blk); S.cnt = cnt; S.need = (unsigned)C.G;
        pg8::EpiUp E{C.HID(), C.ssq(SQ_2A + l)}; pg8::gemm_phase<pg8::EpiUp, pg8::WaitOrder, true, true>(ldsg, g, S, E); }
    else if constexpr (K == 11) { { pg8::Gemm g{C.HID(), C.wgt(l, W_DN), TP, DM, DFF, DFF, DFF}; pg8::StaticOrder S; S.init(TP, DM, C.G, C.blk);
          pg8::EpiRes E{C.out + O_X, C.XB(), C.ssq(SQ_X1 + l)}; pg8::gemm_phase<pg8::EpiRes, pg8::StaticOrder, true, true>(ldsg, g, S, E); }
        { pg8::Gemm g{C.HID(), C.wgt(l, W_DN), T, DM, 1024, DFF, DFF}; pg8::SplitOrder S{C.G, C.blk, 1024}; pg8::EpiPartial E{C.GT(), 1024}; pg8::gemm_phase<pg8::EpiPartial, pg8::SplitOrder, true, true>(ldsg, g, S, E); } }
    else final_norm(C);
}
DI Ctx make_ctx(const Args& args, unsigned char* lds_raw) {
    Ctx C; C.in = args.in; C.out = args.out; C.ws = args.ws; C.lds = (char*)lds_raw; C.tid = threadIdx.x; C.lane = C.tid & 63; C.wave = __builtin_amdgcn_readfirstlane(C.tid >> 6); C.G = gridDim.x; C.blk = blockIdx.x; return C;
}
template <int K> __global__ void __launch_bounds__(NTHR, 2) phase_kernel(Args args, int l) {
    extern __shared__ __attribute__((aligned(16))) unsigned char lds_raw[];
    const Ctx C = make_ctx(args, lds_raw);
    run_kind<K>(C, l, (LAS unsigned char*)lds_raw);
}
#ifndef MK_MEGA
#define MK_MEGA 1
#endif
#if MK_MEGA
__global__ void __launch_bounds__(NTHR, 2) trunk_fwd(Args args) {
    extern __shared__ __attribute__((aligned(16))) unsigned char lds_raw[];
    cg::grid_group grid = cg::this_grid();
    const Ctx C = make_ctx(args, lds_raw); LAS unsigned char* ldsg = (LAS unsigned char*)lds_raw;
    volatile LAS unsigned* xst = (volatile LAS unsigned*)((LAS unsigned char*)lds_raw + LDS_BYTES - 32);
    if (threadIdx.x < 2) xst[threadIdx.x] = 0u;
    __syncthreads();
    grid.sync();
    const XcdBarrier xbar = xcd_barrier_post((unsigned*)(C.ctr() + 1024), xst);
#define GSYNC() xcd_barrier(xbar)
#ifndef KMASK
#define KMASK 0x1fff
#endif
#define RK(k, l) do { if ((KMASK >> (k)) & 1) { run_kind<k>(C, l, ldsg); if ((TIME_A && (k == 0)) || (TIME_B && (k == 2 || k == 3)) || (TIME_C && (k == 10))) { __syncthreads(); run_kind<k>(C, l, ldsg); } } } while (0)
    RK(0, 0); GSYNC();
#define LAYER(l) do { RK(1, l); GSYNC(); RK(2, l); RK(3, l); RK(4, l); GSYNC(); RK(5, l); RK(6, l); RK(7, l); GSYNC(); RK(8, l); GSYNC(); RK(9, l); GSYNC(); RK(10, l); GSYNC(); RK(11, l); GSYNC(); } while (0)
    LAYER(0);
    LAYER(1);
    RK(12, 0);
}
#endif

template <int K> static void launch_kind(const Args& a, int l, int grid, hipStream_t stream) {
    static bool attr_set = false;
    if (!attr_set) { (void)hipFuncSetAttribute((const void*)phase_kernel<K>, hipFuncAttributeMaxDynamicSharedMemorySize, LDS_BYTES); attr_set = true; }
    hipLaunchKernelGGL(phase_kernel<K>, dim3(grid), dim3(NTHR), LDS_BYTES, stream, a, l);
}
extern "C" void kernel_launch(void* const* d_in, const int* in_sizes, int n_in, void* d_out, int out_size, void* d_ws, size_t ws_size, hipStream_t stream) {
    static int grid = 0;
    if (grid == 0) {
        int dev = 0, cus = 0;
        if (n_in != 31 || ws_size < WS_END) { fprintf(stderr, "kernel_launch: unexpected inputs (n_in %d, ws %zu < %zu)\n", n_in, ws_size, (size_t)WS_END); grid = -1; return; }
        (void)hipGetDevice(&dev); (void)hipDeviceGetAttribute(&cus, hipDeviceAttributeMultiprocessorCount, dev);
#if MK_MEGA
        int per_cu = 0;
        (void)hipFuncSetAttribute((const void*)trunk_fwd, hipFuncAttributeMaxDynamicSharedMemorySize, LDS_BYTES);
        (void)hipOccupancyMaxActiveBlocksPerMultiprocessor(&per_cu, (const void*)trunk_fwd, NTHR, LDS_BYTES);
        (void)hipGetLastError();
        if (per_cu < 1) fprintf(stderr, "kernel_launch: occupancy query says %d blocks per CU\n", per_cu);
#endif
        grid = cus > 0 ? cus : 256;
    }
    if (grid < 0) return;
    (void)hipMemsetAsync((char*)d_ws + WS_ZERO, 0, ZERO_BYTES, stream);
    Args a{};
    for (int i = 0; i < 31; ++i) a.in[i] = (const float*)d_in[i];
    a.out = (float*)d_out; a.ws = (unsigned char*)d_ws;
#if MK_MEGA
    void* kargs[] = {&a};
    hipError_t e = hipLaunchCooperativeKernel((const void*)trunk_fwd, dim3(grid), dim3(NTHR), kargs, LDS_BYTES, stream);
    if (e != hipSuccess) fprintf(stderr, "cooperative launch failed: %s (grid %d)\n", hipGetErrorString(e), grid);
#else
    launch_kind<0>(a, 0, grid, stream);
    for (int l = 0; l < 2; ++l) {
        launch_kind<1>(a, l, grid, stream); launch_kind<2>(a, l, grid, stream); launch_kind<3>(a, l, grid, stream); launch_kind<4>(a, l, grid, stream);
        launch_kind<5>(a, l, grid, stream); launch_kind<6>(a, l, grid, stream); launch_kind<7>(a, l, grid, stream); launch_kind<8>(a, l, grid, stream);
        launch_kind<9>(a, l, grid, stream); launch_kind<10>(a, l, grid, stream); launch_kind<11>(a, l, grid, stream);
    }
    launch_kind<12>(a, 0, grid, stream);
#endif
}
```

```cpp
#include <hip/hip_runtime.h>
#include <hip/hip_cooperative_groups.h>
#include <cstdio>
#include <cstdint>
namespace cg = cooperative_groups;
namespace pg8 {
#define PG8_LAS __attribute__((address_space(3)))
typedef unsigned short bf16_t;
typedef short bf16x8 __attribute__((ext_vector_type(8)));
typedef float f32x4 __attribute__((ext_vector_type(4)));
typedef unsigned u32x4 __attribute__((ext_vector_type(4)));
constexpr int BM = 256, BK = 64, HALF = 128, HTB = HALF * BK * 2  , STAGE_BYTES = 8 * HTB, NXCD = 8, WGM = 8;

__host__ __device__ __forceinline__ int lds_byte(int r, int c) { const int st = (r >> 4) * 2 + (c >> 5), rr = r & 15, cc = c & 31, ob = rr * 64 + cc * 2; return st * 1024 + (ob ^ (((ob >> 9) & 1) << 5)); }
__host__ __device__ __forceinline__ void stage_rc(int b, int& R, int& C) { const int st = b / 1024, sb = b % 1024, swz = sb ^ (((sb >> 9) & 1) << 5); R = (st >> 1) * 16 + swz / 64; C = (st & 1) * 32 + (swz % 64) / 2; }
__host__ __device__ __forceinline__ int perm32(int rho) { const int n = rho >> 4, i = rho & 15; return 8 * (i >> 2) + 4 * n + (i & 3); }

struct Unit { int pm, pn, ko; };
struct Gemm { const bf16_t* A; const bf16_t* Bt; int M, N, K, lda, ldb; };

struct StaticOrder {
    int nM, nN, nwg, G, c;
    __host__ __device__ void init(int M, int N, int G_, int c_) { nM = M / BM; nN = N / BM; nwg = nM * nN; G = G_; c = c_; }
    __host__ __device__ bool next(int i, Unit& u) const {
        const long L = (long)i * G + c; if (L >= nwg) return false;
        int wgid = (int)L; { const int q = nwg / NXCD, r = nwg % NXCD, xcd = wgid % NXCD, off = wgid / NXCD; wgid = (xcd < r ? xcd * (q + 1) : r * (q + 1) + (xcd - r) * q) + off; }
        const int nig = WGM * nN, gid = wgid / nig, fm = gid * WGM, gsz = (nM - fm) < WGM ? (nM - fm) : WGM;
        u.pm = fm + ((wgid % nig) % gsz); u.pn = (wgid % nig) / gsz; u.ko = 0; return true;
    }
    __device__ __forceinline__ void a_ready(const Unit&) const {}
    __device__ __forceinline__ void done(const Unit&) const {}
};

struct WaitOrder : StaticOrder {
    unsigned* cnt; unsigned need;
    __device__ __forceinline__ void a_ready(const Unit& u) const {
        if (u.pm >= 64 && need) { while (__hip_atomic_load(cnt, __ATOMIC_RELAXED, __HIP_MEMORY_SCOPE_AGENT) < need) __builtin_amdgcn_s_sleep(2); __builtin_amdgcn_fence(__ATOMIC_ACQUIRE, "agent"); }
    }
};
struct SplitOrder {
    int G, c, kq, nsub;
    __device__ __forceinline__ bool next(int i, Unit& u) const { const int L = i * G + c; if (L >= nsub) return false; u.pm = 64 + (L & 1); u.pn = (L >> 1) & 3; u.ko = (L >> 3) * kq; return true; }
    __device__ __forceinline__ void a_ready(const Unit&) const {}
    __device__ __forceinline__ void done(const Unit&) const {}
};

__device__ __forceinline__ unsigned cvt_pk_bf16(float lo, float hi) { unsigned r; asm volatile("v_cvt_pk_bf16_f32 %0, %1, %2" : "=v"(r) : "v"(lo), "v"(hi)); return r; }
typedef float f32x2 __attribute__((ext_vector_type(2)));
__device__ __forceinline__ f32x2 gelu_pk(f32x2 v) {
    const f32x2 av = __builtin_elementwise_abs(v), d = av * 0.2316418882f + 1.0f;
    f32x2 t; t.x = __builtin_amdgcn_rcpf(d.x); t.y = __builtin_amdgcn_rcpf(d.y);
    f32x2 q = t * 0.5307027145f + (-0.7265760135f); q = q * t + 0.7107068705f; q = q * t + (-0.142248368f); q = q * t + 0.127414796f; q = q * t;
    const f32x2 s = (v * v) * (-0.72134752044f);
    f32x2 e; e.x = __builtin_amdgcn_exp2f(s.x); e.y = __builtin_amdgcn_exp2f(s.y);
    const f32x2 m = v * (q * e), r = v - m;
    f32x2 o; o.x = v.x < 0.f ? m.x : r.x; o.y = v.y < 0.f ? m.y : r.y; return o;
}

template <class Epi, class Sched, bool ALIGN_EPI = false, bool SP2 = false>
__device__ __forceinline__ void gemm_phase(PG8_LAS unsigned char* lds, const Gemm g, const Sched& S, const Epi& E) {
    int tid_ = threadIdx.x; asm volatile("" : "+v"(tid_)); const int tid = tid_, wid = __builtin_amdgcn_readfirstlane(tid >> 6), lane = tid & 63, wr = wid >> 2, wc = wid & 3, fr = lane & 15, fq = lane >> 4;
    const int K = g.K, nt = K / BK;
    unsigned voffA[2], voffB[2];
#pragma unroll
    for (int i = 0; i < 2; ++i) { int R, C; stage_rc(tid * 16 + i * 8192, R, C); const int Rb = Epi::PERM ? ((R & ~31) + perm32(R & 31)) : R;
        voffA[i] = (unsigned)(R * g.lda + C) * 2u; voffB[i] = (unsigned)(Rb * g.ldb + C) * 2u; }
    const size_t kstep = (size_t)(BK * 2);
    const size_t hstepA = (size_t)HALF * g.lda * 2, hstepB = (size_t)HALF * g.ldb * 2;
    const size_t tstepA = 2 * hstepA, tstepB = 2 * hstepB;
    const unsigned ldsw = (unsigned)wid * 1024u;
    const int aoff = lds_byte(wr * 64 + fr, fq * 8), boff = lds_byte(wc * 32 + fr, fq * 8);
#define PG8_SA(b, h) (((b) * 2 + (h)) * HTB)
#define PG8_SB(b, h) ((4 + (b) * 2 + (h)) * HTB)
#define PG8_STAGE(bufoff, gbase, voff) do { _Pragma("unroll") for (int _i = 0; _i < 2; ++_i) \
        __builtin_amdgcn_global_load_lds((const unsigned*)((const char*)(gbase) + (voff)[_i]), (PG8_LAS unsigned*)(lds + (bufoff) + ldsw + _i * 8192), 16, 0, 0); } while (0)
#define PG8_LDA(dst, b, h) do { _Pragma("unroll") for (int m = 0; m < 4; ++m) _Pragma("unroll") for (int k = 0; k < 2; ++k) dst[m][k] = *(const PG8_LAS bf16x8*)(lds + PG8_SA(b, h) + aoff + m * 2048 + k * 1024); } while (0)
#define PG8_LDB(dst, b, h) do { _Pragma("unroll") for (int n = 0; n < 2; ++n) _Pragma("unroll") for (int k = 0; k < 2; ++k) dst[n][k] = *(const PG8_LAS bf16x8*)(lds + PG8_SB(b, h) + boff + n * 2048 + k * 1024); } while (0)
#define PG8_MMA(ai, bj, At, Bt) do { __builtin_amdgcn_s_setprio(1); _Pragma("unroll") for (int m = 0; m < 4; ++m) _Pragma("unroll") for (int n = 0; n < 2; ++n) _Pragma("unroll") for (int k = 0; k < 2; ++k) \
        acc[ai][bj][m][n] = __builtin_amdgcn_mfma_f32_16x16x32_bf16(Bt[n][k], At[m][k], acc[ai][bj][m][n], 0, 0, 0); __builtin_amdgcn_s_setprio(0); } while (0)
#define PG8_WAIT_V(n) asm volatile("s_waitcnt vmcnt(" #n ")" ::: "memory")
#define PG8_WAIT_L(n) asm volatile("s_waitcnt lgkmcnt(" #n ")" ::: "memory")
#define PG8_BAR __builtin_amdgcn_s_barrier()
#define PG8_SCHED __builtin_amdgcn_sched_barrier(0)
    Unit cur, nxt; int ui = 0;
    if (!S.next(0, cur)) return;
    f32x4 acc[2][2][4][2];
#pragma unroll
    for (int a = 0; a < 2; ++a)
#pragma unroll
        for (int b = 0; b < 2; ++b)
#pragma unroll
            for (int m = 0; m < 4; ++m)
#pragma unroll
                for (int n = 0; n < 2; ++n) acc[a][b][m][n] = (f32x4){0.f, 0.f, 0.f, 0.f};
    bf16x8 At[4][2], B0[2][2], B1[2][2];
    const char* cA = (const char*)g.A + (size_t)cur.pm * tstepA + (size_t)cur.ko * 2; const char* cB = (const char*)g.Bt + (size_t)cur.pn * tstepB + (size_t)cur.ko * 2;
    S.a_ready(cur);
    if constexpr (SP2) {
        PG8_STAGE(PG8_SB(0, 0), cB, voffB); PG8_STAGE(PG8_SB(0, 1), cB + hstepB, voffB); PG8_STAGE(PG8_SA(0, 0), cA, voffA); PG8_STAGE(PG8_SA(0, 1), cA + hstepA, voffA);
        if (wr == 1) PG8_BAR;
        PG8_WAIT_V(2); PG8_BAR;
        PG8_STAGE(PG8_SB(1, 0), cB + kstep, voffB); PG8_STAGE(PG8_SA(1, 0), cA + kstep, voffA); PG8_STAGE(PG8_SB(1, 1), cB + hstepB + kstep, voffB);
        PG8_WAIT_V(6); PG8_BAR;
    } else {
        PG8_STAGE(PG8_SB(0, 0), cB, voffB); PG8_STAGE(PG8_SA(0, 0), cA, voffA); PG8_STAGE(PG8_SB(0, 1), cB + hstepB, voffB); PG8_STAGE(PG8_SA(0, 1), cA + hstepA, voffA);
        if (wr == 1) PG8_BAR;
        PG8_WAIT_V(4); PG8_BAR;
        PG8_STAGE(PG8_SB(1, 0), cB + kstep, voffB); PG8_STAGE(PG8_SA(1, 0), cA + kstep, voffA); PG8_STAGE(PG8_SB(1, 1), cB + hstepB + kstep, voffB);
        PG8_WAIT_V(6); PG8_BAR;
    }
    for (;;) {
        const bool has_next = S.next(ui + 1, nxt);
        const char* nA = has_next ? (const char*)g.A + (size_t)nxt.pm * tstepA + (size_t)nxt.ko * 2 : cA; const char* nB = has_next ? (const char*)g.Bt + (size_t)nxt.pn * tstepB + (size_t)nxt.ko * 2 : cB;
        for (int t = 0; t < nt; t += 2) {
            const bool last = (t == nt - 2);
            const char* a1 = cA + (size_t)(t + 1) * kstep;
            const char* a2 = last ? nA : cA + (size_t)(t + 2) * kstep; const char* b2 = last ? nB : cB + (size_t)(t + 2) * kstep;
            const char* a3 = a2 + kstep; const char* b3 = b2 + kstep;
            if (last && has_next) S.a_ready(nxt);
            if constexpr (SP2) {
            PG8_LDB(B0, 0, 0); PG8_LDB(B1, 0, 1); PG8_SCHED; PG8_LDA(At, 0, 0); PG8_STAGE(PG8_SA(1, 1), a1 + hstepA, voffA);
            PG8_WAIT_V(8); PG8_WAIT_L(0); PG8_BAR; PG8_MMA(0, 0, At, B0); PG8_MMA(0, 1, At, B1); PG8_BAR; PG8_SCHED;
            PG8_LDA(At, 0, 1); PG8_STAGE(PG8_SB(0, 0), b2, voffB); PG8_STAGE(PG8_SB(0, 1), b2 + hstepB, voffB); PG8_STAGE(PG8_SA(0, 0), a2, voffA);
            PG8_WAIT_V(8); PG8_WAIT_L(0); PG8_BAR; PG8_MMA(1, 0, At, B0); PG8_MMA(1, 1, At, B1); PG8_BAR; PG8_SCHED;
            PG8_LDB(B0, 1, 0); PG8_LDB(B1, 1, 1); PG8_SCHED; PG8_LDA(At, 1, 0); PG8_STAGE(PG8_SA(0, 1), a2 + hstepA, voffA);
            PG8_WAIT_V(8); PG8_WAIT_L(0); PG8_BAR; PG8_MMA(0, 0, At, B0); PG8_MMA(0, 1, At, B1); PG8_BAR; PG8_SCHED;
            PG8_LDA(At, 1, 1); PG8_STAGE(PG8_SB(1, 0), b3, voffB); PG8_STAGE(PG8_SB(1, 1), b3 + hstepB, voffB); PG8_STAGE(PG8_SA(1, 0), a3, voffA);
            PG8_WAIT_V(8); PG8_WAIT_L(0); PG8_BAR; PG8_MMA(1, 0, At, B0); PG8_MMA(1, 1, At, B1); PG8_BAR; PG8_SCHED;
            } else {
            PG8_LDB(B0, 0, 0); PG8_SCHED; PG8_LDA(At, 0, 0); PG8_STAGE(PG8_SA(1, 1), a1 + hstepA, voffA);
            PG8_WAIT_L(8); PG8_BAR; PG8_WAIT_L(0); PG8_MMA(0, 0, At, B0); PG8_BAR; PG8_SCHED;
            PG8_LDB(B1, 0, 1); PG8_STAGE(PG8_SB(0, 0), b2, voffB);
            PG8_BAR; PG8_WAIT_L(0); PG8_MMA(0, 1, At, B1); PG8_BAR;
            PG8_LDA(At, 0, 1); PG8_STAGE(PG8_SA(0, 0), a2, voffA);
            PG8_BAR; PG8_WAIT_L(0); PG8_MMA(1, 0, At, B0); PG8_BAR; PG8_SCHED;
            PG8_STAGE(PG8_SB(0, 1), b2 + hstepB, voffB);
            PG8_WAIT_V(6); PG8_BAR; PG8_MMA(1, 1, At, B1); PG8_BAR;
            PG8_LDB(B0, 1, 0); PG8_SCHED; PG8_LDA(At, 1, 0); PG8_STAGE(PG8_SA(0, 1), a2 + hstepA, voffA);
            PG8_WAIT_L(8); PG8_BAR; PG8_WAIT_L(0); PG8_MMA(0, 0, At, B0); PG8_BAR; PG8_SCHED;
            PG8_LDB(B1, 1, 1); PG8_STAGE(PG8_SB(1, 0), b3, voffB);
            PG8_BAR; PG8_WAIT_L(0); PG8_MMA(0, 1, At, B1); PG8_BAR;
            PG8_LDA(At, 1, 1); PG8_STAGE(PG8_SA(1, 0), a3, voffA);
            PG8_BAR; PG8_WAIT_L(0); PG8_MMA(1, 0, At, B0); PG8_BAR; PG8_SCHED;
            PG8_STAGE(PG8_SB(1, 1), b3 + hstepB, voffB);
            PG8_WAIT_V(6); PG8_BAR; PG8_MMA(1, 1, At, B1); PG8_BAR;
            }
        }
        if constexpr (ALIGN_EPI) { if (wr == 0) PG8_BAR; }
        if constexpr (!Epi::AFTER_DRAIN) { E(acc, cur, wr, wc, fr, fq); S.done(cur); }
        if (!has_next) break;
#pragma unroll
        for (int a = 0; a < 2; ++a)
#pragma unroll
            for (int b = 0; b < 2; ++b)
#pragma unroll
                for (int m = 0; m < 4; ++m)
#pragma unroll
                    for (int n = 0; n < 2; ++n) acc[a][b][m][n] = (f32x4){0.f, 0.f, 0.f, 0.f};
        cur = nxt; cA = nA; cB = nB; ++ui;
        if constexpr (ALIGN_EPI) { if (wr == 1) PG8_BAR; }
    }
    PG8_WAIT_V(0);
    if constexpr (!ALIGN_EPI) { if (wr == 0) PG8_BAR; }
    PG8_BAR;
    if constexpr (Epi::AFTER_DRAIN) { E.fused(acc, cur, wr, wc, fr, fq, lds, wid, lane); S.done(cur); }
#undef PG8_SA
#undef PG8_SB
#undef PG8_STAGE
#undef PG8_LDA
#undef PG8_LDB
#undef PG8_MMA
#undef PG8_WAIT_V
#undef PG8_WAIT_L
#undef PG8_BAR
#undef PG8_SCHED
}
}

#define DI __device__ __forceinline__
#define LAS __attribute__((address_space(3)))
typedef unsigned short bf16;
typedef short bf16x8 __attribute__((ext_vector_type(8)));
typedef short s16x4 __attribute__((ext_vector_type(4)));
typedef float f32x4 __attribute__((ext_vector_type(4)));
typedef float f32x16 __attribute__((ext_vector_type(16)));
typedef unsigned u32x4 __attribute__((ext_vector_type(4)));
typedef unsigned u32x2 __attribute__((ext_vector_type(2)));
typedef float f32x2_t __attribute__((ext_vector_type(2)));
typedef __bf16 bf16x2_t __attribute__((ext_vector_type(2)));
DI unsigned pk2(float lo, float hi) { f32x2_t v = {lo, hi}; bf16x2_t b = __builtin_convertvector(v, bf16x2_t); return __builtin_bit_cast(unsigned, b); }
DI float bf2f(unsigned short x) { return __uint_as_float((unsigned)x << 16); }
DI float bflo(unsigned w) { return __uint_as_float(w << 16); }
DI float bfhi(unsigned w) { return __uint_as_float(w & 0xffff0000u); }
DI unsigned short f2bf(float f) { return (unsigned short)(pk2(f, 0.f) & 0xffffu); }
#define MFMA32(a, b, c) __builtin_amdgcn_mfma_f32_32x32x16_bf16((a), (b), (c), 0, 0, 0)
DI int crow(int i, int h) { return (i & 3) + 8 * (i >> 2) + 4 * h; }
DI float sigmoidf_(float x) { return 1.f / (1.f + __expf(-x)); }
DI float wave_sum(float v) {
#pragma unroll
    for (int o = 1; o < 64; o <<= 1) v += __shfl_xor(v, o);
    return v;
}
DI bf16x8 lds16(const char* p) { return *(const bf16x8*)p; }
DI bf16x8 lds8x2(const char* p) { const s16x4 a = *(const s16x4*)p, b = *(const s16x4*)(p + 8); return __builtin_shufflevector(a, b, 0, 1, 2, 3, 4, 5, 6, 7); }
typedef short v4i16_t __attribute__((ext_vector_type(4)));
DI s16x4 ldtr(const char* p) { return __builtin_bit_cast(s16x4, __builtin_amdgcn_ds_read_tr16_b64_v4i16((LAS v4i16_t*)p)); }
DI bf16x8 packf8(float a0, float a1, float a2, float a3, float a4, float a5, float a6, float a7) {
    u32x4 w; w.x = pk2(a0, a1); w.y = pk2(a2, a3); w.z = pk2(a4, a5); w.w = pk2(a6, a7); return __builtin_bit_cast(bf16x8, w);
}

constexpr int DM = 1024, TP = 16384, TS = 512, T = TP + TS, NBATCH = 32, DSEQ = 16, PAST = 2048, INW = 1696, INP = 1792, DFF = 4096;
constexpr int C_U = 0, C_HQ = 256, C_HF = 512, C_HI = 768, C_HG = 1024, C_CQ = 1280, C_CKV = 1536, C_KPE = 1664;
constexpr float EPS = 1e-5f;
constexpr float QSCALE = 0.14724444f;
constexpr int NTHR = 512, NWAVE = 8;
constexpr int LDS_BYTES = 147456;

constexpr size_t O_X = 0, O_PKV = 17301504, O_PPE = 21495808, O_PHG = 22544384, O_PRE = 22577152, O_PIM = 22579200,
                 O_SKV = 22581248, O_SPE = 22712320, O_SHG = 22745088, O_SRE = 23793664, O_SIM = 23859200;
constexpr size_t WS_ZERO = 0, ZERO_BYTES = 1048576, WS_SSQ = 65536, SSQ_STRIDE = (size_t)T * 4;
constexpr size_t WS_W = 1048576, W_LAYER = 23330816, W_IN = 0, W_UQ = 3670016, W_KV = 4063232, W_OUT = 4325376, W_UP = 6422528, W_DN = 14811136, W_GLU = 23199744;
constexpr size_t WS_MISC = WS_W + 2 * W_LAYER;
constexpr size_t M_AB = 0, M_BBRE = 16384, M_BBIM = M_BBRE + 131072, M_LB = M_BBIM + 131072, M_COS = M_LB + 2048, M_SIN = M_COS + 1048576, M_KCN = M_SIN + 1048576;
constexpr size_t WS_XB = WS_MISC + 4194304;
constexpr size_t WS_OV = WS_XB + (size_t)T * DM * 2;
constexpr size_t OV_PROJ = 0, OV_QF = OV_PROJ + (size_t)T * INP * 2, OV_KVF = OV_QF + (size_t)T * 768 * 2, OV_KPE = OV_KVF + (size_t)TP * 1024 * 2,
                 OV_MIX = OV_KPE + (size_t)TP * 32 * 2, OV_GT = OV_MIX + (size_t)T * DM * 2, OV_DD = OV_GT + (size_t)288 * 4 * 4096 * 4, OV_EBM = OV_DD + (size_t)288 * 256 * 4,
                 OV_E5 = OV_EBM + (size_t)288 * 256 * 4, OV_END = OV_E5 + (size_t)256 * 16 * 64 * 2 * 4;
constexpr size_t WS_END = WS_OV + OV_END;
static_assert(OV_END >= (size_t)T * DFF * 2, "hidden overlay fits");
static_assert(M_KCN + (size_t)2 * 32 * 64 * 160 * 2 <= 4194304, "misc region");
static_assert(WS_END <= 268435456, "workspace map within 256 MiB");
enum { SQ_X0 = 0, SQ_X1 = 1, SQ_XF = 2, SQ_2A = 3, SQ_2B = 4, SQ_QA = 5, SQ_QB = 6, SQ_KVA = 7, SQ_KVB = 8, SQ_MA = 9, SQ_MB = 10 };

struct Args { const float* in[31]; float* out; unsigned char* ws; };
enum { I_XP = 0, I_XS, I_CKV, I_CPE, I_SHG, I_S5RE, I_S5IM, I_N1G, I_WIN, I_LRE, I_LIM, I_LDT, I_BRE, I_BIM, I_CRE, I_CIM, I_S5D, I_WGLU, I_BGLU, I_LBL, I_QNG, I_WUQ, I_KVNG,
       I_WUK, I_WUV, I_ONG, I_WOUT, I_N2G, I_WUP, I_WDN, I_FNG };

struct Ctx {
    const float* const* in; float* out; unsigned char* ws; char* lds; int tid, lane, wave, G, blk;
    DI float* ssq(int i) const { return (float*)(ws + WS_SSQ + (size_t)i * SSQ_STRIDE); }
    DI bf16* wgt(int l, size_t off) const { return (bf16*)(ws + WS_W + (size_t)l * W_LAYER + off); }
    DI bf16* XB() const { return (bf16*)(ws + WS_XB); }
    DI bf16* PROJ() const { return (bf16*)(ws + WS_OV + OV_PROJ); }
    DI bf16* QF() const { return (bf16*)(ws + WS_OV + OV_QF); }
    DI bf16* KVF() const { return (bf16*)(ws + WS_OV + OV_KVF); }
    DI bf16* KPEB() const { return (bf16*)(ws + WS_OV + OV_KPE); }
    DI bf16* MIX() const { return (bf16*)(ws + WS_OV + OV_MIX); }
    DI bf16* HID() const { return (bf16*)(ws + WS_OV); }
    DI float* GT() const { return (float*)(ws + WS_OV + OV_GT); }
    DI float* DD() const { return (float*)(ws + WS_OV + OV_DD); }
    DI float* EBM() const { return (float*)(ws + WS_OV + OV_EBM); }
    DI float* E5() const { return (float*)(ws + WS_OV + OV_E5); }
    DI float* misc(size_t off) const { return (float*)(ws + WS_MISC + off); }
    DI bf16* KCN() const { return (bf16*)(ws + WS_MISC + M_KCN); }
    DI unsigned* ctr() const { return (unsigned*)(ws + WS_ZERO); }
};
DI int pos_of_row(int row) { return row < TP ? row : PAST + ((row - TP) & 15); }

namespace pg8 {
struct EpiG1 {
    static constexpr bool PERM = true, AFTER_DRAIN = false;
    bf16_t* O; const float* ssq; float* ssq_q; float* ssq_kv; bool atom;
    __device__ __forceinline__ void operator()(const f32x4 (&acc)[2][2][4][2], const Unit& u, int wr, int wc, int fr, int fq) const {
        const int row0 = u.pm * BM + wr * 64 + fr, col0 = u.pn * BM + wc * 32 + 8 * fq;
#pragma unroll
        for (int ai = 0; ai < 2; ++ai)
#pragma unroll
            for (int m = 0; m < 4; ++m) {
                const int row = row0 + ai * HALF + m * 16; const float sc = rsqrtf(ssq[row] * (1.f / 1024.f) + 1e-5f); float s2[2];
#pragma unroll
                for (int bj = 0; bj < 2; ++bj) { const f32x4 v0 = acc[ai][bj][m][0] * sc, v1 = acc[ai][bj][m][1] * sc;
                    u32x4 w; w.x = cvt_pk_bf16(v0[0], v0[1]); w.y = cvt_pk_bf16(v0[2], v0[3]); w.z = cvt_pk_bf16(v1[0], v1[1]); w.w = cvt_pk_bf16(v1[2], v1[3]);
                    *(u32x4*)(O + (size_t)row * 1792 + col0 + bj * HALF) = w;
                    s2[bj] = (v0[0] * v0[0] + v0[1] * v0[1]) + (v0[2] * v0[2] + v0[3] * v0[3]) + (v1[0] * v1[0] + v1[1] * v1[1]) + (v1[2] * v1[2] + v1[3] * v1[3]); }
                if (atom && (u.pn == 5 || u.pn == 6)) { float s = (u.pn == 5) ? s2[0] + s2[1] : s2[0]; s += __shfl_xor(s, 16); s += __shfl_xor(s, 32);
                    if (fq == 0) atomicAdd((u.pn == 5 ? ssq_q : ssq_kv) + row, s); }
            }
    }
};
struct EpiQ {
    static constexpr bool PERM = true, AFTER_DRAIN = false;
    bf16_t* O; const float* ssq;
    __device__ __forceinline__ void operator()(const f32x4 (&acc)[2][2][4][2], const Unit& u, int wr, int wc, int fr, int fq) const {
        const int row0 = u.pm * BM + wr * 64 + fr; int coff[2];
#pragma unroll
        for (int bj = 0; bj < 2; ++bj) { const int c = u.pn * BM + bj * HALF + wc * 32 + 8 * fq; int h, d;
            if (c < 512) { h = c >> 6; d = c & 63; } else { const int j = (c - 512) & 127; h = j >> 4; d = 64 + 16 * ((c - 512) >> 7) + (j & 15); }
            coff[bj] = h * 96 + d; }
        bf16_t* Ob = O + (size_t)row0 * 768;
#pragma unroll
        for (int ai = 0; ai < 2; ++ai)
#pragma unroll
            for (int m = 0; m < 4; ++m) {
                const int dr = ai * HALF + m * 16; const float sc = rsqrtf(ssq[row0 + dr] * (1.f / 256.f) + 1e-5f) * 0.14724444f;
#pragma unroll
                for (int bj = 0; bj < 2; ++bj) { const f32x4 v0 = acc[ai][bj][m][0] * sc, v1 = acc[ai][bj][m][1] * sc;
                    u32x4 w; w.x = cvt_pk_bf16(v0[0], v0[1]); w.y = cvt_pk_bf16(v0[2], v0[3]); w.z = cvt_pk_bf16(v1[0], v1[1]); w.w = cvt_pk_bf16(v1[2], v1[3]);
                    *(u32x4*)(Ob + dr * 768 + coff[bj]) = w; }
                asm volatile("" ::: "memory");
            }
    }
};
struct EpiScaleStore {
    static constexpr bool PERM = true, AFTER_DRAIN = false;
    bf16_t* O; int ldc; const float* ssq; float inv_n;
    __device__ __forceinline__ void operator()(const f32x4 (&acc)[2][2][4][2], const Unit& u, int wr, int wc, int fr, int fq) const {
        const int row0 = u.pm * BM + wr * 64 + fr, col0 = u.pn * BM + wc * 32 + 8 * fq; bf16_t* Ob = O + (size_t)row0 * 1024 + col0;
#pragma unroll
        for (int ai = 0; ai < 2; ++ai)
#pragma unroll
            for (int m = 0; m < 4; ++m) {
                const int dr = ai * HALF + m * 16; const float sc = rsqrtf(ssq[row0 + dr] * (1.f / 128.f) + 1e-5f);
#pragma unroll
                for (int bj = 0; bj < 2; ++bj) { const f32x4 v0 = acc[ai][bj][m][0] * sc, v1 = acc[ai][bj][m][1] * sc;
                    u32x4 w; w.x = cvt_pk_bf16(v0[0], v0[1]); w.y = cvt_pk_bf16(v0[2], v0[3]); w.z = cvt_pk_bf16(v1[0], v1[1]); w.w = cvt_pk_bf16(v1[2], v1[3]);
                    *(u32x4*)(Ob + dr * 1024 + bj * HALF) = w; }
                asm volatile("" ::: "memory");
            }
    }
};
struct EpiUp {
    static constexpr bool PERM = true, AFTER_DRAIN = false;
    bf16_t* O; const float* ssq;
    __device__ __forceinline__ void operator()(const f32x4 (&acc)[2][2][4][2], const Unit& u, int wr, int wc, int fr, int fq) const {
        const int row0 = u.pm * BM + wr * 64 + fr, col0 = u.pn * BM + wc * 32 + 8 * fq;
#pragma unroll
        for (int ai = 0; ai < 2; ++ai)
#pragma unroll
            for (int m = 0; m < 4; ++m) {
                const int row = row0 + ai * HALF + m * 16; const float sc = rsqrtf(ssq[row] * (1.f / 1024.f) + 1e-5f);
#pragma unroll
                for (int bj = 0; bj < 2; ++bj) { f32x4 v0 = acc[ai][bj][m][0] * sc, v1 = acc[ai][bj][m][1] * sc;
#pragma unroll
                    for (int e = 0; e < 4; ++e) { v0[e] = fmaxf(v0[e], 0.f); v1[e] = fmaxf(v1[e], 0.f); }
                    v0 = v0 * v0; v1 = v1 * v1;
                    u32x4 w; w.x = cvt_pk_bf16(v0[0], v0[1]); w.y = cvt_pk_bf16(v0[2], v0[3]); w.z = cvt_pk_bf16(v1[0], v1[1]); w.w = cvt_pk_bf16(v1[2], v1[3]);
                    *(u32x4*)(O + (size_t)row * 4096 + col0 + bj * HALF) = w; }
            }
    }
};
struct EpiRes {
    static constexpr bool PERM = true, AFTER_DRAIN = false;
    float* X; bf16_t* XB; float* ssq_out;
    __device__ __forceinline__ void operator()(const f32x4 (&acc)[2][2][4][2], const Unit& u, int wr, int wc, int fr, int fq) const {
        const int row0 = u.pm * BM + wr * 64 + fr, col0 = u.pn * BM + wc * 32 + 8 * fq;
#pragma unroll
        for (int ai = 0; ai < 2; ++ai)
#pragma unroll
            for (int m = 0; m < 4; ++m) {
                const int row = row0 + ai * HALF + m * 16; float s = 0.f;
#pragma unroll
                for (int bj = 0; bj < 2; ++bj) { float* xp = X + (size_t)row * 1024 + col0 + bj * HALF;
                    const f32x4 v0 = *(const f32x4*)xp + acc[ai][bj][m][0], v1 = *(const f32x4*)(xp + 4) + acc[ai][bj][m][1];
                    *(f32x4*)xp = v0; *(f32x4*)(xp + 4) = v1;
                    u32x4 w; w.x = cvt_pk_bf16(v0[0], v0[1]); w.y = cvt_pk_bf16(v0[2], v0[3]); w.z = cvt_pk_bf16(v1[0], v1[1]); w.w = cvt_pk_bf16(v1[2], v1[3]);
                    *(u32x4*)(XB + (size_t)row * 1024 + col0 + bj * HALF) = w;
                    s += (v0[0] * v0[0] + v0[1] * v0[1]) + (v0[2] * v0[2] + v0[3] * v0[3]) + (v1[0] * v1[0] + v1[1] * v1[1]) + (v1[2] * v1[2] + v1[3] * v1[3]); }
                s += __shfl_xor(s, 16); s += __shfl_xor(s, 32);
                if (fq == 0) atomicAdd(ssq_out + row, s);
            }
    }
};
struct EpiPartial {
    static constexpr bool PERM = true, AFTER_DRAIN = false;
    float* PART; int kq;
    __device__ __forceinline__ void operator()(const f32x4 (&acc)[2][2][4][2], const Unit& u, int wr, int wc, int fr, int fq) const {
        const int row0 = (u.pm - 64) * BM + wr * 64 + fr, col0 = u.pn * BM + wc * 32 + 8 * fq; float* Pb = PART + ((size_t)(u.ko / kq) * 512 + row0) * 1024 + col0;
#pragma unroll
        for (int ai = 0; ai < 2; ++ai)
#pragma unroll
            for (int m = 0; m < 4; ++m)
#pragma unroll
                for (int bj = 0; bj < 2; ++bj) { float* xp = Pb + (size_t)(ai * HALF + m * 16) * 1024 + bj * HALF; *(f32x4*)xp = acc[ai][bj][m][0]; *(f32x4*)(xp + 4) = acc[ai][bj][m][1]; }
    }
};
}

DI int uq_dest(int n) { const int h = n / 96, d = n - h * 96; return d < 64 ? h * 64 + d : (d < 80 ? 512 + h * 16 + (d - 64) : 640 + h * 16 + (d - 80)); }
DI void p0_transpose_item(const float* W, int K, int N, const float* gain, bf16* WT, int row_off, int kind, float* scr, int item, int lane) {
    const int nblk = N / 32, kb = item / nblk, nb = item % nblk, k0 = 64 * kb, n0 = 32 * nb;
#pragma unroll
    for (int i = 0; i < 32; ++i) { const int kk = 2 * i + (lane >> 5); float v = W[(size_t)(k0 + kk) * N + n0 + (lane & 31)]; if (gain) v *= gain[k0 + kk]; scr[kk * 33 + (lane & 31)] = v; }
    __builtin_amdgcn_s_waitcnt(0); asm volatile("" ::: "memory");
    const int c = lane & 7;
#pragma unroll
    for (int j = 0; j < 4; ++j) { const int n = (lane >> 3) + 8 * j; const float* s = scr + (8 * c) * 33 + n;
        u32x4 o; o.x = pk2(s[0 * 33], s[1 * 33]); o.y = pk2(s[2 * 33], s[3 * 33]); o.z = pk2(s[4 * 33], s[5 * 33]); o.w = pk2(s[6 * 33], s[7 * 33]);
        const int dr = kind == 0 ? row_off + n0 + n : uq_dest(n0 + n);
        *(u32x4*)(WT + (size_t)dr * K + k0 + 8 * c) = o; }
    __builtin_amdgcn_s_waitcnt(0); asm volatile("" ::: "memory");
}
DI void p0_prologue(const Ctx& C) {
    float* scr = (float*)(C.lds + C.wave * 16384);
    const int gw = C.blk * NWAVE + C.wave, NGW = C.G * NWAVE, gt = C.blk * NTHR + C.tid, NGT = C.G * NTHR;
    constexpr int I_IN = 16 * 53, I_UQ = 4 * 24, I_UK = 2 * 16, I_OUT = 16 * 32, I_UPN = 16 * 128, I_DNN = 64 * 32, I_GL = 4 * 8;
    constexpr int PER_L = I_IN + I_UQ + 2 * I_UK + I_OUT + I_UPN + I_DNN + I_GL;
    for (int it = gw; it < 2 * PER_L; it += NGW) {
        const int l = it / PER_L; int r = it - l * PER_L;
        if (r < I_IN) { p0_transpose_item(C.in[I_WIN] + (size_t)l * 1024 * INW, 1024, INW, C.in[I_N1G] + l * 1024, C.wgt(l, W_IN), 0, 0, scr, r, C.lane); continue; } r -= I_IN;
        if (r < I_UQ) { p0_transpose_item(C.in[I_WUQ] + (size_t)l * 256 * 768, 256, 768, C.in[I_QNG] + l * 256, C.wgt(l, W_UQ), 0, 1, scr, r, C.lane); continue; } r -= I_UQ;
        if (r < I_UK) { p0_transpose_item(C.in[I_WUK] + (size_t)l * 128 * 512, 128, 512, C.in[I_KVNG] + l * 128, C.wgt(l, W_KV), 0, 0, scr, r, C.lane); continue; } r -= I_UK;
        if (r < I_UK) { p0_transpose_item(C.in[I_WUV] + (size_t)l * 128 * 512, 128, 512, C.in[I_KVNG] + l * 128, C.wgt(l, W_KV), 512, 0, scr, r, C.lane); continue; } r -= I_UK;
        if (r < I_OUT) { p0_transpose_item(C.in[I_WOUT] + (size_t)l * 1024 * 1024, 1024, 1024, C.in[I_ONG] + l * 1024, C.wgt(l, W_OUT), 0, 0, scr, r, C.lane); continue; } r -= I_OUT;
        if (r < I_UPN) { p0_transpose_item(C.in[I_WUP] + (size_t)l * 1024 * 4096, 1024, 4096, C.in[I_N2G] + l * 1024, C.wgt(l, W_UP), 0, 0, scr, r, C.lane); continue; } r -= I_UPN;
        if (r < I_DNN) { p0_transpose_item(C.in[I_WDN] + (size_t)l * 4096 * 1024, 4096, 1024, nullptr, C.wgt(l, W_DN), 0, 0, scr, r, C.lane); continue; } r -= I_DNN;
        p0_transpose_item(C.in[I_WGLU] + (size_t)l * 256 * 256, 256, 256, nullptr, C.wgt(l, W_GLU), 0, 0, scr, r, C.lane);
    }
    for (int i = gt; i < 2 * 96 * 1024 / 8; i += NGT) { const int l = i / (96 * 128), r = i - l * (96 * 128); *(u32x4*)(C.wgt(l, W_IN) + (size_t)INW * 1024 + (size_t)r * 8) = (u32x4){0u, 0u, 0u, 0u}; }
    for (int i = gt; i < 2 * 32 * 64 * 160 / 8; i += NGT) *(u32x4*)(C.KCN() + (size_t)i * 8) = (u32x4){0u, 0u, 0u, 0u};
    float* X = C.out + O_X; bf16* XB = C.XB(); float* sq = C.ssq(SQ_X0);
    for (int m = gw; m < T; m += NGW) {
        const float* src = m < TP ? C.in[I_XP] + (size_t)m * DM : C.in[I_XS] + (size_t)(m - TP) * DM; float s = 0.f;
#pragma unroll
        for (int j = 0; j < 4; ++j) { const f32x4 v = *(const f32x4*)(src + 256 * j + 4 * C.lane); *(f32x4*)(X + (size_t)m * DM + 256 * j + 4 * C.lane) = v;
            u32x2 w; w.x = pk2(v[0], v[1]); w.y = pk2(v[2], v[3]); *(u32x2*)(XB + (size_t)m * DM + 256 * j + 4 * C.lane) = w; s += (v[0] * v[0] + v[1] * v[1]) + (v[2] * v[2] + v[3] * v[3]); }
        s = wave_sum(s); if (C.lane == 0) sq[m] = s;
    }
    for (int i = gt; i < 2 * 16 * 64; i += NGT) {
        const int l = i >> 10, g = (i >> 6) & 15;
        const float dt = expf(C.in[I_LDT][l * 16 + g]), lr = C.in[I_LRE][i], li = C.in[I_LIM][i];
        const float mag = expf(lr * dt); float sn, cs; sincosf(li * dt, &sn, &cs); const float abr = mag * cs, abi = mag * sn;
        const float den = lr * lr + li * li, ir = lr / den, ii = -li / den;
        const float zr = (abr - 1.f) * ir - abi * ii, zi = (abr - 1.f) * ii + abi * ir;
        float* AB = C.misc(M_AB); AB[2 * i] = abr; AB[2 * i + 1] = abi;
        float* BR = C.misc(M_BBRE) + (size_t)i * 16; float* BI = C.misc(M_BBIM) + (size_t)i * 16;
        for (int h = 0; h < 16; ++h) { const float br = C.in[I_BRE][(size_t)i * 16 + h], bi = C.in[I_BIM][(size_t)i * 16 + h]; BR[h] = zr * br - zi * bi; BI[h] = zr * bi + zi * br; }
    }
    for (int i = gt; i < 256; i += NGT) { const float a = C.in[I_LBL][i], b = C.in[I_LBL][256 + i]; const float mx = fmaxf(a, b), ea = expf(a - mx), eb = expf(b - mx);
        C.misc(M_LB)[i] = 0.f; C.misc(M_LB)[256 + i] = eb / (ea + eb); }
    for (int i = gt; i < 16384 * 16; i += NGT) { const int pos = i >> 4, k = i & 15; const double inv = pow(10000.0, -(double)k / 16.0); const double a = (double)pos * inv;
        C.misc(M_COS)[i] = (float)cos(a); C.misc(M_SIN)[i] = (float)sin(a); }
}

DI void misc_rows(const Ctx& C, int l) {
    const int gw = C.blk * NWAVE + C.wave, NGW = C.G * NWAVE; const bf16* P = C.PROJ(); const float* sq = C.ssq(SQ_KVA + l);
    const float* g = C.in[I_KVNG] + l * 128; const float* cs = C.misc(M_COS); const float* sn = C.misc(M_SIN);
    for (int m = gw; m < T; m += NGW) {
        const float r = rsqrtf(sq[m] * (1.f / 128.f) + EPS); const int lane = C.lane;
        const unsigned w = *(const unsigned*)(P + (size_t)m * INP + C_CKV + 2 * lane);
        const float c0 = bflo(w) * r * g[2 * lane], c1 = bfhi(w) * r * g[2 * lane + 1];
        float k1 = 0.f, k2 = 0.f;
        if (lane < 16) { const float x1 = bf2f(P[(size_t)m * INP + C_KPE + lane]), x2 = bf2f(P[(size_t)m * INP + C_KPE + 16 + lane]); const int pos = pos_of_row(m);
            const float c = cs[pos * 16 + lane], s = sn[pos * 16 + lane]; k1 = x1 * c - x2 * s; k2 = x2 * c + x1 * s; }
        if (m < TP) {
            float* okv = C.out + O_PKV + ((size_t)l * TP + m) * 128; *(f32x2_t*)(okv + 2 * lane) = (f32x2_t){c0, c1};
            if (lane < 16) { float* ope = C.out + O_PPE + ((size_t)l * TP + m) * 32; ope[lane] = k1; ope[16 + lane] = k2; bf16* kb = C.KPEB() + (size_t)m * 32; kb[lane] = f2bf(k1); kb[16 + lane] = f2bf(k2); }
        } else {
            const int bi = m - TP, b = bi >> 4, i = bi & 15;
            float* okv = C.out + O_SKV + ((size_t)l * TS + bi) * 128; *(f32x2_t*)(okv + 2 * lane) = (f32x2_t){c0, c1};
            bf16* kc = C.KCN() + ((size_t)(l * 32 + b) * 64 + i) * 160; *(unsigned*)(kc + 2 * lane) = pk2(c0, c1);
            if (lane < 16) { float* ope = C.out + O_SPE + ((size_t)l * TS + bi) * 32; ope[lane] = k1; ope[16 + lane] = k2; kc[128 + lane] = f2bf(k1); kc[144 + lane] = f2bf(k2); }
        }
    }
}

constexpr int S5_UP = 528, S5_HP = 272, S5_HS = 33792;
template <bool FINAL> DI void s5_item(const Ctx& C, int l, int ci) {
    const int lane = C.lane, w = C.wave, r = lane & 31, h = lane >> 5;
    const bool samp = ci >= 256; const int b = ci - 256; const int row0 = samp ? TP + b * 16 : ci * 64; const int ntok = samp ? 16 : 64;
    char* UZ = C.lds; char* HS = C.lds + S5_HS + w * (32 * S5_HP);
    const bf16* P = C.PROJ();
    for (int i = C.tid; i < 2048; i += NTHR) { const int t = i >> 5, c8 = i & 31; u32x4 v = (u32x4){0u, 0u, 0u, 0u}; if (t < ntok) v = *(const u32x4*)(P + (size_t)(row0 + t) * INP + c8 * 8); *(u32x4*)(UZ + t * S5_UP + c8 * 16) = v; }
    __syncthreads();
    for (int gi = 0; gi < 2; ++gi) {
        const int g = 2 * w + gi; const int sidx = (l * 16 + g) * 64 + lane;
        float bbr[16], bbi[16];
        { const float* BR = C.misc(M_BBRE) + (size_t)sidx * 16; const float* BI = C.misc(M_BBIM) + (size_t)sidx * 16;
#pragma unroll
          for (int q = 0; q < 4; ++q) { const f32x4 a = *(const f32x4*)(BR + 4 * q), c = *(const f32x4*)(BI + 4 * q);
#pragma unroll
              for (int e = 0; e < 4; ++e) { bbr[4 * q + e] = a[e]; bbi[4 * q + e] = c[e]; } } }
        const float abr = C.misc(M_AB)[2 * sidx], abi = C.misc(M_AB)[2 * sidx + 1];
        float hr = 0.f, hi = 0.f;
        if (FINAL) {
            if (samp) { hr = C.in[I_S5RE][((size_t)(l * 32 + b) * 16 + g) * 64 + lane]; hi = C.in[I_S5IM][((size_t)(l * 32 + b) * 16 + g) * 64 + lane]; }
            else { float pr = abr, pi = abi;
#pragma unroll
                for (int q = 0; q < 6; ++q) { const float nr = pr * pr - pi * pi, ni = 2.f * pr * pi; pr = nr; pi = ni; }
                const float* E = C.E5() + ((size_t)g * 64 + lane) * 2;
                for (int c0 = 0; c0 < ci; c0 += 16) { f32x2_t e[16];
#pragma unroll
                    for (int q = 0; q < 16; ++q) e[q] = (c0 + q < ci) ? *(const f32x2_t*)(E + (size_t)(c0 + q) * 2048) : (f32x2_t){0.f, 0.f};
#pragma unroll
                    for (int q = 0; q < 16; ++q) if (c0 + q < ci) { const float nr = pr * hr - pi * hi + e[q].x, ni = pr * hi + pi * hr + e[q].y; hr = nr; hi = ni; } } }
        }
        bf16x8 cf[8];
        if (FINAL) {
#pragma unroll
            for (int ks = 0; ks < 8; ++ks) { f32x4 a = (f32x4){0.f, 0.f, 0.f, 0.f}, c = a;
                if (r < 16) { const float* src = (ks < 4 ? C.in[I_CRE] : C.in[I_CIM]) + ((size_t)(l * 16 + g) * 16 + r) * 64 + 16 * (ks & 3) + 8 * h; a = *(const f32x4*)src; c = *(const f32x4*)(src + 4); if (ks >= 4) { a = -a; c = -c; } }
                cf[ks] = packf8(a[0], a[1], a[2], a[3], c[0], c[1], c[2], c[3]); }
        }
        const float dch = (FINAL && r < 16) ? C.in[I_S5D][l * 256 + g * 16 + r] : 0.f;
        for (int half = 0; half < 2; ++half) {
            if (half * 32 >= ntok) break;
            for (int tt = 0; tt < 32; ++tt) {
                const int t = half * 32 + tt;
                if (t < ntok) {
                    const u32x4 u0 = *(const u32x4*)(UZ + t * S5_UP + g * 32), u1 = *(const u32x4*)(UZ + t * S5_UP + g * 32 + 16);
                    float uu[16]; uu[0] = bflo(u0.x); uu[1] = bfhi(u0.x); uu[2] = bflo(u0.y); uu[3] = bfhi(u0.y); uu[4] = bflo(u0.z); uu[5] = bfhi(u0.z); uu[6] = bflo(u0.w); uu[7] = bfhi(u0.w);
                    uu[8] = bflo(u1.x); uu[9] = bfhi(u1.x); uu[10] = bflo(u1.y); uu[11] = bfhi(u1.y); uu[12] = bflo(u1.z); uu[13] = bfhi(u1.z); uu[14] = bflo(u1.w); uu[15] = bfhi(u1.w);
                    float br = 0.f, bi = 0.f;
#pragma unroll
                    for (int q = 0; q < 16; ++q) { br += bbr[q] * uu[q]; bi += bbi[q] * uu[q]; }
                    const float nr = abr * hr - abi * hi + br, ni = abr * hi + abi * hr + bi; hr = nr; hi = ni;
                }
                if (FINAL) { *(bf16*)(HS + tt * S5_HP + lane * 2) = f2bf(hr); *(bf16*)(HS + tt * S5_HP + 128 + lane * 2) = f2bf(hi); }
            }
            if (FINAL) {
                f32x16 acc = {};
#pragma unroll
                for (int ks = 0; ks < 8; ++ks) acc = MFMA32(lds16(HS + r * S5_HP + (16 * ks + 8 * h) * 2), cf[ks], acc);
                if (r < 16) { const int ch = g * 16 + r;
#pragma unroll
                    for (int i = 0; i < 16; ++i) { const int t = half * 32 + crow(i, h);
                        if (t < ntok) { bf16* zp = (bf16*)(UZ + t * S5_UP + ch * 2); const float y = acc[i] + dch * bf2f(*zp);
                            const float a = 0.7978845608f * (y + 0.044715f * y * y * y); const float th = 1.f - 2.f / (1.f + __expf(2.f * a)); *zp = f2bf(0.5f * y * (1.f + th)); } } }
            }
        }
        if (FINAL) {
            if (samp) { C.out[O_SRE + ((size_t)(l * 32 + b) * 16 + g) * 64 + lane] = hr; C.out[O_SIM + ((size_t)(l * 32 + b) * 16 + g) * 64 + lane] = hi; }
            else if (ci == 255) { C.out[O_PRE + ((size_t)l * 16 + g) * 64 + lane] = hr; C.out[O_PIM + ((size_t)l * 16 + g) * 64 + lane] = hi; }
        } else { *(f32x2_t*)(C.E5() + ((size_t)ci * 1024 + g * 64 + lane) * 2) = (f32x2_t){hr, hi}; }
    }
    if (FINAL) {
        __syncthreads();
        f32x16 ga[2] = {{}, {}};
        const bf16* WG = C.wgt(l, W_GLU);
#pragma unroll 4
        for (int ks = 0; ks < 16; ++ks) { const bf16x8 bfr = *(const bf16x8*)(WG + (size_t)(32 * w + r) * 256 + 16 * ks + 8 * h);
            ga[0] = MFMA32(lds16(UZ + r * S5_UP + (16 * ks + 8 * h) * 2), bfr, ga[0]); ga[1] = MFMA32(lds16(UZ + (32 + r) * S5_UP + (16 * ks + 8 * h) * 2), bfr, ga[1]); }
        __syncthreads();
        const int n = 32 * w + r; const float bg = C.in[I_BGLU][l * 256 + n];
#pragma unroll
        for (int rb = 0; rb < 2; ++rb)
#pragma unroll
            for (int i = 0; i < 16; ++i) { const int t = 32 * rb + crow(i, h); bf16* zp = (bf16*)(UZ + t * S5_UP + n * 2); const float z = bf2f(*zp); *zp = f2bf(z * sigmoidf_(ga[rb][i] + bg)); }
        __syncthreads();
        { const int t = C.tid >> 3, s8 = C.tid & 7; float v[32]; float s = 0.f;
#pragma unroll
          for (int q = 0; q < 4; ++q) { const u32x4 u = *(const u32x4*)(UZ + t * S5_UP + s8 * 64 + q * 16);
              v[8 * q] = bflo(u.x); v[8 * q + 1] = bfhi(u.x); v[8 * q + 2] = bflo(u.y); v[8 * q + 3] = bfhi(u.y); v[8 * q + 4] = bflo(u.z); v[8 * q + 5] = bfhi(u.z); v[8 * q + 6] = bflo(u.w); v[8 * q + 7] = bfhi(u.w); }
#pragma unroll
          for (int q = 0; q < 32; ++q) s += v[q] * v[q];
          s += __shfl_xor(s, 1); s += __shfl_xor(s, 2); s += __shfl_xor(s, 4);
          const float rn = rsqrtf(s * (1.f / 256.f) + EPS);
          if (t < ntok) { bf16* dst = C.MIX() + (size_t)(row0 + t) * DM + s8 * 32;
#pragma unroll
              for (int q = 0; q < 4; ++q) { u32x4 o; o.x = pk2(v[8 * q] * rn, v[8 * q + 1] * rn); o.y = pk2(v[8 * q + 2] * rn, v[8 * q + 3] * rn); o.z = pk2(v[8 * q + 4] * rn, v[8 * q + 5] * rn); o.w = pk2(v[8 * q + 6] * rn, v[8 * q + 7] * rn);
                  *(u32x4*)(dst + 8 * q) = o; } } }
    }
    __syncthreads();
}

constexpr int HG_P = 136, HG_WB = 2 * 64 * HG_P;
DI void hgrn_local(const Ctx& C, int l, int it) {
    const int lane = C.lane, r = lane & 31, h = lane >> 5; const int ci = it >> 2, hd = it & 3;
    const bool samp = ci >= 256; const int row0 = samp ? TP + (ci - 256) * 16 : ci * 64; const int ntok = samp ? 16 : 64, tref = (ntok >> 1) - 1;
    char* KT = C.lds + C.wave * HG_WB; char* VT = KT + 64 * HG_P; bf16* P = C.PROJ();
    const float lb = C.misc(M_LB)[l * 256 + hd * 64 + lane], omlb = 1.f - lb;
    float b = 0.f, bref = 0.f;
    for (int t0 = 0; t0 < ntok; t0 += 8) { bf16 hv[8];
#pragma unroll
        for (int q = 0; q < 8; ++q) hv[q] = P[(size_t)(row0 + t0 + q) * INP + C_HF + hd * 64 + lane];
#pragma unroll
        for (int q = 0; q < 8; ++q) { const float fp = bf2f(hv[q]); const float f = lb + omlb * sigmoidf_(fp); b += __logf(f); if (t0 + q == tref) bref = b; } }
    const float blast = b; b = 0.f;
    for (int t0 = 0; t0 < 64; t0 += 8) { bf16 hq8[8], hf8[8], hi8[8];
        if (t0 < ntok) {
#pragma unroll
            for (int q = 0; q < 8; ++q) { const bf16* pr = P + (size_t)(row0 + t0 + q) * INP + hd * 64 + lane; hq8[q] = pr[C_HQ]; hf8[q] = pr[C_HF]; hi8[q] = pr[C_HI]; }
        }
#pragma unroll
        for (int q = 0; q < 8; ++q) { const int t = t0 + q; float qt = 0.f, kt = 0.f, vv = 0.f;
            if (t0 < ntok) { const float fp = bf2f(hf8[q]), hq = bf2f(hq8[q]); const float sg = sigmoidf_(fp); const float f = lb + omlb * sg; b += __logf(f);
                qt = hq * sigmoidf_(hq) * __expf(b - bref); kt = omlb * (1.f - sg) * __expf(bref - b); vv = bf2f(hi8[q]);
                bf16* pw = P + (size_t)(row0 + t) * INP + hd * 64 + lane; pw[C_HQ] = f2bf(qt); pw[C_HF] = f2bf(kt); }
            *(bf16*)(KT + lane * HG_P + t * 2) = f2bf(kt); *(bf16*)(VT + lane * HG_P + t * 2) = f2bf(vv); } }
    C.DD()[(size_t)ci * 256 + hd * 64 + lane] = __expf(blast); C.EBM()[(size_t)ci * 256 + hd * 64 + lane] = __expf(bref);
    const float scg = __expf(blast - bref);
    f32x16 acc[2][2] = {{{}, {}}, {{}, {}}};
#pragma unroll
    for (int ks = 0; ks < 4; ++ks) { bf16x8 a[2], bb[2];
#pragma unroll
        for (int q = 0; q < 2; ++q) { a[q] = lds8x2(VT + (32 * q + r) * HG_P + (16 * ks + 8 * h) * 2); bb[q] = lds8x2(KT + (32 * q + r) * HG_P + (16 * ks + 8 * h) * 2); }
#pragma unroll
        for (int vb = 0; vb < 2; ++vb)
#pragma unroll
            for (int db = 0; db < 2; ++db) acc[vb][db] = MFMA32(a[vb], bb[db], acc[vb][db]); }
    float* G = C.GT() + ((size_t)ci * 4 + hd) * 4096;
#pragma unroll
    for (int db = 0; db < 2; ++db) { const float sc = __shfl(scg, 32 * db + r);
#pragma unroll
        for (int vb = 0; vb < 2; ++vb)
#pragma unroll
            for (int i = 0; i < 16; ++i) G[(32 * vb + crow(i, h)) * 64 + 32 * db + r] = acc[vb][db][i] * sc; }
}
DI void hgrn_prefix(const Ctx& C, int l) {
    const int e = C.blk * NTHR + C.tid;
    if (e < 16384) { const int hd = e >> 12, vd = e & 4095, d = vd & 63, v = vd >> 6; float* G = C.GT() + (size_t)hd * 4096 + vd; const float* D = C.DD() + hd * 64 + d; float S = 0.f;
        for (int c0 = 0; c0 < 256; c0 += 16) { float g[16], dd[16];
#pragma unroll
            for (int q = 0; q < 16; ++q) { g[q] = G[(size_t)(c0 + q) * 16384]; dd[q] = D[(size_t)(c0 + q) * 256]; }
#pragma unroll
            for (int q = 0; q < 16; ++q) { G[(size_t)(c0 + q) * 16384] = S; S = dd[q] * S + g[q]; } }
        C.out[O_PHG + (size_t)l * 16384 + hd * 4096 + d * 64 + v] = S; }
    for (int i = e; i < 32 * 16384; i += C.G * NTHR) { const int b = i >> 14, hv = i & 16383, hd = hv >> 12, vd = hv & 4095, d = vd & 63, v = vd >> 6;
        const float S0 = C.in[I_SHG][((size_t)(l * 32 + b) * 4 + hd) * 4096 + d * 64 + v]; float* G = C.GT() + (size_t)(256 + b) * 16384 + hv;
        const float S1 = C.DD()[(size_t)(256 + b) * 256 + hd * 64 + d] * S0 + *G; *G = S0; C.out[O_SHG + ((size_t)(l * 32 + b) * 4 + hd) * 4096 + d * 64 + v] = S1; }
}
DI void hgrn_final(const Ctx& C, int l, int bi) {
    const int lane = C.lane, r = lane & 31, h = lane >> 5; const int it = bi * 8 + C.wave, ci = it >> 2, hd = it & 3;
    const bool samp = ci >= 256; const int row0 = samp ? TP + (ci - 256) * 16 : ci * 64; const int ntok = samp ? 16 : 64;
    char* VT = C.lds + C.wave * HG_WB; float* SS = (float*)(C.lds + 8 * HG_WB); const bf16* P = C.PROJ();
    for (int t0 = 0; t0 < 64; t0 += 16) { bf16 hv[16];
#pragma unroll
        for (int q = 0; q < 16; ++q) hv[q] = (t0 < ntok) ? P[(size_t)(row0 + t0 + q) * INP + C_HI + hd * 64 + lane] : (bf16)0;
#pragma unroll
        for (int q = 0; q < 16; q += 2) *(unsigned*)(VT + lane * HG_P + (t0 + q) * 2) = (unsigned)hv[q] | ((unsigned)hv[q + 1] << 16); }
    bf16x8 qf[2][4];
    f32x16 at[2][2] = {{{}, {}}, {{}, {}}};
    const bf16x8 zf = {0, 0, 0, 0, 0, 0, 0, 0};
#pragma unroll
    for (int ks = 0; ks < 4; ++ks) { bf16x8 kf[2];
#pragma unroll
        for (int q = 0; q < 2; ++q) { const int t = 32 * q + r; const bool ok = t < ntok;
            qf[q][ks] = ok ? *(const bf16x8*)(P + (size_t)(row0 + t) * INP + C_HQ + hd * 64 + 16 * ks + 8 * h) : zf;
            kf[q] = ok ? *(const bf16x8*)(P + (size_t)(row0 + t) * INP + C_HF + hd * 64 + 16 * ks + 8 * h) : zf; }
        at[0][0] = MFMA32(kf[0], qf[0][ks], at[0][0]); at[0][1] = MFMA32(kf[0], qf[1][ks], at[0][1]); at[1][1] = MFMA32(kf[1], qf[1][ks], at[1][1]); }
#pragma unroll
    for (int i = 0; i < 16; ++i) { const int s = crow(i, h); if (s > r) { at[0][0][i] = 0.f; at[1][1][i] = 0.f; } }
    f32x16 o[2][2] = {{{}, {}}, {{}, {}}};
#pragma unroll
    for (int sb = 0; sb < 2; ++sb)
#pragma unroll
        for (int tb = sb; tb < 2; ++tb)
#pragma unroll
            for (int s2 = 0; s2 < 2; ++s2) { const f32x16& x = at[sb][tb];
                const bf16x8 pkx = packf8(x[8 * s2], x[8 * s2 + 1], x[8 * s2 + 2], x[8 * s2 + 3], x[8 * s2 + 4], x[8 * s2 + 5], x[8 * s2 + 6], x[8 * s2 + 7]);
#pragma unroll
                for (int vb = 0; vb < 2; ++vb) { const char* vp = VT + (32 * vb + r) * HG_P + (32 * sb + 16 * s2 + 4 * h) * 2;
                    const s16x4 lo = *(const s16x4*)vp, hi = *(const s16x4*)(vp + 16); const bf16x8 a2 = __builtin_shufflevector(lo, hi, 0, 1, 2, 3, 4, 5, 6, 7);
                    o[vb][tb] = MFMA32(a2, pkx, o[vb][tb]); } }
    { const float* S = C.GT() + ((size_t)ci * 4 + hd) * 4096; const float* EB = C.EBM() + (size_t)ci * 256 + hd * 64;
#pragma unroll
      for (int ks = 0; ks < 4; ++ks) { const f32x4 e0 = *(const f32x4*)(EB + 16 * ks + 8 * h), e1 = *(const f32x4*)(EB + 16 * ks + 8 * h + 4);
#pragma unroll
          for (int vb = 0; vb < 2; ++vb) { const float* sp = S + (32 * vb + r) * 64 + 16 * ks + 8 * h; const f32x4 s0 = *(const f32x4*)sp * e0, s1 = *(const f32x4*)(sp + 4) * e1;
              const bf16x8 sf = packf8(s0[0], s0[1], s0[2], s0[3], s1[0], s1[1], s1[2], s1[3]);
              o[vb][0] = MFMA32(sf, qf[0][ks], o[vb][0]); o[vb][1] = MFMA32(sf, qf[1][ks], o[vb][1]); } } }
    float sq[2];
#pragma unroll
    for (int tb = 0; tb < 2; ++tb) { float s = 0.f;
#pragma unroll
        for (int vb = 0; vb < 2; ++vb)
#pragma unroll
            for (int i = 0; i < 16; ++i) s += o[vb][tb][i] * o[vb][tb][i];
        s += __shfl_xor(s, 32); sq[tb] = s; if (h == 0) SS[C.wave * 64 + 32 * tb + r] = s; }
    __syncthreads();
    const int wb = C.wave & 4;
#pragma unroll
    for (int tb = 0; tb < 2; ++tb) { const int t = 32 * tb + r; const float tot = SS[(wb + 0) * 64 + t] + SS[(wb + 1) * 64 + t] + SS[(wb + 2) * 64 + t] + SS[(wb + 3) * 64 + t];
        const float rn = rsqrtf(tot * (1.f / 256.f) + EPS);
        if (t < ntok) {
#pragma unroll
            for (int vb = 0; vb < 2; ++vb)
#pragma unroll
                for (int g4 = 0; g4 < 4; ++g4) { const int v = 32 * vb + 8 * g4 + 4 * h; const u32x2 gw = *(const u32x2*)(P + (size_t)(row0 + t) * INP + C_HG + hd * 64 + v);
                    const float g0 = bflo(gw.x), g1 = bfhi(gw.x), g2 = bflo(gw.y), g3 = bfhi(gw.y);
                    u32x2 ow; ow.x = pk2(o[vb][tb][4 * g4] * rn * g0 * sigmoidf_(g0), o[vb][tb][4 * g4 + 1] * rn * g1 * sigmoidf_(g1)); ow.y = pk2(o[vb][tb][4 * g4 + 2] * rn * g2 * sigmoidf_(g2), o[vb][tb][4 * g4 + 3] * rn * g3 * sigmoidf_(g3));
                    *(u32x2*)(C.MIX() + (size_t)(row0 + t) * DM + 256 + hd * 64 + v) = ow; } } }
    __syncthreads();
}

#ifndef ATT_VTRANS
#define ATT_VTRANS 0
#endif
constexpr int AT_QS = 49152, AT_QN = 92160, AT_OLP = 132;
template <bool SAMPLE> DI void attn_unit(const Ctx& C, int l, int hd_or_b, int qb, int pass = 0) {
    constexpr int DQK = SAMPLE ? 160 : 96, DV = SAMPLE ? 128 : 64, KP = SAMPLE ? 336 : 208, VP = SAMPLE ? 336 : 144, NKS = DQK / 16, NVB = DV / 32;
    const int tid = C.tid, lane = C.lane, w = C.wave, r = lane & 31, h = lane >> 5;
    constexpr int KBUF = 64 * KP, VBUF = SAMPLE ? KBUF : 64 * VP, VOFF = SAMPLE ? 0 : 2 * KBUF;
    char* KB = C.lds; char* VB = C.lds + VOFF; char* QS = C.lds + AT_QS;
    const int ntiles = SAMPLE ? 33 : 4 * qb + 4;
    const int q0 = SAMPLE ? 0 : qb * 256;
    const bool wave_on = SAMPLE ? (w < 4) : true;
    const int wchunk = SAMPLE ? 1000 : 4 * qb + (w >> 1);
    bf16x8 qf[SAMPLE ? 1 : NKS];
    const bf16* KVF = C.KVF(); const bf16* KPE = C.KPEB();
    const float* ckv = SAMPLE ? C.in[I_CKV] + (size_t)(l * 32 + hd_or_b) * PAST * 128 : nullptr;
    const float* cpe = SAMPLE ? C.in[I_CPE] + (size_t)(l * 32 + hd_or_b) * PAST * 32 : nullptr;
    const bf16* kcn = SAMPLE ? C.KCN() + (size_t)(l * 32 + hd_or_b) * 64 * 160 : nullptr;
    u32x4 st0, st1, st2; f32x4 sf[5];
#define AT_PREFETCH(j) do { \
        if (!SAMPLE) { \
            const int key = tm >> 3, part = tm & 7; const size_t row = (size_t)(64 * (j) + key); \
            st0 = *(const u32x4*)(KVF + row * 1024 + hd_or_b * 64 + part * 8); \
            st1 = *(const u32x4*)(KVF + row * 1024 + 512 + hd_or_b * 64 + part * 8); \
            if (tm < 256) st2 = *(const u32x4*)(KPE + (size_t)(64 * (j) + (tm >> 2)) * 32 + (tm & 3) * 8); \
        } else if ((j) < 32) { \
            _Pragma("unroll") \
            for (int i = 0; i < 4; ++i) { const int idx = tm + 512 * i; sf[i] = *(const f32x4*)(ckv + (size_t)(64 * (j) + (idx >> 5)) * 128 + (idx & 31) * 4); } \
            sf[4] = *(const f32x4*)(cpe + (size_t)(64 * (j) + (tm >> 3)) * 32 + (tm & 7) * 4); \
        } else { \
            st0 = *(const u32x4*)(kcn + (size_t)tm * 8); st1 = *(const u32x4*)(kcn + (size_t)(tm + 512) * 8); if (tm < 256) st2 = *(const u32x4*)(kcn + (size_t)(tm + 1024) * 8); \
        } \
    } while (0)
#define AT_COMMIT(j, bsel) do { char* KBw = KB + (bsel) * KBUF; char* VBw = VB + (bsel) * VBUF; \
        if (!SAMPLE) { \
            const int key = tm >> 3, part = tm & 7; \
            *(u32x4*)(KBw + key * KP + part * 16) = st0; *(u32x4*)(VBw + key * VP + part * 16) = st1; \
            if (tm < 256) *(u32x4*)(KBw + (tm >> 2) * KP + 128 + (tm & 3) * 16) = st2; \
        } else if ((j) < 32) { \
            _Pragma("unroll") \
            for (int i = 0; i < 4; ++i) { const int idx = tm + 512 * i; u32x2 wv; wv.x = pk2(sf[i][0], sf[i][1]); wv.y = pk2(sf[i][2], sf[i][3]); *(u32x2*)(KBw + (idx >> 5) * KP + (idx & 31) * 8) = wv; } \
            { u32x2 wv; wv.x = pk2(sf[4][0], sf[4][1]); wv.y = pk2(sf[4][2], sf[4][3]); *(u32x2*)(KBw + (tm >> 3) * KP + 256 + (tm & 7) * 8) = wv; } \
        } else { \
            { const int c = tm; *(u32x4*)(KBw + (c / 20) * KP + (c % 20) * 16) = st0; } \
            { const int c = tm + 512; *(u32x4*)(KBw + (c / 20) * KP + (c % 20) * 16) = st1; } \
            if (tm < 256) { const int c = tm + 1024; *(u32x4*)(KBw + (c / 20) * KP + (c % 20) * 16) = st2; } \
        } \
    } while (0)
    int tm = tid;
    if (!SAMPLE) AT_PREFETCH(0);
    if (SAMPLE) {
        const int R = tid >> 2, part = tid & 3, hh = R >> 4, i = R & 15; const bf16* qrow = C.QF() + (size_t)(TP + hd_or_b * 16 + i) * 768 + hh * 96;
        float* QN = (float*)(C.lds + AT_QN) + R * 64;
        { const u32x4 u0 = *(const u32x4*)(qrow + part * 16), u1 = *(const u32x4*)(qrow + part * 16 + 8);
          *(f32x4*)(QN + part * 16) = (f32x4){bflo(u0.x), bfhi(u0.x), bflo(u0.y), bfhi(u0.y)}; *(f32x4*)(QN + part * 16 + 4) = (f32x4){bflo(u0.z), bfhi(u0.z), bflo(u0.w), bfhi(u0.w)};
          *(f32x4*)(QN + part * 16 + 8) = (f32x4){bflo(u1.x), bfhi(u1.x), bflo(u1.y), bfhi(u1.y)}; *(f32x4*)(QN + part * 16 + 12) = (f32x4){bflo(u1.z), bfhi(u1.z), bflo(u1.w), bfhi(u1.w)}; }
        __syncthreads();
        const float* wuk = C.in[I_WUK] + (size_t)l * 128 * 512 + hh * 64;
#pragma unroll 1
        for (int cc = 0; cc < 32; cc += 2) { float a0 = 0.f, a1 = 0.f; const float* w0 = wuk + (size_t)(part * 32 + cc) * 512; const float* w1 = w0 + 512;
#pragma unroll 2
            for (int q = 0; q < 16; ++q) { const f32x4 qv = *(const f32x4*)(QN + 4 * q); const f32x4 x0 = *(const f32x4*)(w0 + 4 * q), x1 = *(const f32x4*)(w1 + 4 * q);
                a0 += qv[0] * x0[0] + qv[1] * x0[1] + qv[2] * x0[2] + qv[3] * x0[3]; a1 += qv[0] * x1[0] + qv[1] * x1[1] + qv[2] * x1[2] + qv[3] * x1[3]; }
            *(unsigned*)(QS + R * 336 + (part * 32 + cc) * 2) = pk2(a0, a1); }
        if (part < 2) { const int pos = PAST + i; const float* cs = C.misc(M_COS) + pos * 16 + 8 * part; const float* sn = C.misc(M_SIN) + pos * 16 + 8 * part;
            const u32x4 x1 = *(const u32x4*)(qrow + 64 + part * 8), x2 = *(const u32x4*)(qrow + 80 + part * 8); u32x4 y1, y2;
#pragma unroll
            for (int e = 0; e < 4; ++e) { const float a0 = bflo(x1[e]), a1 = bfhi(x1[e]), b0 = bflo(x2[e]), b1 = bfhi(x2[e]); const float c0 = cs[2 * e], c1 = cs[2 * e + 1], s0 = sn[2 * e], s1 = sn[2 * e + 1];
                y1[e] = pk2(a0 * c0 - b0 * s0, a1 * c1 - b1 * s1); y2[e] = pk2(b0 * c0 + a0 * s0, b1 * c1 + a1 * s1); }
            *(u32x4*)(QS + R * 336 + 256 + part * 16) = y1; *(u32x4*)(QS + R * 336 + 288 + part * 16) = y2; }
        __syncthreads();
    } else {
        const bf16* qrow = C.QF() + (size_t)(q0 + 32 * w + r) * 768 + hd_or_b * 96;
#pragma unroll
        for (int ks = 0; ks < NKS; ++ks) qf[ks] = *(const bf16x8*)(qrow + 16 * ks + 8 * h);
        { const int pos = q0 + 32 * w + r; const float* cs = C.misc(M_COS) + pos * 16 + 8 * h; const float* sn = C.misc(M_SIN) + pos * 16 + 8 * h;
          const u32x4 x1 = __builtin_bit_cast(u32x4, qf[4]), x2 = __builtin_bit_cast(u32x4, qf[5]); u32x4 y1, y2;
#pragma unroll
          for (int e = 0; e < 4; ++e) { const float a0 = bflo(x1[e]), a1 = bfhi(x1[e]), b0 = bflo(x2[e]), b1 = bfhi(x2[e]); const float c0 = cs[2 * e], c1 = cs[2 * e + 1], s0 = sn[2 * e], s1 = sn[2 * e + 1];
              y1[e] = pk2(a0 * c0 - b0 * s0, a1 * c1 - b1 * s1); y2[e] = pk2(b0 * c0 + a0 * s0, b1 * c1 + a1 * s1); }
          qf[4] = __builtin_bit_cast(bf16x8, y1); qf[5] = __builtin_bit_cast(bf16x8, y2); }
    }
    if (SAMPLE) { asm volatile("" : "+v"(tm)); AT_PREFETCH(0); }
    float mref = 0.f, lrun = 0.f; f32x16 o[NVB]; f32x16 negm = {};
#pragma unroll
    for (int vb = 0; vb < NVB; ++vb) o[vb] = f32x16{};
    const int i16 = lane & 15, gg = (lane >> 4) & 1;
    const char* vlane = VB + (4 * h + (i16 >> 2)) * VP + (16 * gg + 4 * (i16 & 3)) * 2;
    AT_COMMIT(0, 0);
    if (ntiles > 1) AT_PREFETCH(1);
    __syncthreads();
    for (int j = 0; j < ntiles; ++j) {
        const int cb = j & 1;
        if (j + 1 < ntiles) AT_COMMIT(j + 1, cb ^ 1);
        if (j + 2 < ntiles) AT_PREFETCH(j + 2);
        if (wave_on && j <= wchunk) {
            const char* KBc = KB + cb * KBUF; const char* vlc = vlane + cb * VBUF;
            f32x16 p0 = negm, p1 = negm;
#pragma unroll
            for (int ks = 0; ks < NKS; ++ks) { const bf16x8 qv = SAMPLE ? lds16(QS + (32 * w + r) * 336 + (16 * ks + 8 * h) * 2) : qf[ks]; p0 = MFMA32(lds16(KBc + r * KP + (16 * ks + 8 * h) * 2), qv, p0); p1 = MFMA32(lds16(KBc + (32 + r) * KP + (16 * ks + 8 * h) * 2), qv, p1); }
            if (SAMPLE && j == 32) {
#pragma unroll
                for (int i = 0; i < 16; ++i) { if (crow(i, h) >= 16) p0[i] = -1e30f; p1[i] = -1e30f; }
            }
            float mx = fmaxf(fmaxf(p0[0], p0[1]), p1[0]);
#pragma unroll
            for (int i = 2; i < 16; i += 2) mx = fmaxf(fmaxf(mx, p0[i]), p0[i + 1]);
#pragma unroll
            for (int i = 1; i < 15; i += 2) mx = fmaxf(fmaxf(mx, p1[i]), p1[i + 1]);
            mx = fmaxf(mx, p1[15]);
            mx = fmaxf(mx, __shfl_xor(mx, 32));
            if (j == 0) { mref = mx;
#pragma unroll
                for (int i = 0; i < 16; ++i) { p0[i] -= mx; p1[i] -= mx; negm[i] = -mref; }
            } else if (__any(mx > 8.f)) { const float dl = fmaxf(mx, 0.f), al = __builtin_amdgcn_exp2f(-dl); mref += dl; lrun *= al;
#pragma unroll
                for (int i = 0; i < 16; ++i) { p0[i] -= dl; p1[i] -= dl; negm[i] = -mref; }
#pragma unroll
                for (int vb = 0; vb < NVB; ++vb)
#pragma unroll
                    for (int i = 0; i < 16; ++i) o[vb][i] *= al;
            }
            float ls = 0.f;
#pragma unroll
            for (int i = 0; i < 16; ++i) { p0[i] = __builtin_amdgcn_exp2f(p0[i]); p1[i] = __builtin_amdgcn_exp2f(p1[i]); ls += p0[i] + p1[i]; }
            lrun += ls;
#pragma unroll
            for (int kb = 0; kb < 2; ++kb)
#pragma unroll
                for (int s2 = 0; s2 < 2; ++s2) { const f32x16& x = kb ? p1 : p0;
                    const bf16x8 pkx = packf8(x[8 * s2], x[8 * s2 + 1], x[8 * s2 + 2], x[8 * s2 + 3], x[8 * s2 + 4], x[8 * s2 + 5], x[8 * s2 + 6], x[8 * s2 + 7]);
#pragma unroll
                    for (int vb = 0; vb < NVB; ++vb) { const char* vp = vlc + (32 * kb + 16 * s2) * VP + 64 * vb;
                        const s16x4 lo = ldtr(vp), hi = ldtr(vp + 8 * VP); const bf16x8 a2 = __builtin_shufflevector(lo, hi, 0, 1, 2, 3, 4, 5, 6, 7);
                        o[vb] = MFMA32(a2, pkx, o[vb]); }
                    asm volatile("" ::: "memory"); }
        }
        __syncthreads();
    }
    lrun += __shfl_xor(lrun, 32); const float inv = 1.f / lrun;
    if (!SAMPLE) {
        const int row = q0 + 32 * w + r; float s = 0.f; bf16* dst = C.MIX() + (size_t)row * DM + 512 + hd_or_b * 64;
#pragma unroll
        for (int vb = 0; vb < NVB; ++vb)
#pragma unroll
            for (int g4 = 0; g4 < 4; ++g4) { const float a0 = o[vb][4 * g4] * inv, a1 = o[vb][4 * g4 + 1] * inv, a2 = o[vb][4 * g4 + 2] * inv, a3 = o[vb][4 * g4 + 3] * inv;
                s += (a0 * a0 + a1 * a1) + (a2 * a2 + a3 * a3); u32x2 ow; ow.x = pk2(a0, a1); ow.y = pk2(a2, a3); *(u32x2*)(dst + 32 * vb + 8 * g4 + 4 * h) = ow; }
        s += __shfl_xor(s, 32); if (h == 0 && pass == 0) atomicAdd(C.ssq(SQ_MA + l) + row, s);
    } else {
        __syncthreads();
        float* OL = (float*)C.lds;
        if (wave_on) {
#pragma unroll
            for (int vb = 0; vb < NVB; ++vb)
#pragma unroll
                for (int i = 0; i < 16; ++i) OL[(32 * w + r) * AT_OLP + 32 * vb + crow(i, h)] = o[vb][i] * inv;
        }
        __syncthreads();
        const int R = tid >> 2, part = tid & 3, hh = R >> 4, i = R & 15; const int row = TP + hd_or_b * 16 + i;
        float acc[16];
#pragma unroll
        for (int q = 0; q < 16; ++q) acc[q] = 0.f;
        const float* wuv = C.in[I_WUV] + (size_t)l * 128 * 512 + hh * 64 + part * 16;
        for (int c = 0; c < 128; ++c) { const float ol = OL[R * AT_OLP + c];
#pragma unroll
            for (int q = 0; q < 4; ++q) { const f32x4 x = *(const f32x4*)(wuv + (size_t)c * 512 + 4 * q); acc[4 * q] += ol * x[0]; acc[4 * q + 1] += ol * x[1]; acc[4 * q + 2] += ol * x[2]; acc[4 * q + 3] += ol * x[3]; } }
        float s = 0.f;
#pragma unroll
        for (int q = 0; q < 16; ++q) s += acc[q] * acc[q];
        bf16* dst = C.MIX() + (size_t)row * DM + 512 + hh * 64 + part * 16;
        u32x4 o0, o1; o0.x = pk2(acc[0], acc[1]); o0.y = pk2(acc[2], acc[3]); o0.z = pk2(acc[4], acc[5]); o0.w = pk2(acc[6], acc[7]); o1.x = pk2(acc[8], acc[9]); o1.y = pk2(acc[10], acc[11]); o1.z = pk2(acc[12], acc[13]); o1.w = pk2(acc[14], acc[15]);
        *(u32x4*)dst = o0; *(u32x4*)(dst + 8) = o1;
        s += __shfl_xor(s, 1); s += __shfl_xor(s, 2); if (part == 0 && pass == 0) atomicAdd(C.ssq(SQ_MA + l) + row, s);
    }
}
template <bool SAMPLE> DI void attn_phase(const Ctx& C, int l, int pass = 0) {
    unsigned* sched = (unsigned*)(C.lds + LDS_BYTES - 64);
    for (;;) {
        __syncthreads();
        if (C.tid == 0) *sched = atomicAdd(C.ctr() + (SAMPLE ? 24 : 16) + l + 32 * pass, 1u);
        __syncthreads();
        const int u = (int)*sched;
        if (u >= (SAMPLE ? 32 : 512)) break;
        if (SAMPLE) attn_unit<true>(C, l, u, 0, pass); else attn_unit<false>(C, l, u & 7, 63 - (u >> 3), pass);
    }
}
DI void mla_finalize(const Ctx& C, int l) {
    const int gw = C.blk * NWAVE + C.wave, NGW = C.G * NWAVE; const float* sq = C.ssq(SQ_MA + l);
    for (int m = gw; m < T; m += NGW) { const float rn = rsqrtf(sq[m] * (1.f / 512.f) + EPS); u32x4* p = (u32x4*)(C.MIX() + (size_t)m * DM + 512 + C.lane * 8); const u32x4 u = *p;
        u32x4 o; o.x = pk2(bflo(u.x) * rn, bfhi(u.x) * rn); o.y = pk2(bflo(u.y) * rn, bfhi(u.y) * rn); o.z = pk2(bflo(u.z) * rn, bfhi(u.z) * rn); o.w = pk2(bflo(u.w) * rn, bfhi(u.w) * rn); *p = o; }
}
DI void sample_post(const Ctx& C, float* sq, unsigned* cnt, int nsplit) {
    const int gw = C.blk * NWAVE + C.wave, NGW = C.G * NWAVE; const float* PART = C.GT();
    for (int m = TP + gw; m < T; m += NGW) { float* x = C.out + O_X + (size_t)m * DM; float s = 0.f;
#pragma unroll
        for (int j = 0; j < 4; ++j) { f32x4 v = *(const f32x4*)(x + 256 * j + 4 * C.lane);
            for (int ks = 0; ks < nsplit; ++ks) v += *(const f32x4*)(PART + ((size_t)ks * 512 + (m - TP)) * 1024 + 256 * j + 4 * C.lane);
            *(f32x4*)(x + 256 * j + 4 * C.lane) = v;
            u32x2 w; w.x = pk2(v[0], v[1]); w.y = pk2(v[2], v[3]); *(u32x2*)(C.XB() + (size_t)m * DM + 256 * j + 4 * C.lane) = w;
            s += (v[0] * v[0] + v[1] * v[1]) + (v[2] * v[2] + v[3] * v[3]); }
        s = wave_sum(s); if (C.lane == 0) sq[m] = s; }
    if (TP + C.blk * NWAVE < T) { asm volatile("s_waitcnt vmcnt(0)" ::: "memory"); __syncthreads(); if (C.tid == 0) { __builtin_amdgcn_fence(__ATOMIC_RELEASE, "agent"); asm volatile("s_waitcnt vmcnt(0)" ::: "memory"); } }
    if (C.tid == 0) __hip_atomic_fetch_add(cnt, 1u, __ATOMIC_RELAXED, __HIP_MEMORY_SCOPE_AGENT);
}
DI void final_norm(const Ctx& C) {
    const int gw = C.blk * NWAVE + C.wave, NGW = C.G * NWAVE; const float* sq = C.ssq(SQ_XF); const float* g = C.in[I_FNG];
    for (int m = gw; m < T; m += NGW) { float* x = C.out + O_X + (size_t)m * DM; f32x4 v[4]; float s = 0.f;
#pragma unroll
        for (int j = 0; j < 4; ++j) { v[j] = *(f32x4*)(x + 256 * j + 4 * C.lane);
            if (m >= TP) { for (int ks = 0; ks < 8; ++ks) v[j] += *(const f32x4*)(C.GT() + ((size_t)ks * 512 + (m - TP)) * 1024 + 256 * j + 4 * C.lane); }
            s += (v[j][0] * v[j][0] + v[j][1] * v[j][1]) + (v[j][2] * v[j][2] + v[j][3] * v[j][3]); }
        s = wave_sum(s); const float rn = rsqrtf((m < TP ? sq[m] : s) * (1.f / 1024.f) + EPS);
#pragma unroll
        for (int j = 0; j < 4; ++j) { const f32x4 gg = *(const f32x4*)(g + 256 * j + 4 * C.lane); *(f32x4*)(x + 256 * j + 4 * C.lane) = v[j] * rn * gg; } }
}


#ifndef NAIVE_QKV
#define NAIVE_QKV 0
#endif
DI void naive_q(const Ctx& C, int l) {
    const bf16* P = C.PROJ(); const float* W = C.in[I_WUQ] + (size_t)l * 256 * 768; const float* g = C.in[I_QNG] + l * 256; const float* sq = C.ssq(SQ_QA + l);
    for (size_t i = (size_t)C.blk * NTHR + C.tid; i < (size_t)T * 768; i += (size_t)C.G * NTHR) { const int row = (int)(i / 768), n = (int)(i % 768); float a = 0.f;
        for (int k = 0; k < 256; ++k) a += bf2f(P[(size_t)row * INP + C_CQ + k]) * g[k] * W[(size_t)k * 768 + n];
        C.QF()[i] = f2bf(a * rsqrtf(sq[row] * (1.f / 256.f) + EPS) * QSCALE); }
}
DI void naive_kv(const Ctx& C, int l) {
    const bf16* P = C.PROJ(); const float* Wk = C.in[I_WUK] + (size_t)l * 128 * 512; const float* Wv = C.in[I_WUV] + (size_t)l * 128 * 512; const float* g = C.in[I_KVNG] + l * 128; const float* sq = C.ssq(SQ_KVA + l);
    for (size_t i = (size_t)C.blk * NTHR + C.tid; i < (size_t)TP * 1024; i += (size_t)C.G * NTHR) { const int row = (int)(i >> 10), n = (int)(i & 1023); const float* W = n < 512 ? Wk + n : Wv + (n - 512); float a = 0.f;
        for (int k = 0; k < 128; ++k) a += bf2f(P[(size_t)row * INP + C_CKV + k]) * g[k] * W[(size_t)k * 512];
        C.KVF()[i] = f2bf(a * rsqrtf(sq[row] * (1.f / 128.f) + EPS)); }
}

#ifndef NAIVE_S5
#define NAIVE_S5 0
#endif
#ifndef NAIVE_HG
#define NAIVE_HG 0
#endif
DI void naive_s5_scan(const Ctx& C, int l, float* TMP) {
    const int gw = C.blk * NWAVE + C.wave, NGW = C.G * NWAVE, lane = C.lane; const bf16* P = C.PROJ();
    for (int it = gw; it < 33 * 16; it += NGW) { const int sq = it >> 4, g = it & 15; const bool samp = sq > 0; const int b = sq - 1; const int row0 = samp ? TP + b * 16 : 0, n = samp ? 16 : TP;
        const int sidx = (l * 16 + g) * 64 + lane;
        const float dt = expf(C.in[I_LDT][l * 16 + g]), lr = C.in[I_LRE][sidx], li = C.in[I_LIM][sidx]; const float mag = expf(lr * dt); const float abr = mag * cosf(li * dt), abi = mag * sinf(li * dt);
        const float den = lr * lr + li * li, ir = lr / den, ii = -li / den; const float zr = (abr - 1.f) * ir - abi * ii, zi = (abr - 1.f) * ii + abi * ir;
        float bbr[16], bbi[16], cr[16], cim[16];
#pragma unroll
        for (int h = 0; h < 16; ++h) { const float br = C.in[I_BRE][(size_t)sidx * 16 + h], bi = C.in[I_BIM][(size_t)sidx * 16 + h]; bbr[h] = zr * br - zi * bi; bbi[h] = zr * bi + zi * br;
            cr[h] = C.in[I_CRE][((size_t)(l * 16 + g) * 16 + h) * 64 + lane]; cim[h] = C.in[I_CIM][((size_t)(l * 16 + g) * 16 + h) * 64 + lane]; }
        float hr = 0.f, hi = 0.f; if (samp) { hr = C.in[I_S5RE][((size_t)(l * 32 + b) * 16 + g) * 64 + lane]; hi = C.in[I_S5IM][((size_t)(l * 32 + b) * 16 + g) * 64 + lane]; }
        const float dch = lane < 16 ? C.in[I_S5D][l * 256 + g * 16 + lane] : 0.f;
        for (int t = 0; t < n; ++t) { const bf16* up = P + (size_t)(row0 + t) * INP + g * 16; float br = 0.f, bi = 0.f; float myu = 0.f;
#pragma unroll
            for (int h = 0; h < 16; ++h) { const float u = bf2f(up[h]); br += bbr[h] * u; bi += bbi[h] * u; if (h == lane) myu = u; }
            const float nr = abr * hr - abi * hi + br, ni = abr * hi + abi * hr + bi; hr = nr; hi = ni; float yk = 0.f;
#pragma unroll
            for (int h = 0; h < 16; ++h) { const float v = wave_sum(cr[h] * hr - cim[h] * hi); if (h == lane) yk = v; }
            if (lane < 16) { const float y = yk + dch * myu; const float a = 0.7978845608f * (y + 0.044715f * y * y * y); TMP[(size_t)(row0 + t) * 256 + g * 16 + lane] = 0.5f * y * (1.f + tanhf(a)); } }
        if (samp) { C.out[O_SRE + ((size_t)(l * 32 + b) * 16 + g) * 64 + lane] = hr; C.out[O_SIM + ((size_t)(l * 32 + b) * 16 + g) * 64 + lane] = hi; }
        else { C.out[O_PRE + ((size_t)l * 16 + g) * 64 + lane] = hr; C.out[O_PIM + ((size_t)l * 16 + g) * 64 + lane] = hi; } }
}
DI void naive_s5_glu(const Ctx& C, int l, const float* TMP) {
    float* zs = (float*)C.lds; float* red = zs + 256; const int tid = C.tid;
    for (int row = C.blk; row < T; row += C.G) { __syncthreads(); if (tid < 256) zs[tid] = TMP[(size_t)row * 256 + tid]; __syncthreads();
        float o = 0.f; if (tid < 256) { float a = C.in[I_BGLU][l * 256 + tid]; const float* W = C.in[I_WGLU] + (size_t)l * 65536 + tid; for (int k = 0; k < 256; ++k) a += zs[k] * W[(size_t)k * 256]; o = zs[tid] / (1.f + expf(-a)); }
        float s = wave_sum(o * o); if (C.lane == 0) red[C.wave] = s; __syncthreads(); const float tot = red[0] + red[1] + red[2] + red[3];
        if (tid < 256) C.MIX()[(size_t)row * DM + tid] = f2bf(o * rsqrtf(tot * (1.f / 256.f) + EPS)); }
}
DI void naive_hg_scan(const Ctx& C, int l, float* TMP) {
    const bf16* P = C.PROJ(); const float* LB = C.misc(M_LB) + l * 256;
    for (int it = C.blk * NTHR + C.tid; it < 33 * 256; it += C.G * NTHR) { const int sq = it >> 8, hd = (it >> 6) & 3, v = it & 63; const bool samp = sq > 0; const int b = sq - 1; const int row0 = samp ? TP + b * 16 : 0, n = samp ? 16 : TP;
        float S[64];
#pragma unroll
        for (int d = 0; d < 64; ++d) S[d] = samp ? C.in[I_SHG][((size_t)(l * 32 + b) * 4 + hd) * 4096 + d * 64 + v] : 0.f;
        for (int t = 0; t < n; ++t) { const bf16* pr = P + (size_t)(row0 + t) * INP; const float vv = bf2f(pr[C_HI + hd * 64 + v]); float o = 0.f;
#pragma unroll
            for (int d = 0; d < 64; ++d) { const float lb = LB[hd * 64 + d], fp = bf2f(pr[C_HF + hd * 64 + d]), hq = bf2f(pr[C_HQ + hd * 64 + d]); const float sg = 1.f / (1.f + expf(-fp));
                const float f = lb + (1.f - lb) * sg, k = (1.f - lb) * (1.f - sg), q = hq / (1.f + expf(-hq)); S[d] = f * S[d] + k * vv; o += q * S[d]; }
            TMP[(size_t)(row0 + t) * 256 + hd * 64 + v] = o; }
#pragma unroll
        for (int d = 0; d < 64; ++d) { if (samp) C.out[O_SHG + ((size_t)(l * 32 + b) * 4 + hd) * 4096 + d * 64 + v] = S[d]; else C.out[O_PHG + (size_t)l * 16384 + hd * 4096 + d * 64 + v] = S[d]; } }
}
DI void naive_hg_norm(const Ctx& C, int l, const float* TMP) {
    const int gw = C.blk * NWAVE + C.wave, NGW = C.G * NWAVE, lane = C.lane; const bf16* P = C.PROJ();
    for (int m = gw; m < T; m += NGW) { float o[4]; float s = 0.f;
#pragma unroll
        for (int j = 0; j < 4; ++j) { o[j] = TMP[(size_t)m * 256 + 64 * j + lane]; s += o[j] * o[j]; }
        s = wave_sum(s); const float rn = rsqrtf(s * (1.f / 256.f) + EPS);
#pragma unroll
        for (int j = 0; j < 4; ++j) { const float g = bf2f(P[(size_t)m * INP + C_HG + 64 * j + lane]); C.MIX()[(size_t)m * DM + 256 + 64 * j + lane] = f2bf(o[j] * rn * g / (1.f + expf(-g))); } }
}

#ifndef TIME_A
#define TIME_A 0
#endif
#ifndef TIME_B
#define TIME_B 0
#endif
#ifndef TIME_C
#define TIME_C 0
#endif
#ifndef TIME_D
#define TIME_D 0
#endif
#ifndef TIME_ATTP
#define TIME_ATTP 0
#endif
#ifndef TIME_ATTS
#define TIME_ATTS 0
#endif
#ifndef NAIVE_ATTP
#define NAIVE_ATTP 0
#endif
#ifndef NAIVE_ATTS
#define NAIVE_ATTS 0
#endif
DI float wave_max(float v) {
#pragma unroll
    for (int o = 1; o < 64; o <<= 1) v = fmaxf(v, __shfl_xor(v, o));
    return v;
}
DI void naive_attn_prompt(const Ctx& C, int l) {
    const int gw = C.blk * NWAVE + C.wave, NGW = C.G * NWAVE, lane = C.lane; const bf16* QF = C.QF(); const bf16* KVF = C.KVF(); const bf16* KPE = C.KPEB();
    for (int it = gw; it < TP * 8; it += NGW) { const int row = it >> 3, hd = it & 7; float q[96];
#pragma unroll
        for (int d = 0; d < 96; ++d) q[d] = bf2f(QF[(size_t)row * 768 + hd * 96 + d]);
#pragma unroll
        for (int i = 0; i < 16; ++i) { const float c = C.misc(M_COS)[row * 16 + i], s = C.misc(M_SIN)[row * 16 + i]; const float x1 = q[64 + i], x2 = q[80 + i]; q[64 + i] = x1 * c - x2 * s; q[80 + i] = x2 * c + x1 * s; }
        const int nk = 64 * (row / 64 + 1); float m = -1e30f, ls = 0.f; float acc[64];
#pragma unroll
        for (int d = 0; d < 64; ++d) acc[d] = 0.f;
        for (int k = lane; k < nk; k += 64) { float sc = 0.f;
#pragma unroll
            for (int d = 0; d < 64; ++d) sc += q[d] * bf2f(KVF[(size_t)k * 1024 + hd * 64 + d]);
#pragma unroll
            for (int d = 0; d < 32; ++d) sc += q[64 + d] * bf2f(KPE[(size_t)k * 32 + d]);
            const float mn = fmaxf(m, sc), a = exp2f(m - mn), p = exp2f(sc - mn); m = mn; ls = ls * a + p;
#pragma unroll
            for (int d = 0; d < 64; ++d) acc[d] = acc[d] * a + p * bf2f(KVF[(size_t)k * 1024 + 512 + hd * 64 + d]); }
        const float M = wave_max(m), f = exp2f(m - M); const float L = wave_sum(ls * f); float mine = 0.f;
#pragma unroll
        for (int d = 0; d < 64; ++d) { const float v = wave_sum(acc[d] * f) / L; if (d == lane) mine = v; }
        C.MIX()[(size_t)row * DM + 512 + hd * 64 + lane] = f2bf(mine); const float s2 = wave_sum(mine * mine); if (lane == 0) atomicAdd(C.ssq(SQ_MA + l) + row, s2); }
}
DI void naive_attn_sample(const Ctx& C, int l) {
    const int gw = C.blk * NWAVE + C.wave, NGW = C.G * NWAVE, lane = C.lane; const bf16* QF = C.QF(); float* qs = (float*)C.lds + C.wave * 512; float* os = qs + 256;
    for (int it = gw; it < TS * 8; it += NGW) { const int bi = it >> 3, hh = it & 7, b = bi >> 4, i = bi & 15, row = TP + bi, pos = PAST + i;
        const bf16* qr = QF + (size_t)row * 768 + hh * 96;
        for (int c = lane; c < 128; c += 64) { float a = 0.f; const float* w = C.in[I_WUK] + (size_t)l * 65536 + (size_t)c * 512 + hh * 64; for (int d = 0; d < 64; ++d) a += bf2f(qr[d]) * w[d]; qs[c] = a; }
        if (lane < 16) { const float c = C.misc(M_COS)[pos * 16 + lane], s = C.misc(M_SIN)[pos * 16 + lane]; const float x1 = bf2f(qr[64 + lane]), x2 = bf2f(qr[80 + lane]); qs[128 + lane] = x1 * c - x2 * s; qs[144 + lane] = x2 * c + x1 * s; }
        __builtin_amdgcn_s_waitcnt(0); asm volatile("" ::: "memory");
        float m = -1e30f, ls = 0.f; float acc[128];
#pragma unroll
        for (int d = 0; d < 128; ++d) acc[d] = 0.f;
        for (int k = lane; k < PAST + 16; k += 64) { const float* kv = k < PAST ? C.in[I_CKV] + ((size_t)(l * 32 + b) * PAST + k) * 128 : C.out + O_SKV + ((size_t)l * TS + b * 16 + (k - PAST)) * 128;
            const float* pe = k < PAST ? C.in[I_CPE] + ((size_t)(l * 32 + b) * PAST + k) * 32 : C.out + O_SPE + ((size_t)l * TS + b * 16 + (k - PAST)) * 32; float sc = 0.f;
            for (int d = 0; d < 128; ++d) sc += qs[d] * kv[d];
            for (int d = 0; d < 32; ++d) sc += qs[128 + d] * pe[d];
            const float mn = fmaxf(m, sc), a = exp2f(m - mn), p = exp2f(sc - mn); m = mn; ls = ls * a + p;
#pragma unroll
            for (int d = 0; d < 128; ++d) acc[d] = acc[d] * a + p * kv[d]; }
        const float M = wave_max(m), f = exp2f(m - M); const float L = wave_sum(ls * f);
#pragma unroll
        for (int d = 0; d < 128; ++d) { const float v = wave_sum(acc[d] * f) / L; if ((d & 63) == lane) os[d] = v; }
        __builtin_amdgcn_s_waitcnt(0); asm volatile("" ::: "memory");
        float o = 0.f; const float* wv = C.in[I_WUV] + (size_t)l * 65536 + hh * 64 + lane; for (int c = 0; c < 128; ++c) o += os[c] * wv[(size_t)c * 512];
        C.MIX()[(size_t)row * DM + 512 + hh * 64 + lane] = f2bf(o); const float s2 = wave_sum(o * o); if (lane == 0) atomicAdd(C.ssq(SQ_MA + l) + row, s2);
        __builtin_amdgcn_s_waitcnt(0); asm volatile("" ::: "memory"); }
}
#define XB_TMO      128
#define XB_XCNT(j)  (256  + 64 * (j))
#define XB_XSUB(j)  (1280 + 64 * (j))
#define XB_XGEN(j)  (2304 + 64 * (j))
#define XB_TOP      3328
#define XB_TOPGEN   3392
#define XCD_BAR_WORDS 3456
#define XB_SPIN_CAP (1u << 18)

__device__ __forceinline__ unsigned xb_ld(unsigned* p)              { return __hip_atomic_load(p, __ATOMIC_RELAXED, __HIP_MEMORY_SCOPE_AGENT); }
__device__ __forceinline__ unsigned xb_add(unsigned* p, unsigned v) { return __hip_atomic_fetch_add(p, v, __ATOMIC_RELAXED, __HIP_MEMORY_SCOPE_AGENT); }
__device__ __forceinline__ unsigned xb_xcc_id() { return (unsigned)__builtin_amdgcn_s_getreg((3 << 11) | 20) & 0xFu; }
#define XB_SPIN(cond, bar) do { unsigned _sp = 0; while (cond) { __builtin_amdgcn_s_sleep(1); \
    if ((++_sp & 255u) == 0u) { if (xb_ld(&(bar)[XB_TMO])) break; if (_sp > XB_SPIN_CAP) { atomicAdd(&(bar)[XB_TMO], 1u); break; } } } } while (0)

struct XcdBarrier {
    unsigned* bar; unsigned x;
    volatile LAS unsigned* st;
};

__device__ __forceinline__ XcdBarrier xcd_barrier_post(unsigned* bar, volatile LAS unsigned* st) {
    XcdBarrier b; b.bar = bar; b.x = xb_xcc_id(); b.st = st;
    if (threadIdx.x == 0) (void)xb_add(&bar[XB_XCNT(b.x)], 1u);
    return b;
}
__device__ __forceinline__ void xcd_barrier_complete(unsigned* bar, unsigned x, unsigned& nloc, unsigned& nx) {
    const unsigned G = gridDim.x * gridDim.y * gridDim.z;
    unsigned sum, cnt, mine, sp = 0u;
    for (;;) {
        sum = 0u; cnt = 0u; mine = 0u;
#pragma unroll
        for (unsigned j = 0; j < 16; ++j) { const unsigned c = xb_ld(&bar[XB_XCNT(j)]); sum += c; cnt += (c > 0u) ? 1u : 0u; mine = (j == x) ? c : mine; }
        if (sum == G) break;
        __builtin_amdgcn_s_sleep(1);
        if ((++sp & 255u) == 0u) { if (xb_ld(&bar[XB_TMO])) break; if (sp > XB_SPIN_CAP) { atomicAdd(&bar[XB_TMO], 1u); break; } }
    }
    nloc = mine > 0u ? mine : 1u; nx = cnt > 0u ? cnt : 1u;
}

__device__ __forceinline__ void xcd_barrier(const XcdBarrier& b) {
    asm volatile("s_waitcnt vmcnt(0)" ::: "memory");
    __syncthreads();
    if (threadIdx.x == 0) {
        unsigned* bar = b.bar;
        __builtin_amdgcn_s_waitcnt(0);
        unsigned nloc = b.st[0], nx = b.st[1];
        if (nloc == 0u) { xcd_barrier_complete(bar, b.x, nloc, nx); b.st[0] = nloc; b.st[1] = nx; }
        const unsigned old = xb_add(&bar[XB_XSUB(b.x)], 1u);
        const unsigned gen = old / nloc;
        if (old + 1u == (gen + 1u) * nloc) {
            __builtin_amdgcn_fence(__ATOMIC_RELEASE, "agent");
            asm volatile("s_waitcnt vmcnt(0)" ::: "memory");
            const unsigned og = xb_add(&bar[XB_TOP], 1u);
            const unsigned tg = og / nx;
            if (og + 1u == (tg + 1u) * nx) xb_add(&bar[XB_TOPGEN], 1u);
            else XB_SPIN(xb_ld(&bar[XB_TOPGEN]) == tg, bar);
            __builtin_amdgcn_fence(__ATOMIC_ACQUIRE, "agent");
            xb_add(&bar[XB_XGEN(b.x)], 1u);
            asm volatile("s_waitcnt vmcnt(0)" ::: "memory");
        } else {
            XB_SPIN(xb_ld(&bar[XB_XGEN(b.x)]) == gen, bar);
            __builtin_amdgcn_fence(__ATOMIC_ACQUIRE, "agent");
            asm volatile("s_waitcnt vmcnt(0)" ::: "memory");
        }
    }
    __syncthreads();
}

template <int K> DI void run_kind(const Ctx& C0, int l0, LAS unsigned char* ldsg) {
    unsigned zz; asm volatile("s_mov_b32 %0, 0" : "=s"(zz)); Ctx C = C0; C.ws = C0.ws + zz; C.out = C0.out + zz; C.in = C0.in + zz; const int l = l0 + (int)zz;
    { int t_ = C0.tid; asm volatile("" : "+v"(t_)); C.tid = t_; C.lane = t_ & 63; C.wave = __builtin_amdgcn_readfirstlane(t_ >> 6); }
    if constexpr (K == 0) p0_prologue(C);
    else if constexpr (K == 1) { unsigned* cnt = C.ctr() + 128 + 64 * l; if (l > 0) sample_post(C, C.ssq(SQ_X0 + l), cnt, 8);
        pg8::Gemm g{C.XB(), C.wgt(l, W_IN), T, INP, DM, DM, DM}; pg8::WaitOrder S; S.init(T, INP, C.G, C.blk); S.cnt = cnt; S.need = l > 0 ? (unsigned)C.G : 0u;
        pg8::EpiG1 E{C.PROJ(), C.ssq(SQ_X0 + l), C.ssq(SQ_QA + l), C.ssq(SQ_KVA + l), true}; pg8::gemm_phase<pg8::EpiG1, pg8::WaitOrder, true, true>(ldsg, g, S, E);
        if (TIME_D) { __syncthreads(); pg8::EpiG1 E2{C.PROJ(), C.ssq(SQ_X0 + l), C.ssq(SQ_QA + l), C.ssq(SQ_KVA + l), false}; pg8::gemm_phase<pg8::EpiG1, pg8::WaitOrder, true, true>(ldsg, g, S, E2); } }
    else if constexpr (K == 2 && NAIVE_QKV) naive_q(C, l);
    else if constexpr (K == 3 && NAIVE_QKV) naive_kv(C, l);
    else if constexpr (K == 2) { pg8::Gemm g{C.PROJ() + C_CQ, C.wgt(l, W_UQ), T, 768, 256, INP, 256}; pg8::StaticOrder S; S.init(T, 768, C.G, C.blk);
        pg8::EpiQ E{C.QF(), C.ssq(SQ_QA + l)}; pg8::gemm_phase<pg8::EpiQ, pg8::StaticOrder, true, true>(ldsg, g, S, E); }
    else if constexpr (K == 3) { pg8::Gemm g{C.PROJ() + C_CKV, C.wgt(l, W_KV), TP, 1024, 128, INP, 128}; pg8::StaticOrder S; S.init(TP, 1024, C.G, C.blk);
        pg8::EpiScaleStore E{C.KVF(), 1024, C.ssq(SQ_KVA + l), 1.f / 128.f}; pg8::gemm_phase<pg8::EpiScaleStore, pg8::StaticOrder, true, true>(ldsg, g, S, E); }
    else if constexpr (K == 4) { __syncthreads(); misc_rows(C, l);
        if (TIME_B) misc_rows(C, l);
        if (!NAIVE_S5) for (int rep = 0; rep < 1 + TIME_B; ++rep) for (int ci = C.blk; ci < 256; ci += C.G) s5_item<false>(C, l, ci);
        __syncthreads();
        if (!NAIVE_HG) for (int bi = C.G - 1 - C.blk; bi < 144; bi += C.G) hgrn_local(C, l, bi * 8 + C.wave); }
    else if constexpr (K == 5) { if (NAIVE_HG) naive_hg_scan(C, l, C.GT()); else hgrn_prefix(C, l);
        if (NAIVE_S5) naive_s5_scan(C, l, (float*)C.XB()); else for (int rep = 0; rep < 1 + TIME_B; ++rep) for (int ci = C.blk; ci < 288; ci += C.G) s5_item<true>(C, l, ci); }
    else if constexpr (K == 6) { if (NAIVE_ATTS) naive_attn_sample(C, l); else { attn_phase<true>(C, l); if (TIME_ATTS) attn_phase<true>(C, l, 1); } }
    else if constexpr (K == 7) { if (NAIVE_ATTP) naive_attn_prompt(C, l); else { attn_phase<false>(C, l); if (TIME_ATTP) attn_phase<false>(C, l, 1); } }
    else if constexpr (K == 8) { if (NAIVE_HG) naive_hg_norm(C, l, C.GT()); else for (int rep = 0; rep < 1 + TIME_B; ++rep) for (int bi = C.blk; bi < 144; bi += C.G) hgrn_final(C, l, bi);
        if (NAIVE_S5) naive_s5_glu(C, l, (const float*)C.XB());
        mla_finalize(C, l); }
    else if constexpr (K == 9) { { pg8::Gemm g{C.MIX(), C.wgt(l, W_OUT), TP, DM, DM, DM, DM}; pg8::StaticOrder S; S.init(TP, DM, C.G, C.blk);
          pg8::EpiRes E{C.out + O_X, C.XB(), C.ssq(SQ_2A + l)}; pg8::gemm_phase<pg8::EpiRes, pg8::StaticOrder, true, true>(ldsg, g, S, E);
          if (TIME_D) { __syncthreads(); pg8::EpiRes E2{(float*)(C.ws + WS_OV), (bf16*)(C.ws + WS_OV + 73400320), C.ssq(11)}; pg8::gemm_phase<pg8::EpiRes, pg8::StaticOrder, true, true>(ldsg, g, S, E2); } }
        { pg8::Gemm g{C.MIX(), C.wgt(l, W_OUT), T, DM, 256, DM, DM}; pg8::SplitOrder S{C.G, C.blk, 256, 32}; pg8::EpiPartial E{C.GT(), 256}; pg8::gemm_phase<pg8::EpiPartial, pg8::SplitOrder, true, true>(ldsg, g, S, E); } }
    else if constexpr (K == 10) { unsigned* cnt = C.ctr() + 256 + 64 * l; sample_post(C, C.ssq(SQ_2A + l), cnt, 4);
        pg8::Gemm g{C.XB(), C.wgt(l, W_UP), T, DFF, DM, DM, DM}; pg8::WaitOrder S; S.init(T, DFF, C.G, C.blk); S.cnt = cnt; S.need = (unsigned)C.G;
        pg8::EpiUp E{C.HID(), C.ssq(SQ_2A + l)}; pg8::gemm_phase<pg8::EpiUp, pg8::WaitOrder, true, true>(ldsg, g, S, E); }
    else if constexpr (K == 11) { { pg8::Gemm g{C.HID(), C.wgt(l, W_DN), TP, DM, DFF, DFF, DFF}; pg8::StaticOrder S; S.init(TP, DM, C.G, C.blk);
          pg8::EpiRes E{C.out + O_X, C.XB(), C.ssq(SQ_X1 + l)}; pg8::gemm_phase<pg8::EpiRes, pg8::StaticOrder, true, true>(ldsg, g, S, E); }
        { pg8::Gemm g{C.HID(), C.wgt(l, W_DN), T, DM, 512, DFF, DFF}; pg8::SplitOrder S{C.G, C.blk, 512, 64}; pg8::EpiPartial E{C.GT(), 512}; pg8::gemm_phase<pg8::EpiPartial, pg8::SplitOrder, true, true>(ldsg, g, S, E); } }
    else final_norm(C);
}
DI Ctx make_ctx(const Args& args, unsigned char* lds_raw) {
    Ctx C; C.in = args.in; C.out = args.out; C.ws = args.ws; C.lds = (char*)lds_raw; C.tid = threadIdx.x; C.lane = C.tid & 63; C.wave = __builtin_amdgcn_readfirstlane(C.tid >> 6); C.G = gridDim.x; C.blk = blockIdx.x; return C;
}
template <int K> __global__ void __launch_bounds__(NTHR, 2) phase_kernel(Args args, int l) {
    extern __shared__ __attribute__((aligned(16))) unsigned char lds_raw[];
    const Ctx C = make_ctx(args, lds_raw);
    run_kind<K>(C, l, (LAS unsigned char*)lds_raw);
}
#ifndef MK_MEGA
#define MK_MEGA 1
#endif
#if MK_MEGA
__global__ void __launch_bounds__(NTHR, 2) trunk_fwd(Args args) {
    extern __shared__ __attribute__((aligned(16))) unsigned char lds_raw[];
    cg::grid_group grid = cg::this_grid();
    const Ctx C = make_ctx(args, lds_raw); LAS unsigned char* ldsg = (LAS unsigned char*)lds_raw;
    volatile LAS unsigned* xst = (volatile LAS unsigned*)((LAS unsigned char*)lds_raw + LDS_BYTES - 32);
    if (threadIdx.x < 2) xst[threadIdx.x] = 0u;
    __syncthreads();
    grid.sync();
    const XcdBarrier xbar = xcd_barrier_post((unsigned*)(C.ctr() + 1024), xst);
#define GSYNC() xcd_barrier(xbar)
#ifndef KMASK
#define KMASK 0x1fff
#endif
#define RK(k, l) do { if ((KMASK >> (k)) & 1) { run_kind<k>(C, l, ldsg); if ((TIME_A && (k == 0)) || (TIME_B && (k == 2 || k == 3)) || (TIME_C && (k == 10))) { __syncthreads(); run_kind<k>(C, l, ldsg); } } } while (0)
    RK(0, 0); GSYNC();
#define LAYER(l) do { RK(1, l); GSYNC(); RK(2, l); RK(3, l); RK(4, l); GSYNC(); RK(5, l); RK(6, l); RK(7, l); GSYNC(); RK(8, l); GSYNC(); RK(9, l); GSYNC(); RK(10, l); GSYNC(); RK(11, l); GSYNC(); } while (0)
    LAYER(0);
    LAYER(1);
    RK(12, 0);
}
#endif

template <int K> static void launch_kind(const Args& a, int l, int grid, hipStream_t stream) {
    static bool attr_set = false;
    if (!attr_set) { (void)hipFuncSetAttribute((const void*)phase_kernel<K>, hipFuncAttributeMaxDynamicSharedMemorySize, LDS_BYTES); attr_set = true; }
    hipLaunchKernelGGL(phase_kernel<K>, dim3(grid), dim3(NTHR), LDS_BYTES, stream, a, l);
}
extern "C" void kernel_launch(void* const* d_in, const int* in_sizes, int n_in, void* d_out, int out_size, void* d_ws, size_t ws_size, hipStream_t stream) {
    static int grid = 0;
    if (grid == 0) {
        int dev = 0, cus = 0;
        if (n_in != 31 || ws_size < WS_END) { fprintf(stderr, "kernel_launch: unexpected inputs (n_in %d, ws %zu < %zu)\n", n_in, ws_size, (size_t)WS_END); grid = -1; return; }
        (void)hipGetDevice(&dev); (void)hipDeviceGetAttribute(&cus, hipDeviceAttributeMultiprocessorCount, dev);
#if MK_MEGA
        int per_cu = 0;
        (void)hipFuncSetAttribute((const void*)trunk_fwd, hipFuncAttributeMaxDynamicSharedMemorySize, LDS_BYTES);
        (void)hipOccupancyMaxActiveBlocksPerMultiprocessor(&per_cu, (const void*)trunk_fwd, NTHR, LDS_BYTES);
        (void)hipGetLastError();
        if (per_cu < 1) fprintf(stderr, "kernel_launch: occupancy query says %d blocks per CU\n", per_cu);
#endif
        grid = cus > 0 ? cus : 256;
    }
    if (grid < 0) return;
    (void)hipMemsetAsync((char*)d_ws + WS_ZERO, 0, ZERO_BYTES, stream);
    Args a{};
    for (int i = 0; i < 31; ++i) a.in[i] = (const float*)d_in[i];
    a.out = (float*)d_out; a.ws = (unsigned char*)d_ws;
#if MK_MEGA
    void* kargs[] = {&a};
    hipError_t e = hipLaunchCooperativeKernel((const void*)trunk_fwd, dim3(grid), dim3(NTHR), kargs, LDS_BYTES, stream);
    if (e != hipSuccess) fprintf(stderr, "cooperative launch failed: %s (grid %d)\n", hipGetErrorString(e), grid);
#else
    launch_kind<0>(a, 0, grid, stream);
    for (int l = 0; l < 2; ++l) {
        launch_kind<1>(a, l, grid, stream); launch_kind<2>(a, l, grid, stream); launch_kind<3>(a, l, grid, stream); launch_kind<4>(a, l, grid, stream);
        launch_kind<5>(a, l, grid, stream); launch_kind<6>(a, l, grid, stream); launch_kind<7>(a, l, grid, stream); launch_kind<8>(a, l, grid, stream);
        launch_kind<9>(a, l, grid, stream); launch_kind<10>(a, l, grid, stream); launch_kind<11>(a, l, grid, stream);
    }
    launch_kind<12>(a, 0, grid, stream);
#endif
}
```
